# Optimizing an MI355X kernel written in HIP

```python
import math
import jax
import jax.numpy as jnp
from jax import lax
import numpy as np

D_MODEL = 1024
BATCH = 8
SEQ = 2048
DEPTH = 4

GRID_W = 64
CTX_LEN = 256
N_MIXERS = 3

DN_ALPHA = (2 * DEPTH) ** 0.25
DN_BETA = (8 * DEPTH) ** -0.25
LN_EPS = 1e-5
FFN_RES_W = 0.5

N_MOD = 9

D_FF = 2816

DA_HEADS = 8
DA_HEAD_DIM = D_MODEL // DA_HEADS // 2
DA_SCALE = DA_HEAD_DIM ** -0.5
Q_BLOCK = 128
ROPE_BASE = 10000.0
ROPE_AXIS_DIM = DA_HEAD_DIM // 2
ROPE_PAIRS = ROPE_AXIS_DIM // 2

HY_SHORT = 3
HY_EMB = 33
HY_BANDS = (HY_EMB - 1) // 2
HY_FILTER_W = 64
HY_TARGET = 1e-2
HY_MIN_DECAY = math.log(HY_TARGET) / 0.3
HY_MAX_DECAY = math.log(HY_TARGET) / 1.5
HY_SHIFT = 0.05

SSM_D_INNER = 2 * D_MODEL
SSM_HEAD_DIM = 64
SSM_HEADS = SSM_D_INNER // SSM_HEAD_DIM
SSM_GROUPS = 4
SSM_STATE = 128
SSM_CONV = 3
SSM_CHUNK = 128
SSM_GN = SSM_GROUPS * SSM_STATE
SSM_CONV_DIM = SSM_D_INNER + 2 * SSM_GN
SSM_IN_DIM = SSM_D_INNER + SSM_CONV_DIM + 2 * SSM_HEADS

N_ATTN = (DEPTH + 2) // 3
N_HYENA = (DEPTH + 1) // 3
N_SSM = DEPTH // 3

kernel_name = "hybrid_diffattn_hyena_ssd_prefix_dit"


def layer_norm(x, g, b):
    xf = x.astype(jnp.float32)
    mu = jnp.mean(xf, -1, keepdims=True)
    var = jnp.mean(jnp.square(xf - mu), -1, keepdims=True)
    return ((xf - mu) * lax.rsqrt(var + LN_EPS)).astype(x.dtype) * g + b


def rms_norm(x, g):
    xf = x.astype(jnp.float32)
    return (xf * lax.rsqrt(jnp.mean(xf * xf, -1, keepdims=True) + LN_EPS)).astype(x.dtype) * g


def modulate(x, shift, scale):
    return x * (1.0 + scale) + shift


def post_norm(x, y, gate, res_w, g, b):
    return layer_norm(DN_ALPHA * x + res_w * (1.0 + gate) * y, g, b)


def swiglu(h, w13, w2):
    a, u = jnp.split(h @ w13, 2, axis=-1)
    return (jax.nn.silu(a) * u) @ w2


def dwconv_centred(u, w, b):
    k = w.shape[0]
    pad = k // 2
    L = u.shape[1]
    up = jnp.pad(u, ((0, 0), (pad, pad), (0, 0)))
    out = b + up[:, 0:L] * w[0]
    for t in range(1, k):
        out = out + up[:, t:t + L] * w[t]
    return out


def axial_rope(L):
    rows = L // GRID_W
    row = jnp.broadcast_to(jnp.arange(rows, dtype=jnp.float32)[:, None], (rows, GRID_W)).reshape(L)
    col = jnp.broadcast_to(jnp.arange(GRID_W, dtype=jnp.float32)[None, :], (rows, GRID_W)).reshape(L)
    inv = ROPE_BASE ** (-jnp.arange(ROPE_PAIRS, dtype=jnp.float32) / ROPE_PAIRS)
    ang = jnp.stack([row[:, None] * inv, col[:, None] * inv], axis=1)
    ang = jnp.concatenate([ang, ang], -1)
    return jnp.cos(ang), jnp.sin(ang)


def apply_rope(x, cos, sin):
    sh = x.shape
    xs = x.reshape(sh[:-1] + (2, ROPE_AXIS_DIM))
    x1, x2 = jnp.split(xs, 2, axis=-1)
    rot = jnp.concatenate([-x2, x1], -1)
    c = cos[None, :, None, None].astype(x.dtype)
    s = sin[None, :, None, None].astype(x.dtype)
    return (xs * c + rot * s).reshape(sh)


def diff_qkv(h, w_qkv):
    b, L = h.shape[0], h.shape[1]
    q, k, v = jnp.split(h @ w_qkv, 3, axis=-1)
    return (q.reshape(b, L, DA_HEADS, 2, DA_HEAD_DIM),
            k.reshape(b, L, DA_HEADS, 2, DA_HEAD_DIM),
            v.reshape(b, L, DA_HEADS, 2 * DA_HEAD_DIM))


def diff_attend(q, k, v, lam_full):
    s = jnp.einsum('bqhtd,bkhtd->bhtqk', q, k).astype(jnp.float32) * DA_SCALE
    p = jax.nn.softmax(s, axis=-1)
    a = p[:, :, 0] - lam_full * p[:, :, 1]
    return jnp.einsum('bhqk,bkhe->bqhe', a.astype(v.dtype), v)


def diff_out(o, subln_g, lam_init, w_o):
    b, L = o.shape[0], o.shape[1]
    o = rms_norm(o, subln_g) * (1.0 - lam_init)
    return o.reshape(b, L, D_MODEL) @ w_o


def diff_attention(hc, hl, w_qkv, w_o, lam, subln_g, layer_idx, ctx_out):
    b, L = hl.shape[0], hl.shape[1]
    lam_init = 0.8 - 0.6 * math.exp(-0.3 * layer_idx)
    lf = lam.astype(jnp.float32)
    lam_full = jnp.exp(jnp.sum(lf[0] * lf[1])) - jnp.exp(jnp.sum(lf[2] * lf[3])) + lam_init
    qc, kc, vc = diff_qkv(hc, w_qkv)
    ql, kl, vl = diff_qkv(hl, w_qkv)
    cos, sin = axial_rope(L)
    ql = apply_rope(ql, cos, sin)
    kl = apply_rope(kl, cos, sin)
    k_all = jnp.concatenate([kc, kl], axis=1)
    v_all = jnp.concatenate([vc, vl], axis=1)
    nb = L // Q_BLOCK
    qb = ql.reshape(b, nb, Q_BLOCK, DA_HEADS, 2, DA_HEAD_DIM).transpose(1, 0, 2, 3, 4, 5)
    ob = lax.map(lambda q: diff_attend(q, k_all, v_all, lam_full), qb)
    ol = ob.transpose(1, 0, 2, 3, 4).reshape(b, L, DA_HEADS, 2 * DA_HEAD_DIM)
    yl = diff_out(ol, subln_g, lam_init, w_o)
    yc = diff_out(diff_attend(qc, kc, vc, lam_full), subln_g, lam_init, w_o) if ctx_out else None
    return yc, yl


def hyena_filter(L, f_w_in, f_w_mid, f_b, f_freq, f_w_out):
    f32 = jnp.float32
    t = jnp.linspace(0.0, 1.0, L, dtype=f32)[:, None]
    w = 2.0 * math.pi * jnp.arange(L, dtype=f32)[:, None] / L
    f = jnp.linspace(1e-4, HY_BANDS - 1, HY_BANDS, dtype=f32)
    z = jnp.concatenate([t, jnp.cos(f * w), -jnp.sin(f * w)], axis=-1)
    freq = f_freq.astype(f32)
    h = jnp.sin(freq * (z @ f_w_in.astype(f32) + f_b[0].astype(f32)))
    h = jnp.sin(freq * (h @ f_w_mid[0].astype(f32) + f_b[1].astype(f32)))
    h = jnp.sin(freq * (h @ f_w_mid[1].astype(f32) + f_b[2].astype(f32)))
    h = (h @ f_w_out.astype(f32)).reshape(L, 2, D_MODEL)
    deltas = jnp.abs(jnp.linspace(HY_MIN_DECAY, HY_MAX_DECAY, D_MODEL, dtype=f32))
    window = jnp.exp(-t * deltas) + HY_SHIFT
    h = h * window[:, None, :]
    h_fwd, h_bwd = h[:, 0], h[:, 1]
    return jnp.concatenate([h_fwd, jnp.zeros((1, D_MODEL), f32), h_bwd[:0:-1]], axis=0)


def long_conv_bidir(u, k_full, bias):
    L = u.shape[1]
    uf32 = u.astype(jnp.float32)
    uf = jnp.fft.rfft(uf32, n=2 * L, axis=1)
    kf = jnp.fft.rfft(k_full, n=2 * L, axis=0)
    y = jnp.fft.irfft(uf * kf[None], n=2 * L, axis=1)[:, :L]
    return (y + uf32 * bias.astype(jnp.float32)).astype(u.dtype)


def hyena_mixer(h, w_in, b_in, conv_w, conv_b, f_w_in, f_w_mid, f_b, f_freq, f_w_out, bias, w_out, b_out):
    L = h.shape[1]
    k_full = hyena_filter(L, f_w_in, f_w_mid, f_b, f_freq, f_w_out)
    u = dwconv_centred(h @ w_in + b_in, conv_w, conv_b)
    x0, x1, v = jnp.split(u, 3, axis=-1)
    v = long_conv_bidir(v * x1, k_full, bias)
    return (v * x0) @ w_out + b_out


def segsum(a):
    T = a.shape[-1]
    cs = jnp.cumsum(a, axis=-1)
    d = cs[..., :, None] - cs[..., None, :]
    mask = jnp.tril(jnp.ones((T, T), dtype=bool))
    return jnp.where(mask, d, -jnp.inf)


def ssd_scan(xdt, adt, bm, cm, init):
    b, L, h, p = xdt.shape
    g, n = bm.shape[2], bm.shape[3]
    r = h // g
    nc = L // SSM_CHUNK
    X = xdt.reshape(b, nc, SSM_CHUNK, g, r, p)
    A = adt.reshape(b, nc, SSM_CHUNK, g, r).transpose(0, 3, 4, 1, 2)
    Bc = bm.reshape(b, nc, SSM_CHUNK, g, n)
    Cc = cm.reshape(b, nc, SSM_CHUNK, g, n)
    A_cs = jnp.cumsum(A, axis=-1)
    Lmat = jnp.exp(segsum(A))
    CB = jnp.einsum('bclgn,bcsgn->bgcls', Cc, Bc)
    y_diag = jnp.einsum('bgrcls,bcsgrp->bclgrp', CB[:, :, None] * Lmat, X)
    decay_states = jnp.exp(A_cs[..., -1:] - A_cs).transpose(0, 3, 4, 1, 2)
    states = jnp.einsum('bclgn,bclgrp->bcgrpn', Bc, X * decay_states[..., None])
    states = jnp.concatenate([init.reshape(b, 1, g, r, p, n), states], axis=1)
    chunk_decay = jnp.exp(segsum(jnp.pad(A_cs[..., -1], ((0, 0), (0, 0), (0, 0), (1, 0)))))
    states = jnp.einsum('bgrzc,bcgrpn->bzgrpn', chunk_decay, states)
    prev, final = states[:, :-1], states[:, -1]
    y_off = jnp.einsum('bclgn,bcgrpn->bclgrp', Cc, prev) * jnp.exp(A_cs).transpose(0, 3, 4, 1, 2)[..., None]
    return (y_diag + y_off).reshape(b, L, h, p), final.reshape(b, h, p, n)


def ssm_scan(h, w_in, conv_w, conv_b, dt_bias, a_log, d_skip, init_f, init_b):
    f32 = jnp.float32
    b, L = h.shape[0], h.shape[1]
    zxbcdt = h @ w_in
    z = zxbcdt[..., :SSM_D_INNER]
    xbc = zxbcdt[..., SSM_D_INNER:SSM_D_INNER + SSM_CONV_DIM]
    dt = zxbcdt[..., SSM_D_INNER + SSM_CONV_DIM:].reshape(b, L, 2, SSM_HEADS)
    xbc = jax.nn.silu(dwconv_centred(xbc, conv_w, conv_b)).astype(f32)
    xs = xbc[..., :SSM_D_INNER].reshape(b, L, SSM_HEADS, SSM_HEAD_DIM)
    bm = xbc[..., SSM_D_INNER:SSM_D_INNER + SSM_GN].reshape(b, L, SSM_GROUPS, SSM_STATE)
    cm = xbc[..., SSM_D_INNER + SSM_GN:].reshape(b, L, SSM_GROUPS, SSM_STATE)
    dt = jax.nn.softplus(dt.astype(f32) + dt_bias.astype(f32))
    a = -jnp.exp(a_log.astype(f32))
    y_f, s_f = ssd_scan(xs * dt[:, :, 0, :, None], a[0] * dt[:, :, 0], bm, cm, init_f)
    y_b, s_b = ssd_scan(jnp.flip(xs * dt[:, :, 1, :, None], 1), jnp.flip(a[1] * dt[:, :, 1], 1),
                        jnp.flip(bm, 1), jnp.flip(cm, 1), init_b)
    y = y_f + jnp.flip(y_b, 1) + xs * d_skip.astype(f32)[:, None]
    return y.reshape(b, L, SSM_D_INNER), z, s_f, s_b


def ssm_out(y, z, norm_g, w_out):
    b, L = y.shape[0], y.shape[1]
    yg = (y * jax.nn.silu(z.astype(jnp.float32))).reshape(b, L, SSM_GROUPS, SSM_D_INNER // SSM_GROUPS)
    yg = yg * lax.rsqrt(jnp.mean(yg * yg, -1, keepdims=True) + LN_EPS)
    return (yg.reshape(b, L, SSM_D_INNER).astype(z.dtype) * norm_g) @ w_out


def ssm_mixer(hc, hl, w_in, conv_w, conv_b, dt_bias, a_log, d_skip, norm_g, w_out, ctx_out):
    zero = jnp.zeros((hl.shape[0], SSM_HEADS, SSM_HEAD_DIM, SSM_STATE), jnp.float32)
    yc_in, zc, s_f, s_b = ssm_scan(hc, w_in, conv_w, conv_b, dt_bias, a_log, d_skip, zero, zero)
    yl_in, zl, _, _ = ssm_scan(hl, w_in, conv_w, conv_b, dt_bias, a_log, d_skip, s_f, s_b)
    yl = ssm_out(yl_in, zl, norm_g, w_out)
    yc = ssm_out(yc_in, zc, norm_g, w_out) if ctx_out else None
    return yc, yl


def setup_inputs(seed: int = 0) -> dict:
    key = jax.random.key(seed)
    ks = iter(jax.random.split(key, 48))
    f32 = jnp.float32

    def nrm(shape, scale):
        return jax.random.normal(next(ks), shape, f32) * scale

    D, F = D_MODEL, D_FF
    u_dt = jax.random.uniform(next(ks), (N_SSM, 2, SSM_HEADS), f32)
    dt0 = jnp.exp(u_dt * (math.log(0.1) - math.log(1e-3)) + math.log(1e-3))
    return {
        "x": nrm((BATCH, SEQ, D), 1.0),
        "c": nrm((BATCH, D), 1.0),
        "ctx": nrm((BATCH, CTX_LEN, D), 1.0),
        "c_ctx": nrm((D,), 1.0),
        "ada_w": nrm((DEPTH, D, N_MOD * D), 0.1 * D ** -0.5),
        "ada_b": nrm((DEPTH, N_MOD * D), 0.01),
        "ln_g": 1.0 + nrm((DEPTH, 3, D), 0.1),
        "ln_b": nrm((DEPTH, 3, D), 0.01),
        "ffn_w13": nrm((DEPTH, 2, D, 2 * F), D ** -0.5),
        "ffn_w2": nrm((DEPTH, 2, F, D), DN_BETA * F ** -0.5),
        "attn_w_qkv": nrm((N_ATTN, D, 3 * D), D ** -0.5),
        "attn_w_o": nrm((N_ATTN, D, D), DN_BETA * D ** -0.5),
        "attn_lambda": nrm((N_ATTN, 4, DA_HEAD_DIM), 0.1),
        "attn_subln_g": 1.0 + nrm((N_ATTN, 2 * DA_HEAD_DIM), 0.1),
        "hy_w_in": nrm((N_HYENA, D, 3 * D), D ** -0.5),
        "hy_b_in": nrm((N_HYENA, 3 * D), 0.01),
        "hy_conv_w": nrm((N_HYENA, HY_SHORT, 3 * D), HY_SHORT ** -0.5),
        "hy_conv_b": nrm((N_HYENA, 3 * D), 0.01),
        "hy_filt_w_in": nrm((N_HYENA, HY_EMB, HY_FILTER_W), HY_EMB ** -0.5),
        "hy_filt_w_mid": nrm((N_HYENA, 2, HY_FILTER_W, HY_FILTER_W), HY_FILTER_W ** -0.5),
        "hy_filt_b": nrm((N_HYENA, 3, HY_FILTER_W), 0.1),
        "hy_filt_freq": 1.0 + nrm((N_HYENA, HY_FILTER_W), 0.1),
        "hy_filt_w_out": nrm((N_HYENA, HY_FILTER_W, 2 * D), 0.1 * HY_FILTER_W ** -0.5),
        "hy_bias": nrm((N_HYENA, D), 1.0),
        "hy_w_out": nrm((N_HYENA, D, D), DN_BETA * D ** -0.5),
        "hy_b_out": nrm((N_HYENA, D), 0.01),
        "ssm_w_in": nrm((N_SSM, D, SSM_IN_DIM), D ** -0.5),
        "ssm_conv_w": nrm((N_SSM, SSM_CONV, SSM_CONV_DIM), SSM_CONV ** -0.5),
        "ssm_conv_b": nrm((N_SSM, SSM_CONV_DIM), 0.01),
        "ssm_dt_bias": dt0 + jnp.log(-jnp.expm1(-dt0)),
        "ssm_a_log": jnp.log(jax.random.uniform(next(ks), (N_SSM, 2, SSM_HEADS), f32, 1.0, 16.0)),
        "ssm_d": 1.0 + nrm((N_SSM, SSM_HEADS), 0.1),
        "ssm_norm_g": 1.0 + nrm((N_SSM, SSM_D_INNER), 0.1),
        "ssm_w_out": nrm((N_SSM, SSM_D_INNER, D), DN_BETA * SSM_D_INNER ** -0.5),
    }


def reference(x, c, ctx, c_ctx, ada_w, ada_b, ln_g, ln_b, ffn_w13, ffn_w2,
              attn_w_qkv, attn_w_o, attn_lambda, attn_subln_g,
              hy_w_in, hy_b_in, hy_conv_w, hy_conv_b, hy_filt_w_in, hy_filt_w_mid, hy_filt_b,
              hy_filt_freq, hy_filt_w_out, hy_bias, hy_w_out, hy_b_out,
              ssm_w_in, ssm_conv_w, ssm_conv_b, ssm_dt_bias, ssm_a_log, ssm_d, ssm_norm_g, ssm_w_out):
    lat, cx = x, ctx
    s_lat = jax.nn.silu(c)
    s_ctx = jax.nn.silu(c_ctx)
    for i in range(DEPTH):
        kind, j = i % N_MIXERS, i // N_MIXERS
        ctx_out = i < DEPTH - 1
        ctx_in = ctx_out or kind != 1
        ml = jnp.split((s_lat @ ada_w[i] + ada_b[i])[:, None, :], N_MOD, axis=-1)
        mc = jnp.split((s_ctx @ ada_w[i] + ada_b[i])[None, None, :], N_MOD, axis=-1)

        lat = post_norm(lat, swiglu(modulate(lat, ml[0], ml[1]), ffn_w13[i, 0], ffn_w2[i, 0]),
                        ml[2], FFN_RES_W, ln_g[i, 0], ln_b[i, 0])
        if ctx_in:
            cx = post_norm(cx, swiglu(modulate(cx, mc[0], mc[1]), ffn_w13[i, 0], ffn_w2[i, 0]),
                           mc[2], FFN_RES_W, ln_g[i, 0], ln_b[i, 0])

        hl = modulate(lat, ml[3], ml[4])
        hc = modulate(cx, mc[3], mc[4]) if ctx_in else None
        if kind == 0:
            yc, yl = diff_attention(hc, hl, attn_w_qkv[j], attn_w_o[j], attn_lambda[j], attn_subln_g[j], i, ctx_out)
        elif kind == 1:
            hy_args = (hy_w_in[j], hy_b_in[j], hy_conv_w[j], hy_conv_b[j], hy_filt_w_in[j], hy_filt_w_mid[j],
                       hy_filt_b[j], hy_filt_freq[j], hy_filt_w_out[j], hy_bias[j], hy_w_out[j], hy_b_out[j])
            yl = hyena_mixer(hl, *hy_args)
            yc = hyena_mixer(hc, *hy_args) if ctx_out else None
        else:
            yc, yl = ssm_mixer(hc, hl, ssm_w_in[j], ssm_conv_w[j], ssm_conv_b[j], ssm_dt_bias[j],
                               ssm_a_log[j], ssm_d[j], ssm_norm_g[j], ssm_w_out[j], ctx_out)
        lat = post_norm(lat, yl, ml[5], 1.0, ln_g[i, 1], ln_b[i, 1])
        if ctx_out:
            cx = post_norm(cx, yc, mc[5], 1.0, ln_g[i, 1], ln_b[i, 1])

        lat = post_norm(lat, swiglu(modulate(lat, ml[6], ml[7]), ffn_w13[i, 1], ffn_w2[i, 1]),
                        ml[8], FFN_RES_W, ln_g[i, 2], ln_b[i, 2])
        if ctx_out:
            cx = post_norm(cx, swiglu(modulate(cx, mc[6], mc[7]), ffn_w13[i, 1], ffn_w2[i, 1]),
                           mc[8], FFN_RES_W, ln_g[i, 2], ln_b[i, 2])
    return lat
```

```cpp
#include <hip/hip_runtime.h>
#include <hip/hip_cooperative_groups.h>
#include <cstdio>
namespace cg = cooperative_groups;

#define LAS __attribute__((address_space(3)))
typedef unsigned short bf16_t;
typedef short bf16x8 __attribute__((ext_vector_type(8)));
typedef float f32x4 __attribute__((ext_vector_type(4)));
typedef float f32x2 __attribute__((ext_vector_type(2)));
typedef unsigned u32x4 __attribute__((ext_vector_type(4)));
typedef unsigned u32x2 __attribute__((ext_vector_type(2)));

constexpr int D = 1024, FF = 2816, TL = 16384, TC = 2048, TA = 18432, SEQ = 2048, CTXL = 256, NB = 8;
constexpr int NMODC = 9216;
constexpr float DN_ALPHA = 1.681792830507429f;
constexpr float LN_EPS = 1e-5f;
constexpr int SSM_IN = 5184, SSM_INP = 5376;

constexpr size_t al256(size_t x) { return (x + 255) & ~(size_t)255; }
constexpr size_t OFF_MOD = 0;
constexpr size_t OFF_ROPE = OFF_MOD + al256((size_t)4 * 9 * NMODC * 4);
constexpr size_t OFF_BAR = OFF_ROPE + al256(2 * 1024 * 4);
constexpr size_t OFF_KLAT = OFF_BAR + 16384;
constexpr size_t OFF_KCTX = OFF_KLAT + (size_t)4096 * 1024 * 4;
constexpr size_t OFF_W13T = OFF_KCTX + (size_t)512 * 1024 * 4;
constexpr size_t OFF_W2T = OFF_W13T + (size_t)8 * 5632 * 1024 * 2;
constexpr size_t OFF_WQKT = OFF_W2T + (size_t)8 * 1024 * 2816 * 2;
constexpr size_t OFF_WVT = OFF_WQKT + (size_t)2 * 2048 * 1024 * 2;
constexpr size_t OFF_WOT = OFF_WVT + (size_t)2 * 1024 * 1024 * 2;
constexpr size_t OFF_WHIT = OFF_WOT + (size_t)2 * 1024 * 1024 * 2;
constexpr size_t OFF_WHOT = OFF_WHIT + (size_t)3072 * 1024 * 2;
constexpr size_t OFF_WSIT = OFF_WHOT + (size_t)1024 * 1024 * 2;
constexpr size_t OFF_WSOT = OFF_WSIT + (size_t)SSM_INP * 1024 * 2;
constexpr size_t OFF_LAT = OFF_WSOT + (size_t)1024 * 2048 * 2;
constexpr size_t OFF_HB = OFF_LAT + (size_t)TA * D * 4;
constexpr size_t OFF_BIG = OFF_HB + (size_t)TA * D * 2;
constexpr size_t OFF_ACT = OFF_BIG;
constexpr size_t OFF_SLAB = OFF_ACT + al256((size_t)TA * FF * 2);
constexpr size_t OFF_QK = OFF_BIG;
constexpr size_t OFF_VT = OFF_QK + (size_t)TA * 2048 * 2;
constexpr size_t OFF_AO = OFF_VT + (size_t)1024 * TA * 2;
constexpr size_t OFF_HU = OFF_BIG;
constexpr int HLT = SEQ + CTXL;
constexpr size_t OFF_HX0 = OFF_HU + (size_t)TA * 3072 * 2;
constexpr size_t OFF_HVT = OFF_HX0 + (size_t)TA * D * 4;
constexpr size_t OFF_HYT = OFF_HVT + (size_t)D * NB * HLT * 2;
constexpr size_t OFF_HG = OFF_HYT + (size_t)D * NB * HLT * 2;
constexpr size_t OFF_ZX = OFF_BIG;
constexpr size_t OFF_Y = OFF_ZX + al256((size_t)TA * SSM_IN * 2);
constexpr size_t WS_END = OFF_Y + (size_t)TA * 2048 * 4;
static_assert(OFF_HG + (size_t)TA * D * 2 <= WS_END && OFF_SLAB + (size_t)8 * TC * D * 4 <= WS_END, "ws map");
static_assert(WS_END < (size_t)720 * 1000 * 1000, "ws budget");

constexpr int LDS_BYTES = 142336;

struct Params { const float* in[34]; float* out; unsigned char* ws; int ph_lo, ph_hi; };
typedef const __attribute__((address_space(4))) unsigned char* KArg;
struct PV {
    KArg ka; int tid, bid, gsz;
    __device__ __forceinline__ const float* in(int k) const { return *(const float* const __attribute__((address_space(4)))*)(ka + 8 * k); }
    __device__ __forceinline__ float* out() const { return *(float* const __attribute__((address_space(4)))*)(ka + 8 * 34); }
    __device__ __forceinline__ unsigned char* ws() const { return *(unsigned char* const __attribute__((address_space(4)))*)(ka + 8 * 35); }
};

typedef __bf16 bf16x2_t __attribute__((ext_vector_type(2)));
__device__ __forceinline__ unsigned cvt_pk_bf16(float lo, float hi) { const f32x2 v = {lo, hi}; const bf16x2_t r = __builtin_convertvector(v, bf16x2_t); return __builtin_bit_cast(unsigned, r); }
__device__ __forceinline__ unsigned cvt_pk_bf16_m(float lo, float hi) { return cvt_pk_bf16(lo, hi); }
__device__ __forceinline__ float bf2f(unsigned short b) { return __uint_as_float(((unsigned)b) << 16); }
__device__ __forceinline__ float bflo(unsigned w) { return __uint_as_float(w << 16); }
__device__ __forceinline__ float bfhi(unsigned w) { return __uint_as_float(w & 0xffff0000u); }
__device__ __forceinline__ float wave_sum(float v) {
#pragma unroll
    for (int o = 1; o < 64; o <<= 1) v += __shfl_xor(v, o);
    return v;
}
__device__ __forceinline__ float xmax16(float x) { const u32x2 r = __builtin_amdgcn_permlane16_swap(__float_as_uint(x), __float_as_uint(x), false, false); return fmaxf(__uint_as_float(r[0]), __uint_as_float(r[1])); }
__device__ __forceinline__ float xmax32(float x) { const u32x2 r = __builtin_amdgcn_permlane32_swap(__float_as_uint(x), __float_as_uint(x), false, false); return fmaxf(__uint_as_float(r[0]), __uint_as_float(r[1])); }
__device__ __forceinline__ float silu_f(float a) { return a * __builtin_amdgcn_rcpf(1.0f + __expf(-a)); }
#define LDS_WAIT() asm volatile("s_waitcnt lgkmcnt(0)" ::: "memory")

#define XB_TMO      128
#define XB_XCNT(j)  (256  + 64 * (j))
#define XB_XSUB(j)  (1280 + 64 * (j))
#define XB_XGEN(j)  (2304 + 64 * (j))
#define XB_TOP      3328
#define XB_TOPGEN   3392
#define XCD_BAR_WORDS 3456
#define XB_SPIN_CAP (1u << 18)
__device__ __forceinline__ unsigned xb_ld(unsigned* p)              { return __hip_atomic_load(p, __ATOMIC_RELAXED, __HIP_MEMORY_SCOPE_AGENT); }
__device__ __forceinline__ unsigned xb_add(unsigned* p, unsigned v) { return __hip_atomic_fetch_add(p, v, __ATOMIC_RELAXED, __HIP_MEMORY_SCOPE_AGENT); }
__device__ __forceinline__ unsigned xb_xcc_id() { return (unsigned)__builtin_amdgcn_s_getreg((3 << 11) | 20) & 0xFu; }
#define XB_SPIN(cond, bar) do { unsigned _sp = 0; while (cond) { __builtin_amdgcn_s_sleep(1); \
    if ((++_sp & 255u) == 0u) { if (xb_ld(&(bar)[XB_TMO])) break; if (_sp > XB_SPIN_CAP) { atomicAdd(&(bar)[XB_TMO], 1u); break; } } } } while (0)
struct XcdBarrier { unsigned* bar; unsigned x; volatile LAS unsigned* st; };
__device__ __forceinline__ XcdBarrier xcd_barrier_post(unsigned* bar, volatile LAS unsigned* st, int tid) {
    XcdBarrier b; b.bar = bar; b.x = xb_xcc_id(); b.st = st;
    if (tid == 0) (void)xb_add(&bar[XB_XCNT(b.x)], 1u);
    return b;
}
__device__ __forceinline__ void xcd_barrier_complete(unsigned* bar, unsigned x, unsigned G, unsigned& nloc, unsigned& nx) {
    unsigned sum, cnt, mine, sp = 0u;
    for (;;) {
        sum = 0u; cnt = 0u; mine = 0u;
#pragma unroll
        for (unsigned j = 0; j < 16; ++j) { const unsigned c = xb_ld(&bar[XB_XCNT(j)]); sum += c; cnt += (c > 0u) ? 1u : 0u; mine = (j == x) ? c : mine; }
        if (sum == G) break;
        __builtin_amdgcn_s_sleep(1);
        if ((++sp & 255u) == 0u) { if (xb_ld(&bar[XB_TMO])) break; if (sp > XB_SPIN_CAP) { atomicAdd(&bar[XB_TMO], 1u); break; } }
    }
    nloc = mine > 0u ? mine : 1u; nx = cnt > 0u ? cnt : 1u;
}
__device__ __forceinline__ void xcd_barrier(const XcdBarrier& b, int tid, unsigned G) {
    asm volatile("s_waitcnt vmcnt(0)" ::: "memory");
    __syncthreads();
    if (tid == 0) {
        unsigned* bar = b.bar;
        __builtin_amdgcn_s_waitcnt(0);
        unsigned nloc = b.st[0], nx = b.st[1];
        if (nloc == 0u) { xcd_barrier_complete(bar, b.x, G, nloc, nx); b.st[0] = nloc; b.st[1] = nx; }
        const unsigned old = xb_add(&bar[XB_XSUB(b.x)], 1u);
        const unsigned gen = old / nloc;
        if (old + 1u == (gen + 1u) * nloc) {
            __builtin_amdgcn_fence(__ATOMIC_RELEASE, "agent");
            asm volatile("s_waitcnt vmcnt(0)" ::: "memory");
            const unsigned og = xb_add(&bar[XB_TOP], 1u);
            const unsigned tg = og / nx;
            if (og + 1u == (tg + 1u) * nx) xb_add(&bar[XB_TOPGEN], 1u);
            else XB_SPIN(xb_ld(&bar[XB_TOPGEN]) == tg, bar);
            __builtin_amdgcn_fence(__ATOMIC_ACQUIRE, "agent");
            xb_add(&bar[XB_XGEN(b.x)], 1u);
            asm volatile("s_waitcnt vmcnt(0)" ::: "memory");
        } else {
            XB_SPIN(xb_ld(&bar[XB_XGEN(b.x)]) == gen, bar);
            __builtin_amdgcn_fence(__ATOMIC_ACQUIRE, "agent");
            asm volatile("s_waitcnt vmcnt(0)" ::: "memory");
        }
    }
    __syncthreads();
}


namespace pg8 {
constexpr int BM = 256, BK = 64, HALF = 128, HTB = HALF * BK * 2, STAGE_BYTES = 8 * HTB, NXCD = 8, WGM = 8;
__device__ __forceinline__ int lds_byte(int r, int c) { const int st = (r >> 4) * 2 + (c >> 5), rr = r & 15, cc = c & 31, ob = rr * 64 + cc * 2; return st * 1024 + (ob ^ (((ob >> 9) & 1) << 5)); }
__device__ __forceinline__ void stage_rc(int b, int& R, int& C) { const int st = b / 1024, sb = b % 1024, swz = sb ^ (((sb >> 9) & 1) << 5); R = (st >> 1) * 16 + swz / 64; C = (st & 1) * 32 + (swz % 64) / 2; }
__device__ __forceinline__ int perm32(int rho) { const int n = rho >> 4, i = rho & 15; return 8 * (i >> 2) + 4 * n + (i & 3); }
struct Unit { int pm, pn, kt0, nt, ks; };
struct Gemm { const bf16_t* A; const bf16_t* Bt; int M, N, K, lda; };
struct StaticOrder {
    int nM, nN, nwg, G, c, ntk;
    __device__ void init(int M, int N, int G_, int c_) { nM = M / BM; nN = N / BM; nwg = nM * nN; G = G_; c = c_; ntk = 0; }
    __device__ void setk(int K) { ntk = K / BK; }
    __device__ bool next(int i, Unit& u) const {
        const long L = (long)i * G + c; if (L >= nwg) return false;
        int wgid = (int)L; { const int q = nwg / NXCD, r = nwg % NXCD, xcd = wgid % NXCD, off = wgid / NXCD; wgid = (xcd < r ? xcd * (q + 1) : r * (q + 1) + (xcd - r) * q) + off; }
        const int nig = WGM * nN, gid = wgid / nig, fm = gid * WGM, gsz = (nM - fm) < WGM ? (nM - fm) : WGM;
        u.pm = fm + ((wgid % nig) % gsz); u.pn = (wgid % nig) / gsz; u.kt0 = 0; u.nt = ntk; u.ks = -1; return true;
    }
};
template <int NSL> struct SplitOrder {
    int G, c, ntk;
    __device__ void init(int K, int G_, int c_) { G = G_; c = c_; ntk = K / BK; }
    __device__ bool next(int i, Unit& u) const {
        const int L = i * G + c;
        if (L >= 256 + 32 * NSL) return false;
        if (L < 256) {
            const int xcd = L & 7, off = L >> 3;
            u.pm = 8 * xcd + (off & 7); u.pn = off >> 3; u.kt0 = 0; u.nt = ntk; u.ks = -1;
        } else {
            const int j = L - 256, ks = j % NSL, tile = j / NSL;
            const int np = ntk / 2, q = np / NSL, r = np % NSL;
            const int p0 = ks * q + (ks < r ? ks : r), pc = q + (ks < r ? 1 : 0);
            u.pm = 64 + (tile >> 2); u.pn = tile & 3; u.kt0 = 2 * p0; u.nt = 2 * pc; u.ks = ks;
        }
        return true;
    }
};

template <class Epi, class Sched>
__device__ __forceinline__ void gemm_phase(LAS unsigned char* lds, const Gemm g, const Sched& S, const Epi& E, const int tid_in) {
    const int tid = tid_in, wid = __builtin_amdgcn_readfirstlane(tid >> 6), lane = tid & 63, wr = wid >> 2, wc = wid & 3, fr = lane & 15, fq = lane >> 4;
    const int K = g.K, lda = g.lda;
    unsigned voffA[2], voffB[2];
#pragma unroll
    for (int i = 0; i < 2; ++i) { int R, C; stage_rc(tid * 16 + i * 8192, R, C); const int Rb = Epi::PERM ? ((R & ~31) + perm32(R & 31)) : R;
        voffA[i] = (unsigned)(R * lda + C) * 2u; voffB[i] = (unsigned)(Rb * K + C) * 2u; }
    const size_t kstep = (size_t)(BK * 2);
    const size_t hstepA = (size_t)HALF * lda * 2, hstepB = (size_t)HALF * K * 2;
    const size_t tstepA = 2 * hstepA, tstepB = 2 * hstepB;
    const unsigned ldsw = (unsigned)wid * 1024u;
    const int aoff = lds_byte(wr * 64 + fr, fq * 8), boff = lds_byte(wc * 32 + fr, fq * 8);
#define PG8_SA(b, h) (((b) * 2 + (h)) * HTB)
#define PG8_SB(b, h) ((4 + (b) * 2 + (h)) * HTB)
#define PG8_STAGE(bufoff, gbase, voff) do { _Pragma("unroll") for (int _i = 0; _i < 2; ++_i) \
        __builtin_amdgcn_global_load_lds((const unsigned*)((const char*)(gbase) + (voff)[_i]), (LAS unsigned*)(lds + (bufoff) + ldsw + _i * 8192), 16, 0, 0); } while (0)
#define PG8_LDA(dst, b, h) do { _Pragma("unroll") for (int m = 0; m < 4; ++m) _Pragma("unroll") for (int k = 0; k < 2; ++k) dst[m][k] = *(const LAS bf16x8*)(lds + PG8_SA(b, h) + aoff + m * 2048 + k * 1024); } while (0)
#define PG8_LDB(dst, b, h) do { _Pragma("unroll") for (int n = 0; n < 2; ++n) _Pragma("unroll") for (int k = 0; k < 2; ++k) dst[n][k] = *(const LAS bf16x8*)(lds + PG8_SB(b, h) + boff + n * 2048 + k * 1024); } while (0)
#define PG8_MMA(ai, bj, At, Bt) do { __builtin_amdgcn_s_setprio(1); _Pragma("unroll") for (int m = 0; m < 4; ++m) _Pragma("unroll") for (int n = 0; n < 2; ++n) _Pragma("unroll") for (int k = 0; k < 2; ++k) \
        acc[ai][bj][m][n] = __builtin_amdgcn_mfma_f32_16x16x32_bf16(Bt[n][k], At[m][k], acc[ai][bj][m][n], 0, 0, 0); __builtin_amdgcn_s_setprio(0); } while (0)
#define PG8_WAIT_V(n) asm volatile("s_waitcnt vmcnt(" #n ")" ::: "memory")
#define PG8_WAIT_L(n) asm volatile("s_waitcnt lgkmcnt(" #n ")" ::: "memory")
#define PG8_BAR __builtin_amdgcn_s_barrier()
#define PG8_SCHED __builtin_amdgcn_sched_barrier(0)
    Unit cur, nxt; int ui = 0;
    if (!S.next(0, cur)) return;
    f32x4 acc[2][2][4][2];
#pragma unroll
    for (int a = 0; a < 2; ++a)
#pragma unroll
        for (int b = 0; b < 2; ++b)
#pragma unroll
            for (int m = 0; m < 4; ++m)
#pragma unroll
                for (int n = 0; n < 2; ++n) acc[a][b][m][n] = (f32x4){0.f, 0.f, 0.f, 0.f};
    bf16x8 At[4][2], B0[2][2], B1[2][2];
    const char* cA = (const char*)g.A + (size_t)cur.pm * tstepA + (size_t)cur.kt0 * kstep; const char* cB = (const char*)g.Bt + (size_t)cur.pn * tstepB + (size_t)cur.kt0 * kstep;
    PG8_STAGE(PG8_SB(0, 0), cB, voffB); PG8_STAGE(PG8_SB(0, 1), cB + hstepB, voffB); PG8_STAGE(PG8_SA(0, 0), cA, voffA); PG8_STAGE(PG8_SA(0, 1), cA + hstepA, voffA);
    if (wr == 1) PG8_BAR;
    PG8_WAIT_V(2); PG8_BAR;
    PG8_STAGE(PG8_SB(1, 0), cB + kstep, voffB); PG8_STAGE(PG8_SA(1, 0), cA + kstep, voffA); PG8_STAGE(PG8_SB(1, 1), cB + hstepB + kstep, voffB);
    PG8_WAIT_V(6); PG8_BAR;
    for (;;) {
        const bool has_next = S.next(ui + 1, nxt);
        const char* nA = has_next ? (const char*)g.A + (size_t)nxt.pm * tstepA + (size_t)nxt.kt0 * kstep : cA; const char* nB = has_next ? (const char*)g.Bt + (size_t)nxt.pn * tstepB + (size_t)nxt.kt0 * kstep : cB;
        const int nt = cur.nt;
        for (int t = 0; t < nt; t += 2) {
            const bool last = (t == nt - 2);
            const char* a1 = cA + (size_t)(t + 1) * kstep;
            const char* a2 = last ? nA : cA + (size_t)(t + 2) * kstep; const char* b2 = last ? nB : cB + (size_t)(t + 2) * kstep;
            const char* a3 = a2 + kstep; const char* b3 = b2 + kstep;
            PG8_LDB(B0, 0, 0); PG8_LDB(B1, 0, 1); PG8_SCHED; PG8_LDA(At, 0, 0); PG8_STAGE(PG8_SA(1, 1), a1 + hstepA, voffA);
            PG8_WAIT_V(8); PG8_WAIT_L(0); PG8_BAR; PG8_MMA(0, 0, At, B0); PG8_MMA(0, 1, At, B1); PG8_BAR; PG8_SCHED;
            PG8_LDA(At, 0, 1); PG8_STAGE(PG8_SB(0, 0), b2, voffB); PG8_STAGE(PG8_SB(0, 1), b2 + hstepB, voffB); PG8_STAGE(PG8_SA(0, 0), a2, voffA);
            PG8_WAIT_V(8); PG8_WAIT_L(0); PG8_BAR; PG8_MMA(1, 0, At, B0); PG8_MMA(1, 1, At, B1); PG8_BAR; PG8_SCHED;
            PG8_LDB(B0, 1, 0); PG8_LDB(B1, 1, 1); PG8_SCHED; PG8_LDA(At, 1, 0); PG8_STAGE(PG8_SA(0, 1), a2 + hstepA, voffA);
            PG8_WAIT_V(8); PG8_WAIT_L(0); PG8_BAR; PG8_MMA(0, 0, At, B0); PG8_MMA(0, 1, At, B1); PG8_BAR; PG8_SCHED;
            PG8_LDA(At, 1, 1); PG8_STAGE(PG8_SB(1, 0), b3, voffB); PG8_STAGE(PG8_SB(1, 1), b3 + hstepB, voffB); PG8_STAGE(PG8_SA(1, 0), a3, voffA);
            PG8_WAIT_V(8); PG8_WAIT_L(0); PG8_BAR; PG8_MMA(1, 0, At, B0); PG8_MMA(1, 1, At, B1); PG8_BAR; PG8_SCHED;
        }
        if (wr == 0) PG8_BAR;
        E(acc, cur, wr, wc, fr, fq);
        if (!has_next) break;
#pragma unroll
        for (int a = 0; a < 2; ++a)
#pragma unroll
            for (int b = 0; b < 2; ++b)
#pragma unroll
                for (int m = 0; m < 4; ++m)
#pragma unroll
                    for (int n = 0; n < 2; ++n) acc[a][b][m][n] = (f32x4){0.f, 0.f, 0.f, 0.f};
        cur = nxt; cA = nA; cB = nB; ++ui;
        if (wr == 1) PG8_BAR;
    }
    PG8_WAIT_V(0);
    PG8_BAR;
#undef PG8_SA
#undef PG8_SB
#undef PG8_STAGE
#undef PG8_LDA
#undef PG8_LDB
#undef PG8_MMA
#undef PG8_WAIT_V
#undef PG8_WAIT_L
#undef PG8_BAR
#undef PG8_SCHED
}
}
using pg8::Unit;
typedef f32x4 AccT[2][2][4][2];

struct EpiSwiglu {
    static constexpr bool PERM = true;
    bf16_t* O;
    __device__ __forceinline__ void operator()(const AccT& acc, const Unit& u, int wr, int wc, int fr, int fq) const {
        const int row0 = u.pm * 256 + wr * 64 + fr, col0 = u.pn * 128 + wc * 32 + 8 * fq;
#pragma unroll
        for (int ai = 0; ai < 2; ++ai)
#pragma unroll
            for (int m = 0; m < 4; ++m) {
                bf16_t* rowp = O + (size_t)(row0 + ai * 128 + m * 16) * FF + col0;
                const f32x4 a0 = acc[ai][0][m][0], a1 = acc[ai][0][m][1], u0 = acc[ai][1][m][0], u1 = acc[ai][1][m][1];
                u32x4 w;
                w.x = cvt_pk_bf16(silu_f(a0[0]) * u0[0], silu_f(a0[1]) * u0[1]);
                w.y = cvt_pk_bf16(silu_f(a0[2]) * u0[2], silu_f(a0[3]) * u0[3]);
                w.z = cvt_pk_bf16(silu_f(a1[0]) * u1[0], silu_f(a1[1]) * u1[1]);
                w.w = cvt_pk_bf16(silu_f(a1[2]) * u1[2], silu_f(a1[3]) * u1[3]);
                *(u32x4*)rowp = w;
            }
    }
};
struct EpiResid {
    static constexpr bool PERM = false;
    float* lat; const float* modl; int gidx; float w; const float* bias;
    __device__ __forceinline__ void operator()(const AccT& acc, const Unit& u, int wr, int wc, int fr, int fq) const {
        const int mr = (u.pm < 64) ? (u.pm >> 3) : 8;
        const int row0 = u.pm * 256 + wr * 64 + fr, col0 = u.pn * 256 + wc * 32 + 4 * fq;
        const float* gate = modl + (size_t)mr * NMODC + gidx * 1024 + col0;
        float* base = lat + (size_t)row0 * D + col0;
        f32x4 xa[8], xb[8];
#pragma unroll
        for (int i = 0; i < 8; ++i) xa[i] = *(const f32x4*)(base + (size_t)((i >> 2) * 128 + (i & 3) * 16) * D);
#pragma unroll
        for (int k = 0; k < 4; ++k) {
            const int bj = k >> 1, n = k & 1, co = bj * 128 + n * 16;
            if (k < 3) { const int co2 = ((k + 1) >> 1) * 128 + ((k + 1) & 1) * 16;
#pragma unroll
                for (int i = 0; i < 8; ++i) xb[i] = *(const f32x4*)(base + (size_t)((i >> 2) * 128 + (i & 3) * 16) * D + co2); }
            const f32x4 gv = (*(const f32x4*)(gate + co) + 1.0f) * w;
            const f32x4 bv = bias ? *(const f32x4*)(bias + col0 + co) : (f32x4){0.f, 0.f, 0.f, 0.f};
            __builtin_amdgcn_sched_barrier(0);
#pragma unroll
            for (int i = 0; i < 8; ++i) { const int ai = i >> 2, m = i & 3;
                *(f32x4*)(base + (size_t)(ai * 128 + m * 16) * D + co) = xa[i] * DN_ALPHA + gv * (acc[ai][bj][m][n] + bv); }
#pragma unroll
            for (int i = 0; i < 8; ++i) xa[i] = xb[i];
        }
    }
};
struct EpiResidSplit {
    static constexpr bool PERM = false;
    EpiResid r; float* slabs;
    __device__ __forceinline__ void operator()(const AccT& acc, const Unit& u, int wr, int wc, int fr, int fq) const {
        if (u.ks < 0) { r(acc, u, wr, wc, fr, fq); return; }
        const int row0 = u.pm * 256 + wr * 64 + fr, col0 = u.pn * 256 + wc * 32 + 4 * fq;
        float* sb = slabs + ((size_t)u.ks * TC + (row0 - TL)) * D + col0;
#pragma unroll
        for (int ai = 0; ai < 2; ++ai)
#pragma unroll
            for (int m = 0; m < 4; ++m)
#pragma unroll
                for (int bj = 0; bj < 2; ++bj)
#pragma unroll
                    for (int n = 0; n < 2; ++n) *(f32x4*)(sb + (size_t)(ai * 128 + m * 16) * D + bj * 128 + n * 16) = acc[ai][bj][m][n];
    }
};
struct EpiQK {
    static constexpr bool PERM = false;
    bf16_t* O; const float* tab;
    __device__ __forceinline__ void operator()(const AccT& acc, const Unit& u, int wr, int wc, int fr, int fq) const {
        const int row0 = u.pm * 256 + wr * 64 + fr, col0 = u.pn * 256 + wc * 32 + 4 * fq;
        const int axis = wc & 1;
        if (u.pm < 64) {
            f32x4 cs, sn, csn, snn;
            { const int t = row0 & 2047; const int pos = axis ? (t & 63) : (t >> 6);
              cs = *(const f32x4*)(tab + pos * 16 + 4 * fq); sn = *(const f32x4*)(tab + 1024 + pos * 16 + 4 * fq); csn = cs; snn = sn; }
#pragma unroll
            for (int i = 0; i < 8; ++i) {
                const int ai = i >> 2, m = i & 3;
                const int r = row0 + ai * 128 + m * 16;
                if (i < 7) { const int r2 = row0 + ((i + 1) >> 2) * 128 + ((i + 1) & 3) * 16; const int t = r2 & 2047; const int pos = axis ? (t & 63) : (t >> 6);
                    csn = *(const f32x4*)(tab + pos * 16 + 4 * fq); snn = *(const f32x4*)(tab + 1024 + pos * 16 + 4 * fq); }
                bf16_t* rowp = O + (size_t)r * 2048 + col0;
#pragma unroll
                for (int bj = 0; bj < 2; ++bj) {
                    const f32x4 x1 = acc[ai][bj][m][0], x2 = acc[ai][bj][m][1];
                    const f32x4 o1 = x1 * cs - x2 * sn, o2 = x2 * cs + x1 * sn;
                    u32x2 w1, w2; w1.x = cvt_pk_bf16(o1[0], o1[1]); w1.y = cvt_pk_bf16(o1[2], o1[3]); w2.x = cvt_pk_bf16(o2[0], o2[1]); w2.y = cvt_pk_bf16(o2[2], o2[3]);
                    *(u32x2*)(rowp + bj * 128) = w1; *(u32x2*)(rowp + bj * 128 + 16) = w2;
                }
                cs = csn; sn = snn;
            }
        } else {
#pragma unroll
            for (int i = 0; i < 8; ++i) {
                const int ai = i >> 2, m = i & 3;
                bf16_t* rowp = O + (size_t)(row0 + ai * 128 + m * 16) * 2048 + col0;
#pragma unroll
                for (int bj = 0; bj < 2; ++bj) {
                    const f32x4 x1 = acc[ai][bj][m][0], x2 = acc[ai][bj][m][1];
                    u32x2 w1, w2; w1.x = cvt_pk_bf16(x1[0], x1[1]); w1.y = cvt_pk_bf16(x1[2], x1[3]); w2.x = cvt_pk_bf16(x2[0], x2[1]); w2.y = cvt_pk_bf16(x2[2], x2[3]);
                    *(u32x2*)(rowp + bj * 128) = w1; *(u32x2*)(rowp + bj * 128 + 16) = w2;
                }
            }
        }
    }
};
struct EpiB {
    static constexpr bool PERM = true;
    bf16_t* O; int ldc; const float* bias; int ncols;
    __device__ __forceinline__ void operator()(const AccT& acc, const Unit& u, int wr, int wc, int fr, int fq) const {
        const int row0 = u.pm * 256 + wr * 64 + fr, col0 = u.pn * 256 + wc * 32 + 8 * fq;
        bf16_t* base = O + (size_t)row0 * ldc + col0;
#pragma unroll
        for (int bj = 0; bj < 2; ++bj) {
            if (col0 + bj * 128 < ncols) {
                f32x4 b0 = (f32x4){0.f, 0.f, 0.f, 0.f}, b1 = (f32x4){0.f, 0.f, 0.f, 0.f};
                if (bias) { b0 = *(const f32x4*)(bias + col0 + bj * 128); b1 = *(const f32x4*)(bias + col0 + bj * 128 + 4); }
#pragma unroll
                for (int ai = 0; ai < 2; ++ai)
#pragma unroll
                    for (int m = 0; m < 4; ++m) {
                        const f32x4 v0 = acc[ai][bj][m][0] + b0, v1 = acc[ai][bj][m][1] + b1;
                        u32x4 w; w.x = cvt_pk_bf16(v0[0], v0[1]); w.y = cvt_pk_bf16(v0[2], v0[3]); w.z = cvt_pk_bf16(v1[0], v1[1]); w.w = cvt_pk_bf16(v1[2], v1[3]);
                        *(u32x4*)(base + (size_t)(ai * 128 + m * 16) * ldc + bj * 128) = w;
                    }
            }
            asm volatile("" ::: "memory");
        }
    }
};

__device__ __forceinline__ void transpose_tile(const float* W, int ldw, bf16_t* WT, int ldt, int k0, int n0, int drow0, LAS float* scr, int lane) {
    f32x4 wv[8];
#pragma unroll
    for (int i = 0; i < 8; ++i) wv[i] = *(const f32x4*)(W + (size_t)(k0 + 8 * i + (lane >> 3)) * ldw + n0 + 4 * (lane & 7));
#pragma unroll
    for (int i = 0; i < 8; ++i) { LAS float* dd = scr + (8 * i + (lane >> 3)) * 33 + 4 * (lane & 7); dd[0] = wv[i][0]; dd[1] = wv[i][1]; dd[2] = wv[i][2]; dd[3] = wv[i][3]; }
    LDS_WAIT();
    const int c = lane & 7;
#pragma unroll
    for (int j = 0; j < 4; ++j) { const int n = (lane >> 3) + 8 * j; const LAS float* s = scr + (8 * c) * 33 + n;
        u32x4 o; o.x = cvt_pk_bf16(s[0 * 33], s[1 * 33]); o.y = cvt_pk_bf16(s[2 * 33], s[3 * 33]); o.z = cvt_pk_bf16(s[4 * 33], s[5 * 33]); o.w = cvt_pk_bf16(s[6 * 33], s[7 * 33]);
        *(u32x4*)(WT + (size_t)(drow0 + n) * ldt + k0 + 8 * c) = o; }
    LDS_WAIT();
}

__device__ __forceinline__ void hyena_filter_pos(const PV& P, int pos, int lane) {
    const float* fw_in = P.in(18);
    const float* fw_mid = P.in(19);
    const float* fb = P.in(20);
    const float* ffreq = P.in(21);
    const float* fw_out = P.in(22);
    int L, n, RL; bf16_t* kf;
    if (pos < SEQ) { L = SEQ; n = pos; RL = 4096; kf = (bf16_t*)(P.ws() + OFF_KLAT); } else { L = CTXL; n = pos - SEQ; RL = 512; kf = (bf16_t*)(P.ws() + OFF_KCTX); }
    const float t = (float)n / (float)(L - 1);
    const float w = 6.283185307179586f * (float)n / (float)L;
    float zv = 0.f;
    if (lane == 0) zv = t;
    else if (lane < 17) { const float f = 1e-4f + (float)(lane - 1) * ((15.0f - 1e-4f) / 15.0f); zv = cosf(f * w); }
    else if (lane < 33) { const float f = 1e-4f + (float)(lane - 17) * ((15.0f - 1e-4f) / 15.0f); zv = -sinf(f * w); }
    const float fr = ffreq[lane];
    float a = fb[lane];
    for (int k = 0; k < 33; ++k) a += __shfl(zv, k) * fw_in[k * 64 + lane];
    float h = sinf(fr * a);
    a = fb[64 + lane];
    for (int k = 0; k < 64; ++k) a += __shfl(h, k) * fw_mid[k * 64 + lane];
    h = sinf(fr * a);
    a = fb[128 + lane];
    for (int k = 0; k < 64; ++k) a += __shfl(h, k) * fw_mid[4096 + k * 64 + lane];
    h = sinf(fr * a);
    f32x4 o[8];
#pragma unroll
    for (int i = 0; i < 8; ++i) o[i] = (f32x4){0.f, 0.f, 0.f, 0.f};
    for (int k = 0; k < 64; ++k) {
        const float hk = __shfl(h, k);
        const f32x4* wr = (const f32x4*)(fw_out + (size_t)k * 2048) + lane;
#pragma unroll
        for (int i = 0; i < 8; ++i) o[i] += hk * wr[64 * i];
    }
    const float dmin = -15.350567286626973f, dmax = -3.0701134573253945f;
#pragma unroll
    for (int i = 0; i < 8; ++i) {
        const int c = lane * 4 + 256 * i; const int dir = c >> 10, d0 = c & 1023;
        f32x4 r;
#pragma unroll
        for (int j = 0; j < 4; ++j) { const float dl = fabsf(dmin + (float)(d0 + j) * ((dmax - dmin) / 1023.0f)); r[j] = o[i][j] * (expf(-t * dl) + 0.05f); }
        const int idx = dir == 0 ? (L - 1 - n) : (L - 1 + n);
        if (dir == 0 || n >= 1) {
#pragma unroll
            for (int j = 0; j < 4; ++j) { float v = r[j]; if (dir == 0 && n == 0) v += P.in(23)[d0 + j];
                kf[(size_t)(d0 + j) * RL + idx] = (bf16_t)(cvt_pk_bf16(v, 0.f) & 0xffffu); }
        }
    }
}

__device__ __forceinline__ void phase_prologue(const PV& P, LAS unsigned char* lds) {
    const int tid = P.tid, lane = tid & 63, wave = __builtin_amdgcn_readfirstlane(tid >> 6), G = P.gsz;
    unsigned char* ws = P.ws();
    {
        LAS float* sv = (LAS float*)lds;
        LAS float* red = (LAS float*)(lds + 9 * 1024 * 4);
        const float* cin = P.in(1); const float* cctx = P.in(3);
        for (int i = tid; i < 9 * 1024; i += 512) { const float v = (i < 8192) ? cin[i] : cctx[i - 8192]; sv[i] = v / (1.0f + expf(-v)); }
        __syncthreads();
        const float* ada_w = P.in(4); const float* ada_b = P.in(5);
        float* mod = (float*)(ws + OFF_MOD);
        for (int uidx = P.bid; uidx < 288; uidx += G) {
            const int l = uidx / 72, cb = uidx % 72, cn = tid & 127, kq = tid >> 7;
            const float* wp = ada_w + (size_t)l * 1024 * NMODC + (size_t)(256 * kq) * NMODC + 128 * cb + cn;
            float acc[9];
#pragma unroll
            for (int r = 0; r < 9; ++r) acc[r] = 0.f;
#pragma unroll 4
            for (int k = 0; k < 256; ++k) {
                const float wv = wp[(size_t)k * NMODC];
#pragma unroll
                for (int r = 0; r < 9; ++r) acc[r] += sv[r * 1024 + 256 * kq + k] * wv;
            }
#pragma unroll
            for (int r = 0; r < 9; ++r) red[(kq * 9 + r) * 128 + cn] = acc[r];
            __syncthreads();
            for (int o = tid; o < 9 * 128; o += 512) { const int r = o >> 7, c2 = o & 127;
                const float s = red[(0 * 9 + r) * 128 + c2] + red[(1 * 9 + r) * 128 + c2] + red[(2 * 9 + r) * 128 + c2] + red[(3 * 9 + r) * 128 + c2];
                mod[((size_t)l * 9 + r) * NMODC + 128 * cb + c2] = s + ada_b[(size_t)l * NMODC + 128 * cb + c2]; }
            __syncthreads();
        }
    }
    if (P.bid == 0) { unsigned* bw = (unsigned*)(ws + OFF_BAR); for (int i = tid; i < XCD_BAR_WORDS; i += 512) bw[i] = 0u; }
    if (P.bid == G - 1) {
        float* tab = (float*)(ws + OFF_ROPE);
        for (int i = tid; i < 1024; i += 512) { const int pos = i >> 4, f = i & 15; const float inv = powf(10000.0f, -(float)f / 16.0f); const float ang = (float)pos * inv; tab[i] = cosf(ang); tab[1024 + i] = sinf(ang); }
    }
    __syncthreads();
    LAS float* scr = (LAS float*)(lds + wave * 16384);
    const int gw = P.bid * 8 + wave, NGW = G * 8;
    constexpr int I_13 = 8 * 16 * 176, I_2 = 8 * 44 * 32, I_QKV = 2 * 16 * 96, I_O = 2 * 16 * 32, I_HI = 16 * 96, I_HO = 16 * 32, I_SI = 16 * 162, I_SO = 32 * 32, I_PAD = 192, I_F = SEQ + CTXL;
    constexpr int NIT = I_13 + I_2 + I_QKV + I_O + I_HI + I_HO + I_SI + I_SO + I_PAD + I_F;
    for (int it = gw; it < NIT; it += NGW) {
        int r = it;
        if (r < I_13) { const int q = r / 2816, rr = r % 2816, kb = rr / 176, nb = rr % 176, n0 = 32 * nb; const int half = n0 >= FF ? 1 : 0, jn = n0 - half * FF;
            transpose_tile(P.in(8) + (size_t)q * 1024 * 5632, 5632, (bf16_t*)(ws + OFF_W13T) + (size_t)q * 5632 * 1024, 1024, 64 * kb, n0, 256 * (jn >> 7) + 128 * half + (jn & 127), scr, lane); continue; } r -= I_13;
        if (r < I_2) { const int q = r / 1408, rr = r % 1408, kb = rr / 32, nb = rr % 32;
            transpose_tile(P.in(9) + (size_t)q * FF * 1024, 1024, (bf16_t*)(ws + OFF_W2T) + (size_t)q * 1024 * FF, FF, 64 * kb, 32 * nb, 32 * nb, scr, lane); continue; } r -= I_2;
        if (r < I_QKV) { const int q = r / 1536, rr = r % 1536, kb = rr / 96, nb = rr % 96, n0 = 32 * nb;
            if (n0 < 2048) transpose_tile(P.in(10) + (size_t)q * 1024 * 3072, 3072, (bf16_t*)(ws + OFF_WQKT) + (size_t)q * 2048 * 1024, 1024, 64 * kb, n0, n0, scr, lane);
            else transpose_tile(P.in(10) + (size_t)q * 1024 * 3072, 3072, (bf16_t*)(ws + OFF_WVT) + (size_t)q * 1024 * 1024, 1024, 64 * kb, n0, n0 - 2048, scr, lane);
            continue; } r -= I_QKV;
        if (r < I_O) { const int q = r / 512, rr = r % 512, kb = rr / 32, nb = rr % 32;
            transpose_tile(P.in(11) + (size_t)q * 1024 * 1024, 1024, (bf16_t*)(ws + OFF_WOT) + (size_t)q * 1024 * 1024, 1024, 64 * kb, 32 * nb, 32 * nb, scr, lane); continue; } r -= I_O;
        if (r < I_HI) { const int kb = r / 96, nb = r % 96;
            transpose_tile(P.in(14), 3072, (bf16_t*)(ws + OFF_WHIT), 1024, 64 * kb, 32 * nb, 32 * nb, scr, lane); continue; } r -= I_HI;
        if (r < I_HO) { const int kb = r / 32, nb = r % 32;
            transpose_tile(P.in(24), 1024, (bf16_t*)(ws + OFF_WHOT), 1024, 64 * kb, 32 * nb, 32 * nb, scr, lane); continue; } r -= I_HO;
        if (r < I_SI) { const int kb = r / 162, nb = r % 162;
            transpose_tile(P.in(26), SSM_IN, (bf16_t*)(ws + OFF_WSIT), 1024, 64 * kb, 32 * nb, 32 * nb, scr, lane); continue; } r -= I_SI;
        if (r < I_SO) { const int kb = r / 32, nb = r % 32;
            transpose_tile(P.in(33), 1024, (bf16_t*)(ws + OFF_WSOT), 2048, 64 * kb, 32 * nb, 32 * nb, scr, lane); continue; } r -= I_SO;
        if (r < I_PAD) { u32x4* p = (u32x4*)((bf16_t*)(ws + OFF_WSIT) + (size_t)(SSM_IN + r) * 1024); unsigned zz = 0u; asm volatile("" : "+v"(zz)); const u32x4 z = (u32x4){zz, zz, zz, zz}; p[lane] = z; p[64 + lane] = z; continue; } r -= I_PAD;
        hyena_filter_pos(P, r, lane);
    }
}

__device__ __forceinline__ void ln_rows(f32x4 (&v)[4], const float* g, const float* b, int lane) {
    float s = 0.f;
#pragma unroll
    for (int j = 0; j < 4; ++j) s += (v[j][0] + v[j][1]) + (v[j][2] + v[j][3]);
    const float mean = wave_sum(s) * (1.f / D); float s2 = 0.f;
#pragma unroll
    for (int j = 0; j < 4; ++j) { v[j] = v[j] - mean; s2 += (v[j][0] * v[j][0] + v[j][1] * v[j][1]) + (v[j][2] * v[j][2] + v[j][3] * v[j][3]); }
    const float rstd = 1.0f / sqrtf(wave_sum(s2) * (1.f / D) + LN_EPS);
#pragma unroll
    for (int j = 0; j < 4; ++j) { const f32x4 gg = *((const f32x4*)g + lane + 64 * j), bb = *((const f32x4*)b + lane + 64 * j); v[j] = v[j] * rstd * gg + bb; }
}
__device__ __forceinline__ void write_hb(const f32x4 (&v)[4], const float* shift, const float* scale, bf16_t* hrow, int lane) {
#pragma unroll
    for (int j = 0; j < 4; ++j) { const f32x4 sh = *((const f32x4*)shift + lane + 64 * j), sc = *((const f32x4*)scale + lane + 64 * j);
        const f32x4 o = v[j] * (sc + 1.0f) + sh; u32x2 w; w.x = cvt_pk_bf16(o[0], o[1]); w.y = cvt_pk_bf16(o[2], o[3]);
        *((u32x2*)hrow + lane + 64 * j) = w; }
}
__device__ __forceinline__ int mod_row(int r) { return r < TL ? (r >> 11) : 8; }

__device__ __forceinline__ void phase_init(const PV& P) {
    const int lane = P.tid & 63, wave = P.tid >> 6, gw = P.bid * 8 + wave, NGW = P.gsz * 8;
    float* lat = (float*)(P.ws() + OFF_LAT); bf16_t* hb = (bf16_t*)(P.ws() + OFF_HB); const float* mod = (const float*)(P.ws() + OFF_MOD);
    f32x4 nv[4];
    if (gw < TA) { const float* s0 = gw < TL ? P.in(0) + (size_t)gw * D : P.in(2) + (size_t)(gw - TL) * D;
#pragma unroll
        for (int j = 0; j < 4; ++j) nv[j] = *((const f32x4*)s0 + lane + 64 * j); }
    for (int r = gw; r < TA; r += NGW) {
        f32x4 v[4];
#pragma unroll
        for (int j = 0; j < 4; ++j) v[j] = nv[j];
        if (r + NGW < TA) { const int r2 = r + NGW; const float* s2 = r2 < TL ? P.in(0) + (size_t)r2 * D : P.in(2) + (size_t)(r2 - TL) * D;
#pragma unroll
            for (int j = 0; j < 4; ++j) nv[j] = *((const f32x4*)s2 + lane + 64 * j); }
#pragma unroll
        for (int j = 0; j < 4; ++j) *((f32x4*)(lat + (size_t)r * D) + lane + 64 * j) = v[j];
        const float* m = mod + (size_t)mod_row(r) * NMODC;
        write_hb(v, m, m + 1024, hb + (size_t)r * D, lane);
    }
}
__device__ __forceinline__ void phase_ln(const PV& P, int M, const float* g, const float* b, const float* nmod  , int qshift, float* outp,
                                         const float* slabs, const float* gate8  , float wres) {
    const int lane = P.tid & 63, wave = P.tid >> 6, gw = P.bid * 8 + wave, NGW = P.gsz * 8;
    float* lat = (float*)(P.ws() + OFF_LAT); bf16_t* hb = (bf16_t*)(P.ws() + OFF_HB);
    f32x4 gg[4], bb[4];
#pragma unroll
    for (int j = 0; j < 4; ++j) { gg[j] = *((const f32x4*)g + lane + 64 * j); bb[j] = *((const f32x4*)b + lane + 64 * j); }
    f32x4 nv[4];
    if (gw < M) {
#pragma unroll
        for (int j = 0; j < 4; ++j) nv[j] = *((const f32x4*)(lat + (size_t)gw * D) + lane + 64 * j);
    }
    for (int r = gw; r < M; r += NGW) {
        float* row = lat + (size_t)r * D;
        f32x4 v[4];
#pragma unroll
        for (int j = 0; j < 4; ++j) v[j] = nv[j];
        if (r + NGW < M) {
#pragma unroll
            for (int j = 0; j < 4; ++j) nv[j] = *((const f32x4*)(lat + (size_t)(r + NGW) * D) + lane + 64 * j);
        }
        if (slabs && r >= TL) {
#pragma unroll
            for (int j = 0; j < 4; ++j) {
                f32x4 s = (f32x4){0.f, 0.f, 0.f, 0.f};
#pragma unroll
                for (int k = 0; k < 8; ++k) s += *((const f32x4*)(slabs + ((size_t)k * TC + (r - TL)) * D) + lane + 64 * j);
                const f32x4 gt = *((const f32x4*)gate8 + lane + 64 * j);
                v[j] = v[j] * DN_ALPHA + (gt + 1.0f) * wres * s;
            }
        }
        f32x4 shv[4], scv[4];
        if (!outp) { const float* m = nmod + (size_t)mod_row(r) * NMODC + qshift * 1024;
#pragma unroll
            for (int j = 0; j < 4; ++j) { shv[j] = *((const f32x4*)m + lane + 64 * j); scv[j] = *((const f32x4*)(m + 1024) + lane + 64 * j); } }
        {
            float s = 0.f;
#pragma unroll
            for (int j = 0; j < 4; ++j) s += (v[j][0] + v[j][1]) + (v[j][2] + v[j][3]);
            const float mean = wave_sum(s) * (1.f / D); float s2 = 0.f;
#pragma unroll
            for (int j = 0; j < 4; ++j) { v[j] = v[j] - mean; s2 += (v[j][0] * v[j][0] + v[j][1] * v[j][1]) + (v[j][2] * v[j][2] + v[j][3] * v[j][3]); }
            const float rstd = 1.0f / sqrtf(wave_sum(s2) * (1.f / D) + LN_EPS);
#pragma unroll
            for (int j = 0; j < 4; ++j) v[j] = v[j] * rstd * gg[j] + bb[j];
        }
        if (outp) {
#pragma unroll
            for (int j = 0; j < 4; ++j) *((f32x4*)(outp + (size_t)r * D) + lane + 64 * j) = v[j];
        } else {
#pragma unroll
            for (int j = 0; j < 4; ++j) *((f32x4*)row + lane + 64 * j) = v[j];
#pragma unroll
            for (int j = 0; j < 4; ++j) { const f32x4 o = v[j] * (scv[j] + 1.0f) + shv[j]; u32x2 w; w.x = cvt_pk_bf16(o[0], o[1]); w.y = cvt_pk_bf16(o[2], o[3]);
                *((u32x2*)(hb + (size_t)r * D) + lane + 64 * j) = w; }
        }
    }
}

__device__ __forceinline__ void phase_attention(const PV& P, LAS unsigned char* lds, int j_attn, float lam_init, bool ctx_q) {
    const int tid = P.tid, lane = tid & 63, wave = __builtin_amdgcn_readfirstlane(tid >> 6), g = lane >> 4, q16 = lane & 15;
    const bf16_t* qk = (const bf16_t*)(P.ws() + OFF_QK); const bf16_t* vt = (const bf16_t*)(P.ws() + OFF_VT); bf16_t* ao = (bf16_t*)(P.ws() + OFF_AO);
    const float* lam = P.in(12) + j_attn * 256; const float* subg = P.in(13) + j_attn * 128;
    const float lam_full = expf(wave_sum(lam[lane] * lam[64 + lane])) - expf(wave_sum(lam[128 + lane] * lam[192 + lane])) + lam_init;
    constexpr int KROW = 272, VROW = 144;
    constexpr int ABUF = 64 * KROW + 128 * VROW;
    const float sc = 0.125f * 1.4426950408889634f;
    const int NU = 1024 + (ctx_q ? 128 : 0);
    for (int uidx = P.bid; uidx < NU; uidx += P.gsz) {
        int b, h, qrow0, ntiles;
        if (uidx < 1024) { b = uidx >> 7; h = (uidx >> 4) & 7; qrow0 = b * SEQ + (uidx & 15) * 128; ntiles = 36; }
        else { const int u2 = uidx - 1024; b = u2 >> 4; h = (u2 >> 1) & 7; qrow0 = TL + b * CTXL + (u2 & 1) * 128; ntiles = 4; }
        bf16x8 qf[2][2];
        { const bf16_t* qp = qk + (size_t)(qrow0 + wave * 16 + q16) * 2048 + h * 128 + 8 * g;
#pragma unroll
          for (int mp = 0; mp < 2; ++mp)
#pragma unroll
              for (int kk = 0; kk < 2; ++kk) { const u32x4 qw = *(const u32x4*)(qp + mp * 64 + kk * 32); u32x4 qs;
#pragma unroll
                  for (int e = 0; e < 4; ++e) qs[e] = cvt_pk_bf16_m(bflo(qw[e]) * sc, bfhi(qw[e]) * sc);
                  qf[mp][kk] = __builtin_bit_cast(bf16x8, qs); } }
        f32x4 accO[2][8];
#pragma unroll
        for (int mp = 0; mp < 2; ++mp)
#pragma unroll
            for (int nt = 0; nt < 8; ++nt) accO[mp][nt] = (f32x4){0.f, 0.f, 0.f, 0.f};
        float mrun[2] = {-INFINITY, -INFINITY}, lrun[2] = {0.f, 0.f};
        u32x4 stg[4];
        auto tile_tok = [&](int i) { return i < 4 ? TL + b * CTXL + 64 * i : b * SEQ + 64 * (i - 4); };
#define ATT_LOAD(i) do { const int tok = tile_tok(i); \
            _Pragma("unroll") for (int c2 = 0; c2 < 2; ++c2) { const int c = tid + 512 * c2; \
                stg[c2] = *(const u32x4*)(qk + (size_t)(tok + (c >> 4)) * 2048 + 1024 + h * 128 + (c & 15) * 8); \
                stg[2 + c2] = *(const u32x4*)(vt + (size_t)(h * 128 + (c >> 3)) * TA + tok + (c & 7) * 8); } } while (0)
#define ATT_STORE(bi) do { LAS unsigned char* Kw = lds + (bi) * ABUF; LAS unsigned char* Vw = Kw + 64 * KROW; \
            _Pragma("unroll") for (int c2 = 0; c2 < 2; ++c2) { const int c = tid + 512 * c2; \
                *(LAS u32x4*)(Kw + (c >> 4) * KROW + (c & 15) * 16) = stg[c2]; \
                *(LAS u32x4*)(Vw + (c >> 3) * VROW + (c & 7) * 16) = stg[2 + c2]; } } while (0)
        ATT_LOAD(0);
        ATT_STORE(0);
        __syncthreads();
        for (int it = 0; it < ntiles; ++it) {
            const LAS unsigned char* Kl = lds + (it & 1) * ABUF; const LAS unsigned char* Vl = Kl + 64 * KROW;
            if (it + 1 < ntiles) ATT_LOAD(it + 1);
            bf16x8 pf[2][2];
            const LAS unsigned char* kbase = Kl + (8 * (q16 >> 2) + (q16 & 3)) * KROW + 16 * g;
#define ATT_KF(mp, kt, kk) (*(const LAS bf16x8*)(kbase + (32 * ((kt) >> 1) + 4 * ((kt) & 1)) * KROW + (mp) * 128 + (kk) * 64))
            bf16x8 kf[2][8];
#pragma unroll
            for (int f = 0; f < 8; ++f) kf[0][f] = ATT_KF(0, f >> 1, f & 1);
#pragma unroll
            for (int mp = 0; mp < 2; ++mp) {
                f32x4 s[4];
                if (mp == 0) {
#pragma unroll
                    for (int f = 0; f < 8; ++f) kf[1][f] = ATT_KF(1, f >> 1, f & 1);
                    __builtin_amdgcn_sched_barrier(0);
                }
#pragma unroll
                for (int kk = 0; kk < 2; ++kk)
#pragma unroll
                    for (int kt = 0; kt < 4; ++kt) {
                        if (kk == 0) s[kt] = (f32x4){0.f, 0.f, 0.f, 0.f};
                        s[kt] = __builtin_amdgcn_mfma_f32_16x16x32_bf16(kf[mp][2 * kt + kk], qf[mp][kk], s[kt], 0, 0, 0);
                    }
                float mx = -INFINITY;
#pragma unroll
                for (int kt = 0; kt < 4; ++kt) mx = fmaxf(mx, fmaxf(fmaxf(s[kt][0], s[kt][1]), fmaxf(s[kt][2], s[kt][3])));
                mx = xmax32(xmax16(mx));
                const float mnew = fmaxf(mrun[mp], mx);
                const float alpha = __builtin_amdgcn_exp2f(mrun[mp] - mnew);
                mrun[mp] = mnew;
                float ps = 0.f;
#pragma unroll
                for (int kt = 0; kt < 4; ++kt) {
#pragma unroll
                    for (int j = 0; j < 4; ++j) { const float p = __builtin_amdgcn_exp2f(s[kt][j] - mnew); s[kt][j] = p; ps += p; }
                }
                lrun[mp] = lrun[mp] * alpha + ps;
                if (__any(alpha != 1.0f)) {
#pragma unroll
                    for (int nt = 0; nt < 8; ++nt) accO[mp][nt] = accO[mp][nt] * alpha;
                }
#pragma unroll
                for (int kb = 0; kb < 2; ++kb) {
                    u32x4 w;
                    w.x = cvt_pk_bf16_m(s[2 * kb][0], s[2 * kb][1]); w.y = cvt_pk_bf16_m(s[2 * kb][2], s[2 * kb][3]);
                    w.z = cvt_pk_bf16_m(s[2 * kb + 1][0], s[2 * kb + 1][1]); w.w = cvt_pk_bf16_m(s[2 * kb + 1][2], s[2 * kb + 1][3]);
                    pf[mp][kb] = __builtin_bit_cast(bf16x8, w);
                }
            }
            {
                const LAS unsigned char* vbase = Vl + q16 * VROW + 16 * g;
#define ATT_VF(f) (*(const LAS bf16x8*)(vbase + ((f) >> 1) * 16 * VROW + ((f) & 1) * 64))
                bf16x8 va[4], vn[4];
#pragma unroll
                for (int f = 0; f < 4; ++f) va[f] = ATT_VF(f);
#pragma unroll
                for (int grp = 0; grp < 4; ++grp) {
                    if (grp < 3) {
#pragma unroll
                        for (int f = 0; f < 4; ++f) vn[f] = ATT_VF(4 * (grp + 1) + f);
                    }
                    __builtin_amdgcn_sched_barrier(0);
#pragma unroll
                    for (int f = 0; f < 4; ++f) { const int nt = 2 * grp + (f >> 1), kb = f & 1;
                        accO[0][nt] = __builtin_amdgcn_mfma_f32_16x16x32_bf16(va[f], pf[0][kb], accO[0][nt], 0, 0, 0);
                        accO[1][nt] = __builtin_amdgcn_mfma_f32_16x16x32_bf16(va[f], pf[1][kb], accO[1][nt], 0, 0, 0); }
#pragma unroll
                    for (int f = 0; f < 4; ++f) va[f] = vn[f];
                }
#undef ATT_VF
            }
#undef ATT_KF
            if (it + 1 < ntiles) ATT_STORE((it + 1) & 1);
            __syncthreads();
        }
#undef ATT_LOAD
#undef ATT_STORE
        float l0 = lrun[0]; l0 += __shfl_xor(l0, 16); l0 += __shfl_xor(l0, 32);
        float l1 = lrun[1]; l1 += __shfl_xor(l1, 16); l1 += __shfl_xor(l1, 32);
        const float i0 = 1.0f / l0, i1 = lam_full / l1;
        float ss = 0.f;
#pragma unroll
        for (int nt = 0; nt < 8; ++nt) { accO[0][nt] = accO[0][nt] * i0 - accO[1][nt] * i1;
            ss += (accO[0][nt][0] * accO[0][nt][0] + accO[0][nt][1] * accO[0][nt][1]) + (accO[0][nt][2] * accO[0][nt][2] + accO[0][nt][3] * accO[0][nt][3]); }
        ss += __shfl_xor(ss, 16); ss += __shfl_xor(ss, 32);
        const float rs = (1.0f / sqrtf(ss * (1.0f / 128.0f) + LN_EPS)) * (1.0f - lam_init);
        bf16_t* op = ao + (size_t)(qrow0 + wave * 16 + q16) * D + h * 128 + 4 * g;
#pragma unroll
        for (int nt = 0; nt < 8; ++nt) { const f32x4 gg = *(const f32x4*)(subg + 16 * nt + 4 * g); const f32x4 o = accO[0][nt] * rs * gg;
            u32x2 w; w.x = cvt_pk_bf16(o[0], o[1]); w.y = cvt_pk_bf16(o[2], o[3]); *(u32x2*)(op + 16 * nt) = w; }
    }
}

__device__ __forceinline__ void phase_hy_short(const PV& P, LAS unsigned char* lds) {
    const bf16_t* hu = (const bf16_t*)(P.ws() + OFF_HU); float* x0o = (float*)(P.ws() + OFF_HX0); bf16_t* vT = (bf16_t*)(P.ws() + OFF_HVT);
    const float* cw = P.in(16); const float* cb = P.in(17);
    const int tid = P.tid;
    constexpr int RS = 264;
    const bool hoist = (P.gsz & 7) == 0;
    f32x4 hw0[3], hw1[3], hw2[3], hbb[3];
    { const int dq0 = 128 * (P.bid & 7) + 4 * (tid & 31);
#pragma unroll
      for (int part = 0; part < 3; ++part) { const int c = part * 1024 + dq0;
          hw0[part] = *(const f32x4*)(cw + c); hw1[part] = *(const f32x4*)(cw + 3072 + c); hw2[part] = *(const f32x4*)(cw + 6144 + c); hbb[part] = *(const f32x4*)(cb + c); } }
    for (int uidx = P.bid; uidx < 8 * 36 * 8; uidx += P.gsz) {
        const int db = uidx & 7, sb = (uidx >> 3) % 36, b = uidx / 288;
        const bool isl = sb < 32; const int L = isl ? SEQ : CTXL, t0 = isl ? 64 * sb : 64 * (sb - 32), rbase = isl ? b * SEQ : TL + b * CTXL, toff = isl ? 0 : SEQ;
#pragma unroll
        for (int k = 0; k < 4; ++k) {
            const int idx = tid + 512 * k, tl = idx >> 5, d4 = idx & 31, t = t0 + tl, r = rbase + t, dq = 128 * db + 4 * d4;
            const bool hp = t > 0, hn = t < L - 1;
            float res[3][4];
#pragma unroll
            for (int part = 0; part < 3; ++part) {
                const int c = part * 1024 + dq;
                const u32x2 z2 = (u32x2){0u, 0u};
                const u32x2 um = hp ? *(const u32x2*)(hu + (size_t)(r - 1) * 3072 + c) : z2;
                const u32x2 u0 = *(const u32x2*)(hu + (size_t)r * 3072 + c);
                const u32x2 up = hn ? *(const u32x2*)(hu + (size_t)(r + 1) * 3072 + c) : z2;
                f32x4 w0 = hw0[part], w1 = hw1[part], w2 = hw2[part], bb = hbb[part];
                if (!hoist) { w0 = *(const f32x4*)(cw + c); w1 = *(const f32x4*)(cw + 3072 + c); w2 = *(const f32x4*)(cw + 6144 + c); bb = *(const f32x4*)(cb + c); }
                res[part][0] = bb[0] + bflo(um.x) * w0[0] + bflo(u0.x) * w1[0] + bflo(up.x) * w2[0];
                res[part][1] = bb[1] + bfhi(um.x) * w0[1] + bfhi(u0.x) * w1[1] + bfhi(up.x) * w2[1];
                res[part][2] = bb[2] + bflo(um.y) * w0[2] + bflo(u0.y) * w1[2] + bflo(up.y) * w2[2];
                res[part][3] = bb[3] + bfhi(um.y) * w0[3] + bfhi(u0.y) * w1[3] + bfhi(up.y) * w2[3];
            }
            *(f32x4*)(x0o + (size_t)r * D + dq) = (f32x4){res[0][0], res[0][1], res[0][2], res[0][3]};
            u32x2 w; w.x = cvt_pk_bf16(res[2][0] * res[1][0], res[2][1] * res[1][1]); w.y = cvt_pk_bf16(res[2][2] * res[1][2], res[2][3] * res[1][3]);
            *(LAS u32x2*)(lds + tl * RS + d4 * 8) = w;
        }
        __syncthreads();
#pragma unroll
        for (int k = 0; k < 2; ++k) {
            const int idx = tid + 512 * k, tk = idx & 7, dl = idx >> 3;
            unsigned e[8];
#pragma unroll
            for (int j = 0; j < 8; ++j) e[j] = *(const LAS bf16_t*)(lds + (8 * tk + j) * RS + dl * 2);
            u32x4 w; w.x = e[0] | (e[1] << 16); w.y = e[2] | (e[3] << 16); w.z = e[4] | (e[5] << 16); w.w = e[6] | (e[7] << 16);
            *(u32x4*)(vT + ((size_t)(128 * db + dl) * NB + b) * HLT + toff + t0 + 8 * tk) = w;
        }
        __syncthreads();
    }
}

__device__ __forceinline__ void phase_hy_conv(const PV& P, LAS unsigned char* lds) {
    const bf16_t* vT = (const bf16_t*)(P.ws() + OFF_HVT); bf16_t* yT = (bf16_t*)(P.ws() + OFF_HYT);
    const int tid = P.tid, lane = tid & 63, wave = __builtin_amdgcn_readfirstlane(tid >> 6), g = lane >> 4, q16 = lane & 15;
    constexpr int R0_OFF = 0, R1_OFF = 8208, VT_OFF = 16416, VRS = 4112;
    for (int uidx = P.bid; uidx < 2048; uidx += P.gsz) {
        const bool isl = uidx < 1024; const int d = uidx & 1023;
        const int L = isl ? SEQ : CTXL, RL = isl ? 4096 : 512, toff = isl ? 0 : SEQ;
        const bf16_t* rsrc = isl ? (const bf16_t*)(P.ws() + OFF_KLAT) + (size_t)d * 4096 : (const bf16_t*)(P.ws() + OFF_KCTX) + (size_t)d * 512;
        for (int i = tid; i < RL / 8; i += 512) *(LAS u32x4*)(lds + R0_OFF + i * 16) = *(const u32x4*)(rsrc + 8 * i);
        for (int i = tid; i < L; i += 512) { const int bb = i / (L / 8), c = i % (L / 8);
            *(LAS u32x4*)(lds + VT_OFF + bb * VRS + c * 16) = *(const u32x4*)(vT + ((size_t)d * NB + bb) * HLT + toff + 8 * c); }
        __syncthreads();
        for (int k = tid; k < RL / 2; k += 512) {
            const unsigned hi = *(const LAS unsigned*)(lds + R0_OFF + 4 * k), lo = k > 0 ? *(const LAS unsigned*)(lds + R0_OFF + 4 * k - 4) : 0u;
            *(LAS unsigned*)(lds + R1_OFF + 4 * k) = __builtin_amdgcn_alignbit(hi, lo, 16);
        }
        __syncthreads();
        const int ntile = L / 16, nsb = L / 32, C = L - 1;
        const int tau0 = (wave & 1) + 32 * (wave >> 1);
        if (tau0 < ntile) {
            const int base0 = C - 16 * tau0 - q16 + 8 * g;
            const int sel = (q16 & 1) ? R0_OFF : (R1_OFF + 2);
#define HC_FRAG(dst, f) do { int eb = base0 - 32 * (f); eb = eb < 0 ? (eb & 1) : eb; const LAS unsigned* p_ = (const LAS unsigned*)(lds + sel + eb * 2); \
            u32x4 w_; w_.x = p_[0]; w_.y = p_[1]; w_.z = p_[2]; w_.w = p_[3]; dst = __builtin_bit_cast(bf16x8, w_); } while (0)
            f32x4 acc[16]; bf16x8 fr[16];
#pragma unroll
            for (int i = 0; i < 16; ++i) acc[i] = (f32x4){0.f, 0.f, 0.f, 0.f};
#pragma unroll
            for (int i = 1; i < 16; ++i) HC_FRAG(fr[i], i);
            const LAS unsigned char* vrow = lds + VT_OFF + (q16 & 7) * VRS + 16 * g;
            for (int sb0 = 0; sb0 < nsb; sb0 += 16) {
#pragma unroll
                for (int u = 0; u < 16; ++u) {
                    const int sbk = sb0 + u;
                    if (sbk < nsb) {
                        HC_FRAG(fr[(16 - u) & 15], -sbk);
                        const bf16x8 bv = *(const LAS bf16x8*)(vrow + sbk * 64);
#pragma unroll
                        for (int i = 0; i < 16; ++i) acc[i] = __builtin_amdgcn_mfma_f32_16x16x32_bf16(fr[(i - u) & 15], bv, acc[i], 0, 0, 0);
                    }
                }
            }
#undef HC_FRAG
            if (q16 < 8) {
                bf16_t* yp = yT + ((size_t)d * NB + q16) * HLT + toff + 4 * g;
#pragma unroll
                for (int i = 0; i < 16; ++i) { const int tau = tau0 + 2 * i;
                    if (tau < ntile) { u32x2 w; w.x = cvt_pk_bf16(acc[i][0], acc[i][1]); w.y = cvt_pk_bf16(acc[i][2], acc[i][3]); *(u32x2*)(yp + 16 * tau) = w; } }
            }
        }
        __syncthreads();
    }
}

__device__ __forceinline__ void phase_hy_gate(const PV& P, LAS unsigned char* lds) {
    const bf16_t* yT = (const bf16_t*)(P.ws() + OFF_HYT); const float* x0 = (const float*)(P.ws() + OFF_HX0); bf16_t* gout = (bf16_t*)(P.ws() + OFF_HG);
    const int tid = P.tid;
    constexpr int RS = 264;
    for (int uidx = P.bid; uidx < 8 * 36 * 8; uidx += P.gsz) {
        const int db = uidx & 7, sb = (uidx >> 3) % 36, b = uidx / 288;
        const bool isl = sb < 32; const int t0 = isl ? 64 * sb : 64 * (sb - 32), rbase = isl ? b * SEQ : TL + b * CTXL, toff = isl ? 0 : SEQ;
        f32x4 xq[4];
#pragma unroll
        for (int k = 0; k < 4; ++k) { const int idx = tid + 512 * k, tl = idx >> 5, d4 = idx & 31; xq[k] = *(const f32x4*)(x0 + (size_t)(rbase + t0 + tl) * D + 128 * db + 4 * d4); }
#pragma unroll
        for (int k = 0; k < 2; ++k) {
            const int idx = tid + 512 * k, tk = idx & 7, dl = idx >> 3;
            const u32x4 w = *(const u32x4*)(yT + ((size_t)(128 * db + dl) * NB + b) * HLT + toff + t0 + 8 * tk);
#pragma unroll
            for (int j = 0; j < 4; ++j) { *(LAS bf16_t*)(lds + (8 * tk + 2 * j) * RS + dl * 2) = (bf16_t)(w[j] & 0xffffu); *(LAS bf16_t*)(lds + (8 * tk + 2 * j + 1) * RS + dl * 2) = (bf16_t)(w[j] >> 16); }
        }
        __syncthreads();
#pragma unroll
        for (int k = 0; k < 4; ++k) {
            const int idx = tid + 512 * k, tl = idx >> 5, d4 = idx & 31, r = rbase + t0 + tl, dq = 128 * db + 4 * d4;
            const u32x2 yv = *(const LAS u32x2*)(lds + tl * RS + d4 * 8);
            const f32x4 xv = xq[k];
            u32x2 w; w.x = cvt_pk_bf16(bflo(yv.x) * xv[0], bfhi(yv.x) * xv[1]); w.y = cvt_pk_bf16(bflo(yv.y) * xv[2], bfhi(yv.y) * xv[3]);
            *(u32x2*)(gout + (size_t)r * D + dq) = w;
        }
        __syncthreads();
    }
}

__device__ __forceinline__ float softplus_f(float x) { return x > 20.f ? x : log1pf(expf(x)); }
__device__ __forceinline__ void phase_ssm_scan(const PV& P, LAS unsigned char* lds) {
    const bf16_t* zx = (const bf16_t*)(P.ws() + OFF_ZX); float* Y = (float*)(P.ws() + OFF_Y); const bf16_t* bcact = (const bf16_t*)(P.ws() + OFF_HB);
    const float* cw = P.in(27); const float* cb = P.in(28); const float* dtb = P.in(29); const float* alog = P.in(30); const float* dsk = P.in(31);
    const int tid = P.tid, lane = tid & 63, wave = __builtin_amdgcn_readfirstlane(tid >> 6), g = lane >> 4, q16 = lane & 15;
    constexpr int RS = 272;
    LAS unsigned char* BS = lds;
    LAS unsigned char* CS = lds + 128 * RS;
    LAS unsigned char* BT = lds + 256 * RS;
    LAS unsigned char* XT = lds + 384 * RS;
    LAS unsigned char* ST = lds + 448 * RS;
    LAS float* csf = (LAS float*)(lds + 512 * RS);
    LAS float* dtf = csf + 128;
    LAS float* WX = (LAS float*)(lds + 512 * RS + 1024);
    for (int uidx = P.bid; uidx < 256; uidx += P.gsz) {
        const int b = uidx >> 5, h = uidx & 31, grp = h >> 3;
        const float Dh = dsk[h];
        __syncthreads();
        if (tid < 256) { const int tap = tid >> 6, cx = tid & 63; WX[tid] = tap < 3 ? cw[tap * 3072 + h * 64 + cx] : cb[h * 64 + cx]; }
        __syncthreads();
        for (int dir = 0; dir < 2; ++dir) {
            const float av = -expf(alog[dir * 32 + h]), dtbias = dtb[dir * 32 + h];
            f32x4 st[4];
#pragma unroll
            for (int i = 0; i < 4; ++i) st[i] = (f32x4){0.f, 0.f, 0.f, 0.f};
            u32x4 rawX[2][3], rawC[8]; float dtr0 = 0.f, dtr1 = 0.f;
#define SC_GEO(cx, ccx, Lx, basex) const int ccx = (cx) < 2 ? (cx) : (cx) - 2, Lx = (cx) < 2 ? CTXL : SEQ, basex = (cx) < 2 ? TL + b * CTXL : b * SEQ
#define SC_ROWX(l, ccx, Lx) (dir == 0 ? 128 * (ccx) + (l) : (Lx) - 1 - 128 * (ccx) - (l))
#define SC_FETCH(ccx, Lx, basex) do { \
            _Pragma("unroll") for (int k = 0; k < 2; ++k) { const int it = tid + 512 * k; const int l = it & 127, gi = __builtin_amdgcn_readfirstlane(it >> 7); \
                const int t = SC_ROWX(l, ccx, Lx); const u32x4 z4 = (u32x4){0u, 0u, 0u, 0u}; \
                const bf16_t* bp = zx + (size_t)((basex) + t) * SSM_IN + 2048 + h * 64 + 8 * gi; \
                rawX[k][0] = t > 0 ? *(const u32x4*)(bp - SSM_IN) : z4; rawX[k][1] = *(const u32x4*)bp; rawX[k][2] = t < (Lx) - 1 ? *(const u32x4*)(bp + SSM_IN) : z4; } \
            _Pragma("unroll") for (int k = 2; k < 10; ++k) { const int it = tid + 512 * k; const int l = it & 127, gi = __builtin_amdgcn_readfirstlane(it >> 7); \
                const int t = SC_ROWX(l, ccx, Lx); \
                const int bcol = gi < 24 ? grp * 128 + 8 * (gi - 8) : 512 + grp * 128 + 8 * (gi - 24); \
                rawC[k - 2] = *(const u32x4*)(bcact + (size_t)((basex) + t) * 1024 + bcol); } } while (0)
#define SC_FETCH_DT(ccx, Lx, basex) do { if (wave < 2) { \
                dtr0 = bf2f(zx[(size_t)((basex) + SC_ROWX(64 * wave + lane, ccx, Lx)) * SSM_IN + 5120 + dir * 32 + h]); \
                if (wave == 1) dtr1 = bf2f(zx[(size_t)((basex) + SC_ROWX(lane, ccx, Lx)) * SSM_IN + 5120 + dir * 32 + h]); } } while (0)
#define SC_STAGE() do { \
            _Pragma("unroll") for (int k = 0; k < 2; ++k) { const int it = tid + 512 * k; const int l = it & 127, gi = __builtin_amdgcn_readfirstlane(it >> 7); \
                float o[8]; \
                _Pragma("unroll") for (int e2 = 0; e2 < 4; ++e2) { \
                    const unsigned wm = rawX[k][0][e2], w0 = rawX[k][1][e2], wp = rawX[k][2][e2]; \
                    const f32x2 c0 = *(const LAS f32x2*)(WX + 8 * gi + 2 * e2), c1 = *(const LAS f32x2*)(WX + 64 + 8 * gi + 2 * e2), c2 = *(const LAS f32x2*)(WX + 128 + 8 * gi + 2 * e2), cbv = *(const LAS f32x2*)(WX + 192 + 8 * gi + 2 * e2); \
                    o[2 * e2] = silu_f(cbv[0] + bflo(wm) * c0[0] + bflo(w0) * c1[0] + bflo(wp) * c2[0]); \
                    o[2 * e2 + 1] = silu_f(cbv[1] + bfhi(wm) * c0[1] + bfhi(w0) * c1[1] + bfhi(wp) * c2[1]); } \
                const float dtl = dtf[l]; \
                _Pragma("unroll") for (int e = 0; e < 8; ++e) *(LAS bf16_t*)(XT + (8 * gi + e) * RS + l * 2) = (bf16_t)(cvt_pk_bf16(o[e] * dtl, 0.f) & 0xffffu); \
                if (dir == 0) { float* yq = Y + (size_t)(base + SC_ROW(l)) * 2048 + h * 64 + 8 * gi; \
                    *(f32x4*)yq = (f32x4){o[0] * Dh, o[1] * Dh, o[2] * Dh, o[3] * Dh}; *(f32x4*)(yq + 4) = (f32x4){o[4] * Dh, o[5] * Dh, o[6] * Dh, o[7] * Dh}; } } \
            _Pragma("unroll") for (int k = 2; k < 10; ++k) { const int it = tid + 512 * k; const int l = it & 127, gi = __builtin_amdgcn_readfirstlane(it >> 7); \
                const u32x4 w = rawC[k - 2]; \
                if (gi < 24) { \
                    const int n0 = 8 * (gi - 8); \
                    *(LAS u32x4*)(BS + l * RS + n0 * 2) = w; \
                    const float dec = __expf(cs127 - csf[l]); \
                    _Pragma("unroll") for (int e2 = 0; e2 < 4; ++e2) { \
                        *(LAS bf16_t*)(BT + (n0 + 2 * e2) * RS + l * 2) = (bf16_t)(cvt_pk_bf16(bflo(w[e2]) * dec, 0.f) & 0xffffu); \
                        *(LAS bf16_t*)(BT + (n0 + 2 * e2 + 1) * RS + l * 2) = (bf16_t)(cvt_pk_bf16(bfhi(w[e2]) * dec, 0.f) & 0xffffu); } \
                } else { \
                    *(LAS u32x4*)(CS + l * RS + 8 * (gi - 24) * 2) = w; \
                } } } while (0)
            { SC_GEO(0, cc0, L0, base0); SC_FETCH(cc0, L0, base0); SC_FETCH_DT(cc0, L0, base0); }
#pragma unroll 1
            for (int c = 0; c < 18; ++c) {
                SC_GEO(c, cc, L, base);
#define SC_ROW(l) SC_ROWX(l, cc, L)
                if (wave < 2) {
                    const int l = 64 * wave + lane;
                    const float dtv = softplus_f(dtr0 + dtbias);
                    float x = av * dtv;
#pragma unroll
                    for (int o = 1; o < 64; o <<= 1) { const float y = __shfl_up(x, o); if (lane >= o) x += y; }
                    if (wave == 1) { const float d0 = softplus_f(dtr1 + dtbias); x += wave_sum(av * d0); }
                    csf[l] = x; dtf[l] = dtv;
                }
                __syncthreads();
                const float cs127 = csf[127];
                SC_STAGE();
                asm volatile("s_waitcnt vmcnt(0)" ::: "memory");
                __syncthreads();
                if (c + 1 < 18) { SC_GEO(c + 1, ccn, Ln, basen); SC_FETCH(ccn, Ln, basen); SC_FETCH_DT(ccn, Ln, basen); }
                {
                    const int l = 16 * wave + q16;
                    const float csl = csf[l];
                    float* yp = Y + (size_t)(base + SC_ROW(l)) * 2048 + h * 64 + 4 * g;
                    f32x4 yold[4];
#pragma unroll
                    for (int pt = 0; pt < 4; ++pt) yold[pt] = (f32x4){0.f, 0.f, 0.f, 0.f};
                    if (dir == 1) {
#pragma unroll
                        for (int pt = 0; pt < 4; ++pt) yold[pt] = *(const f32x4*)(yp + 16 * pt);
                    }
                    bf16x8 cfrag[4];
#pragma unroll
                    for (int kk = 0; kk < 4; ++kk) cfrag[kk] = *(const LAS bf16x8*)(CS + l * RS + (8 * g + 32 * kk) * 2);
                    f32x4 acc[4];
#pragma unroll
                    for (int pt = 0; pt < 4; ++pt) acc[pt] = (f32x4){0.f, 0.f, 0.f, 0.f};
                    if (c > 0) {
                        const LAS unsigned char* sbase = ST + q16 * RS + 16 * g;
                        bf16x8 sa[4], sn[4];
#pragma unroll
                        for (int kk = 0; kk < 4; ++kk) sa[kk] = *(const LAS bf16x8*)(sbase + 64 * kk);
#pragma unroll
                        for (int pt = 0; pt < 4; ++pt) {
                            if (pt < 3) {
#pragma unroll
                                for (int kk = 0; kk < 4; ++kk) sn[kk] = *(const LAS bf16x8*)(sbase + (16 * (pt + 1)) * RS + 64 * kk);
                            }
                            __builtin_amdgcn_sched_barrier(0);
#pragma unroll
                            for (int kk = 0; kk < 4; ++kk) acc[pt] = __builtin_amdgcn_mfma_f32_16x16x32_bf16(sa[kk], cfrag[kk], acc[pt], 0, 0, 0);
#pragma unroll
                            for (int kk = 0; kk < 4; ++kk) sa[kk] = sn[kk];
                        }
                        const float el = __expf(csl);
#pragma unroll
                        for (int pt = 0; pt < 4; ++pt) acc[pt] = acc[pt] * el;
                    }
                    const int nblk = (wave >> 1) + 1;
                    for (int sb = 0; sb < nblk; ++sb) {
                        f32x4 gt[2];
                        bf16x8 bfr8[8], xfr[4];
#pragma unroll
                        for (int f = 0; f < 8; ++f) { const int kt = f >> 2, kk = f & 3; const int srow = 32 * sb + 8 * (q16 >> 2) + 4 * kt + (q16 & 3);
                            bfr8[f] = *(const LAS bf16x8*)(BS + srow * RS + (8 * g + 32 * kk) * 2); }
#pragma unroll
                        for (int pt = 0; pt < 4; ++pt) xfr[pt] = *(const LAS bf16x8*)(XT + (16 * pt + q16) * RS + (32 * sb + 8 * g) * 2);
                        __builtin_amdgcn_sched_barrier(0);
#pragma unroll
                        for (int kt = 0; kt < 2; ++kt) {
                            gt[kt] = (f32x4){0.f, 0.f, 0.f, 0.f};
#pragma unroll
                            for (int kk = 0; kk < 4; ++kk) gt[kt] = __builtin_amdgcn_mfma_f32_16x16x32_bf16(bfr8[4 * kt + kk], cfrag[kk], gt[kt], 0, 0, 0);
                        }
                        const f32x4 cs0 = *(const LAS f32x4*)(csf + 32 * sb + 8 * g), cs1 = *(const LAS f32x4*)(csf + 32 * sb + 8 * g + 4);
                        float mm[8];
#pragma unroll
                        for (int j = 0; j < 4; ++j) {
                            const int s0 = 32 * sb + 8 * g + j, s1 = s0 + 4;
                            mm[j] = (s0 <= l) ? gt[0][j] * __expf(fminf(csl - cs0[j], 0.f)) : 0.f;
                            mm[4 + j] = (s1 <= l) ? gt[1][j] * __expf(fminf(csl - cs1[j], 0.f)) : 0.f;
                        }
                        u32x4 w; w.x = cvt_pk_bf16_m(mm[0], mm[1]); w.y = cvt_pk_bf16_m(mm[2], mm[3]); w.z = cvt_pk_bf16_m(mm[4], mm[5]); w.w = cvt_pk_bf16_m(mm[6], mm[7]);
                        const bf16x8 pm = __builtin_bit_cast(bf16x8, w);
#pragma unroll
                        for (int pt = 0; pt < 4; ++pt) acc[pt] = __builtin_amdgcn_mfma_f32_16x16x32_bf16(xfr[pt], pm, acc[pt], 0, 0, 0);
                    }
#pragma unroll
                    for (int pt = 0; pt < 4; ++pt) { if (dir == 0) yold[pt] = *(const f32x4*)(yp + 16 * pt); *(f32x4*)(yp + 16 * pt) = yold[pt] + acc[pt]; }
                }
                asm volatile("s_waitcnt vmcnt(0)" ::: "memory");
                __syncthreads();
                {
                    const float ec = __expf(cs127);
#pragma unroll
                    for (int pt = 0; pt < 4; ++pt) st[pt] = st[pt] * ec;
                    {
                        bf16x8 btf[4], xa[4], xn[4];
#pragma unroll
                        for (int kk = 0; kk < 4; ++kk) btf[kk] = *(const LAS bf16x8*)(BT + (16 * wave + q16) * RS + (8 * g + 32 * kk) * 2);
#pragma unroll
                        for (int pt = 0; pt < 4; ++pt) xa[pt] = *(const LAS bf16x8*)(XT + (16 * pt + q16) * RS + (8 * g) * 2);
#pragma unroll
                        for (int kk = 0; kk < 4; ++kk) {
                            if (kk < 3) {
#pragma unroll
                                for (int pt = 0; pt < 4; ++pt) xn[pt] = *(const LAS bf16x8*)(XT + (16 * pt + q16) * RS + (8 * g + 32 * (kk + 1)) * 2);
                            }
                            __builtin_amdgcn_sched_barrier(0);
#pragma unroll
                            for (int pt = 0; pt < 4; ++pt) st[pt] = __builtin_amdgcn_mfma_f32_16x16x32_bf16(xa[pt], btf[kk], st[pt], 0, 0, 0);
#pragma unroll
                            for (int pt = 0; pt < 4; ++pt) xa[pt] = xn[pt];
                        }
                    }
#pragma unroll
                    for (int pt = 0; pt < 4; ++pt)
#pragma unroll
                        for (int j = 0; j < 4; ++j) *(LAS bf16_t*)(ST + (16 * pt + 4 * g + j) * RS + (16 * wave + q16) * 2) = (bf16_t)(cvt_pk_bf16(st[pt][j], 0.f) & 0xffffu);
                }
                __syncthreads();
#undef SC_ROW
            }
#undef SC_GEO
#undef SC_ROWX
#undef SC_FETCH
#undef SC_FETCH_DT
#undef SC_STAGE
        }
    }
}
__device__ __forceinline__ void phase_ssm_bc(const PV& P) {
    const bf16_t* zx = (const bf16_t*)(P.ws() + OFF_ZX); bf16_t* bc = (bf16_t*)(P.ws() + OFF_HB);
    const float* cw = P.in(27); const float* cb = P.in(28);
    const int tid = P.tid, c8 = (tid & 127) * 8, rsub = tid >> 7;
    f32x4 w0[2], w1[2], w2[2], bb[2];
#pragma unroll
    for (int q = 0; q < 2; ++q) { w0[q] = *(const f32x4*)(cw + 2048 + c8 + 4 * q); w1[q] = *(const f32x4*)(cw + 3072 + 2048 + c8 + 4 * q); w2[q] = *(const f32x4*)(cw + 6144 + 2048 + c8 + 4 * q); bb[q] = *(const f32x4*)(cb + 2048 + c8 + 4 * q); }
    const int rstep = P.gsz * 4;
    u32x4 nm, n0, np;
#define BC_LOAD(rr) do { int t_, L_; if ((rr) < TL) { t_ = (rr) & (SEQ - 1); L_ = SEQ; } else { t_ = ((rr) - TL) & (CTXL - 1); L_ = CTXL; } \
        const bf16_t* bp_ = zx + (size_t)(rr) * SSM_IN + 4096 + c8; const u32x4 z4_ = (u32x4){0u, 0u, 0u, 0u}; \
        nm = t_ > 0 ? *(const u32x4*)(bp_ - SSM_IN) : z4_; n0 = *(const u32x4*)bp_; np = t_ < L_ - 1 ? *(const u32x4*)(bp_ + SSM_IN) : z4_; } while (0)
    if (P.bid * 4 + rsub < TA) BC_LOAD(P.bid * 4 + rsub);
    for (int r = P.bid * 4 + rsub; r < TA; r += rstep) {
        const u32x4 um = nm, u0 = n0, up = np;
        if (r + rstep < TA) BC_LOAD(r + rstep);
        float o[8];
#pragma unroll
        for (int e2 = 0; e2 < 4; ++e2) { const int q = e2 >> 1, k = (e2 & 1) * 2;
            o[2 * e2] = silu_f(bb[q][k] + bflo(um[e2]) * w0[q][k] + bflo(u0[e2]) * w1[q][k] + bflo(up[e2]) * w2[q][k]);
            o[2 * e2 + 1] = silu_f(bb[q][k + 1] + bfhi(um[e2]) * w0[q][k + 1] + bfhi(u0[e2]) * w1[q][k + 1] + bfhi(up[e2]) * w2[q][k + 1]); }
        u32x4 w; w.x = cvt_pk_bf16(o[0], o[1]); w.y = cvt_pk_bf16(o[2], o[3]); w.z = cvt_pk_bf16(o[4], o[5]); w.w = cvt_pk_bf16(o[6], o[7]);
        *(u32x4*)(bc + (size_t)r * 1024 + c8) = w;
    }
#undef BC_LOAD
}
__device__ __forceinline__ void phase_ssm_gate(const PV& P) {
    const bf16_t* zx = (const bf16_t*)(P.ws() + OFF_ZX); float* Y = (float*)(P.ws() + OFF_Y); const float* ng = P.in(32);
    const int lane = P.tid & 63, wave = P.tid >> 6, gw = P.bid * 8 + wave, NGW = P.gsz * 8;
    f32x4 ngv[8];
#pragma unroll
    for (int j = 0; j < 8; ++j) ngv[j] = *((const f32x4*)ng + lane + 64 * j);
    f32x4 ny[8]; u32x2 nz[8];
    if (gw < TA) {
#pragma unroll
        for (int j = 0; j < 8; ++j) { ny[j] = *((const f32x4*)(Y + (size_t)gw * 2048) + lane + 64 * j); nz[j] = *((const u32x2*)(zx + (size_t)gw * SSM_IN) + lane + 64 * j); }
    }
    for (int r = gw; r < TA; r += NGW) {
        float* yrow = Y + (size_t)r * 2048;
        f32x4 v[8], cy[8]; u32x2 cz[8];
#pragma unroll
        for (int j = 0; j < 8; ++j) { cy[j] = ny[j]; cz[j] = nz[j]; }
        if (r + NGW < TA) {
#pragma unroll
            for (int j = 0; j < 8; ++j) { ny[j] = *((const f32x4*)(Y + (size_t)(r + NGW) * 2048) + lane + 64 * j); nz[j] = *((const u32x2*)(zx + (size_t)(r + NGW) * SSM_IN) + lane + 64 * j); }
        }
#pragma unroll
        for (int j = 0; j < 8; ++j) { const f32x4 y = cy[j]; const u32x2 zz = cz[j];
            v[j][0] = y[0] * silu_f(bflo(zz.x)); v[j][1] = y[1] * silu_f(bfhi(zz.x)); v[j][2] = y[2] * silu_f(bflo(zz.y)); v[j][3] = y[3] * silu_f(bfhi(zz.y)); }
        float rs[4];
#pragma unroll
        for (int gq = 0; gq < 4; ++gq) { float s = 0.f;
#pragma unroll
            for (int jj = 0; jj < 2; ++jj) { const f32x4 x = v[2 * gq + jj]; s += (x[0] * x[0] + x[1] * x[1]) + (x[2] * x[2] + x[3] * x[3]); }
            rs[gq] = 1.0f / sqrtf(wave_sum(s) * (1.0f / 512.0f) + LN_EPS); }
        bf16_t* orow = (bf16_t*)yrow;
#pragma unroll
        for (int j = 0; j < 8; ++j) { const f32x4 o = v[j] * rs[j >> 1] * ngv[j];
            u32x2 w; w.x = cvt_pk_bf16(o[0], o[1]); w.y = cvt_pk_bf16(o[2], o[3]); *((u32x2*)orow + lane + 64 * j) = w; }
    }
}


#ifndef REP_ATT
#define REP_ATT 1
#endif
#ifndef REP_HL
#define REP_HL 1
#endif
#ifndef REP_SCAN
#define REP_SCAN 1
#endif
#ifndef REP_FFN1
#define REP_FFN1 1
#endif
#ifndef REP_PRO
#define REP_PRO 1
#endif
#ifndef PROBE_STAGE_MASK
#define PROBE_STAGE_MASK 0
#endif
#ifndef PROBE_KIND_MASK
#define PROBE_KIND_MASK 7
#endif
__global__ void __launch_bounds__(512, 2) fwd_megakernel(Params PK) {
    extern __shared__ __attribute__((aligned(16))) unsigned char shm[];
    LAS unsigned char* lds = (LAS unsigned char*)shm;
    cg::grid_group grid = cg::this_grid();
    bool first = true;
    const int ph_lo = PK.ph_lo, ph_hi = PK.ph_hi;
    volatile LAS unsigned* bst = (volatile LAS unsigned*)(lds + LDS_BYTES - 64);
    if (threadIdx.x < 2) bst[threadIdx.x] = 0u;
    __syncthreads();
    XcdBarrier xbar; xbar.bar = nullptr; xbar.x = 0u; xbar.st = bst;
    int nseam = 0;
    int prep = 0;
    for (int ph = ph_lo; ph < ph_hi; ) {
        int layer = 0, st = -1;
        if (ph >= 2) { layer = (ph - 2) / 12; st = (ph - 2) % 12; }
        const int kind = layer % 3, jm = layer / 3;
        if (ph >= 2 && ((st == 5 || st == 6) && kind == 0)) { ++ph; continue; }
        if (!first) {
            if (nseam == 0) { grid.sync(); xbar = xcd_barrier_post((unsigned*)(PK.ws + OFF_BAR), bst, (int)threadIdx.x); }
            else xcd_barrier(xbar, (int)threadIdx.x, gridDim.x);
            ++nseam;
        }
        first = false;
        PV P; P.ka = (KArg)__builtin_amdgcn_kernarg_segment_ptr();
        asm volatile("" : "+s"(P.ka));
        { int t_ = threadIdx.x, b_ = blockIdx.x, g_ = gridDim.x; asm volatile("" : "+v"(t_)); asm volatile("" : "+s"(b_)); asm volatile("" : "+s"(g_)); P.tid = t_; P.bid = b_; P.gsz = g_; }
        const int G = P.gsz, bid = P.bid;
        unsigned char* ws = P.ws();
        float* lat = (float*)(ws + OFF_LAT); const bf16_t* hb = (const bf16_t*)(ws + OFF_HB); const float* mod = (const float*)(ws + OFF_MOD);
        if (ph == 0) { for (int rep = 0; rep < REP_PRO; ++rep) { phase_prologue(P, lds); __syncthreads(); } ++ph; continue; }
        if (ph == 1) { phase_init(P); ++ph; continue; }
        const bool lastl = (layer == 3);
        const float* modl = mod + (size_t)layer * 9 * NMODC;
        const int Mpost = lastl ? TL : TA;
        pg8::StaticOrder S;
        switch (st) {
        case 0: case 9: {
            const int s = st == 0 ? 0 : 1; const int M = (st == 9) ? Mpost : TA;
            pg8::Gemm g{hb, (const bf16_t*)(ws + OFF_W13T) + (size_t)(layer * 2 + s) * 5632 * 1024, M, 5632, 1024, 1024};
            S.init(M, 5632, G, bid); S.setk(1024); EpiSwiglu E{(bf16_t*)(ws + OFF_ACT)};
            for (int rep = 0; rep < REP_FFN1; ++rep) pg8::gemm_phase(lds, g, S, E, P.tid);
        } break;
        case 1: case 10: {
            const int s = st == 1 ? 0 : 1; const int M = (st == 10) ? Mpost : TA;
            pg8::Gemm g{(const bf16_t*)(ws + OFF_ACT), (const bf16_t*)(ws + OFF_W2T) + (size_t)(layer * 2 + s) * 1024 * FF, M, 1024, FF, FF};
            EpiResid E{lat, modl, s == 0 ? 2 : 8, 0.5f, nullptr};
            if (M == TA) { pg8::SplitOrder<8> S2; S2.init(FF, G, bid); EpiResidSplit E2{E, (float*)(ws + OFF_SLAB)}; pg8::gemm_phase(lds, g, S2, E2, P.tid); }
            else { S.init(M, 1024, G, bid); S.setk(FF); pg8::gemm_phase(lds, g, S, E, P.tid); }
        } break;
        case 2: case 8: case 11: {
            const int lidx = st == 2 ? 0 : (st == 8 ? 1 : 2);
            const bool fin = (st == 11) && lastl;
            const int Mln = st == 2 ? TA : (st == 8 ? Mpost : (lastl ? TL : TA));
            const float* nm = st == 11 ? modl + (size_t)9 * NMODC : modl;
            const int qs = st == 2 ? 3 : (st == 8 ? 6 : 0);
            const bool comb = (st == 2) || (st == 11 && !lastl);
            const float* sl = comb ? (const float*)(ws + OFF_SLAB) : nullptr;
            const float* g8 = modl + (size_t)8 * NMODC + (st == 2 ? 2 : 8) * 1024;
            phase_ln(P, Mln, P.in(6) + (size_t)(layer * 3 + lidx) * D, P.in(7) + (size_t)(layer * 3 + lidx) * D, nm, qs, fin ? P.out() : nullptr, sl, g8, 0.5f);
        } break;
        case 3: {
            if (kind == 0) {
                { pg8::Gemm g{hb, (const bf16_t*)(ws + OFF_WQKT) + (size_t)jm * 2048 * 1024, TA, 2048, 1024, 1024};
                  S.init(TA, 2048, G, bid); S.setk(1024); EpiQK E{(bf16_t*)(ws + OFF_QK), (const float*)(ws + OFF_ROPE)};
                  pg8::gemm_phase(lds, g, S, E, P.tid); }
                { pg8::Gemm g{(const bf16_t*)(ws + OFF_WVT) + (size_t)jm * 1024 * 1024, hb, 1024, TA, 1024, 1024};
                  S.init(1024, TA, G, bid); S.setk(1024); EpiB E{(bf16_t*)(ws + OFF_VT), TA, nullptr, TA};
                  pg8::gemm_phase(lds, g, S, E, P.tid); }
            } else if (kind == 1) {
                pg8::Gemm g{hb, (const bf16_t*)(ws + OFF_WHIT), TA, 3072, 1024, 1024};
                S.init(TA, 3072, G, bid); S.setk(1024); EpiB E{(bf16_t*)(ws + OFF_HU), 3072, P.in(15), 3072};
                pg8::gemm_phase(lds, g, S, E, P.tid);
            } else {
                pg8::Gemm g{hb, (const bf16_t*)(ws + OFF_WSIT), TA, SSM_INP, 1024, 1024};
                S.init(TA, SSM_INP, G, bid); S.setk(1024); EpiB E{(bf16_t*)(ws + OFF_ZX), SSM_IN, nullptr, SSM_IN};
                pg8::gemm_phase(lds, g, S, E, P.tid);
            }
        } break;
        case 4: {
            if (kind == 0) { for (int rep = 0; rep < REP_ATT; ++rep) phase_attention(P, lds, jm, layer == 0 ? 0.2f : (0.8f - 0.6f * 0.40656965974059917f), !lastl); }
            else if (kind == 1) phase_hy_short(P, lds);
            else phase_ssm_bc(P);
        } break;
        case 5: {
            if (kind == 1) phase_hy_conv(P, lds);
            else phase_ssm_scan(P, lds);
        } break;
        case 6: if (kind == 1) phase_hy_gate(P, lds); else phase_ssm_gate(P); break;
        case 7: {
            const bf16_t* Ap = kind == 0 ? (const bf16_t*)(ws + OFF_AO) : (kind == 1 ? (const bf16_t*)(ws + OFF_HG) : (const bf16_t*)(ws + OFF_Y));
            const bf16_t* Bp = kind == 0 ? (const bf16_t*)(ws + OFF_WOT) + (size_t)jm * 1024 * 1024 : (kind == 1 ? (const bf16_t*)(ws + OFF_WHOT) : (const bf16_t*)(ws + OFF_WSOT));
            const int Mo = kind == 0 ? Mpost : TA, Ko = kind == 2 ? 2048 : 1024, ldo = kind == 2 ? 4096 : 1024;
            const float* bo = kind == 1 ? P.in(25) : nullptr;
            pg8::Gemm g{Ap, Bp, Mo, 1024, Ko, ldo};
            S.init(Mo, 1024, G, bid); S.setk(Ko); EpiResid E{lat, modl, 5, 1.0f, bo};
            pg8::gemm_phase(lds, g, S, E, P.tid);
        } break;
        default: break;
        }
        if (PROBE_STAGE_MASK && ((PROBE_STAGE_MASK >> st) & 1) && ((PROBE_KIND_MASK >> kind) & 1) && prep == 0) prep = 1; else { prep = 0; ++ph; }
    }
}

extern "C" void kernel_launch(void* const* d_in, const int* in_sizes, int n_in, void* d_out, int out_size, void* d_ws, size_t ws_size, hipStream_t stream) {
    static int grid = 0;
    if (grid == 0) {
        if (n_in != 34 || ws_size < WS_END) { fprintf(stderr, "kernel_launch: unexpected n_in %d or ws_size %zu (< %zu)\n", n_in, ws_size, (size_t)WS_END); grid = -1; return; }
        int dev = 0, cus = 0, per_cu = 0;
        (void)hipGetDevice(&dev);
        (void)hipDeviceGetAttribute(&cus, hipDeviceAttributeMultiprocessorCount, dev);
        if (hipFuncSetAttribute((const void*)fwd_megakernel, hipFuncAttributeMaxDynamicSharedMemorySize, LDS_BYTES) != hipSuccess) { fprintf(stderr, "kernel_launch: hipFuncSetAttribute failed\n"); }
        (void)hipOccupancyMaxActiveBlocksPerMultiprocessor(&per_cu, (const void*)fwd_megakernel, 512, LDS_BYTES);
        (void)hipGetLastError();
        if (per_cu < 1) { fprintf(stderr, "kernel_launch: occupancy query says %d blocks per CU\n", per_cu); per_cu = 1; }
        grid = cus;
    }
    if (grid < 0) return;
    Params p{};
    for (int i = 0; i < 34; ++i) p.in[i] = (const float*)d_in[i];
    p.out = (float*)d_out; p.ws = (unsigned char*)d_ws; p.ph_lo = 0; p.ph_hi = 2 + 48;
    void* args[] = {&p};
    hipError_t e = hipLaunchCooperativeKernel((const void*)fwd_megakernel, dim3(grid), dim3(512), args, LDS_BYTES, stream);
    if (e != hipSuccess) fprintf(stderr, "cooperative launch failed: %s (grid %d)\n", hipGetErrorString(e), grid);
}
```

```cpp
#include <hip/hip_runtime.h>
#include <hip/hip_cooperative_groups.h>
#include <cstdio>
namespace cg = cooperative_groups;

#define LAS __attribute__((address_space(3)))
typedef unsigned short bf16_t;
typedef short bf16x8 __attribute__((ext_vector_type(8)));
typedef float f32x4 __attribute__((ext_vector_type(4)));
typedef float f32x2 __attribute__((ext_vector_type(2)));
typedef unsigned u32x4 __attribute__((ext_vector_type(4)));
typedef unsigned u32x2 __attribute__((ext_vector_type(2)));

constexpr int D = 1024, FF = 2816, TL = 16384, TC = 2048, TA = 18432, SEQ = 2048, CTXL = 256, NB = 8;
constexpr int NMODC = 9216;
constexpr float DN_ALPHA = 1.681792830507429f;
constexpr float LN_EPS = 1e-5f;
constexpr int SSM_IN = 5184, SSM_INP = 5376;

constexpr size_t al256(size_t x) { return (x + 255) & ~(size_t)255; }
constexpr size_t OFF_MOD = 0;
constexpr size_t OFF_ROPE = OFF_MOD + al256((size_t)4 * 9 * NMODC * 4);
constexpr size_t OFF_BAR = OFF_ROPE + al256(2 * 1024 * 4);
constexpr size_t OFF_KLAT = OFF_BAR + 16384;
constexpr size_t OFF_KCTX = OFF_KLAT + (size_t)4096 * 1024 * 4;
constexpr size_t OFF_W13T = OFF_KCTX + (size_t)512 * 1024 * 4;
constexpr size_t OFF_W2T = OFF_W13T + (size_t)8 * 5632 * 1024 * 2;
constexpr size_t OFF_WQKT = OFF_W2T + (size_t)8 * 1024 * 2816 * 2;
constexpr size_t OFF_WVT = OFF_WQKT + (size_t)2 * 2048 * 1024 * 2;
constexpr size_t OFF_WOT = OFF_WVT + (size_t)2 * 1024 * 1024 * 2;
constexpr size_t OFF_WHIT = OFF_WOT + (size_t)2 * 1024 * 1024 * 2;
constexpr size_t OFF_WHOT = OFF_WHIT + (size_t)3072 * 1024 * 2;
constexpr size_t OFF_WSIT = OFF_WHOT + (size_t)1024 * 1024 * 2;
constexpr size_t OFF_WSOT = OFF_WSIT + (size_t)SSM_INP * 1024 * 2;
constexpr size_t OFF_LAT = OFF_WSOT + (size_t)1024 * 2048 * 2;
constexpr size_t OFF_HB = OFF_LAT + (size_t)TA * D * 4;
constexpr size_t OFF_BIG = OFF_HB + (size_t)TA * D * 2;
constexpr size_t OFF_ACT = OFF_BIG;
constexpr size_t OFF_SLAB = OFF_ACT + al256((size_t)TA * FF * 2);
constexpr size_t OFF_QK = OFF_BIG;
constexpr size_t OFF_VT = OFF_QK + (size_t)TA * 2048 * 2;
constexpr size_t OFF_AO = OFF_VT + (size_t)1024 * TA * 2;
constexpr size_t OFF_HU = OFF_BIG;
constexpr int HLT = SEQ + CTXL;
constexpr size_t OFF_HX0 = OFF_HU + (size_t)TA * 3072 * 2;
constexpr size_t OFF_HVT = OFF_HX0 + (size_t)TA * D * 4;
constexpr size_t OFF_HYT = OFF_HVT + (size_t)D * NB * HLT * 2;
constexpr size_t OFF_HG = OFF_HYT + (size_t)D * NB * HLT * 2;
constexpr size_t OFF_ZX = OFF_BIG;
constexpr size_t OFF_Y = OFF_ZX + al256((size_t)TA * SSM_IN * 2);
constexpr size_t WS_END = OFF_Y + (size_t)TA * 2048 * 4;
static_assert(OFF_HG + (size_t)TA * D * 2 <= WS_END && OFF_SLAB + (size_t)8 * TC * D * 4 <= WS_END, "ws map");
static_assert(WS_END < (size_t)720 * 1000 * 1000, "ws budget");

constexpr int LDS_BYTES = 141312;

struct Params { const float* in[34]; float* out; unsigned char* ws; int ph_lo, ph_hi; };
typedef const __attribute__((address_space(4))) unsigned char* KArg;
struct PV {
    KArg ka; int tid, bid, gsz;
    __device__ __forceinline__ const float* in(int k) const { return *(const float* const __attribute__((address_space(4)))*)(ka + 8 * k); }
    __device__ __forceinline__ float* out() const { return *(float* const __attribute__((address_space(4)))*)(ka + 8 * 34); }
    __device__ __forceinline__ unsigned char* ws() const { return *(unsigned char* const __attribute__((address_space(4)))*)(ka + 8 * 35); }
};

typedef __bf16 bf16x2_t __attribute__((ext_vector_type(2)));
__device__ __forceinline__ unsigned cvt_pk_bf16(float lo, float hi) { const f32x2 v = {lo, hi}; const bf16x2_t r = __builtin_convertvector(v, bf16x2_t); return __builtin_bit_cast(unsigned, r); }
__device__ __forceinline__ unsigned cvt_pk_bf16_m(float lo, float hi) { return cvt_pk_bf16(lo, hi); }
__device__ __forceinline__ float bf2f(unsigned short b) { return __uint_as_float(((unsigned)b) << 16); }
__device__ __forceinline__ float bflo(unsigned w) { return __uint_as_float(w << 16); }
__device__ __forceinline__ float bfhi(unsigned w) { return __uint_as_float(w & 0xffff0000u); }
__device__ __forceinline__ float wave_sum(float v) {
#pragma unroll
    for (int o = 1; o < 64; o <<= 1) v += __shfl_xor(v, o);
    return v;
}
__device__ __forceinline__ float xmax16(float x) { const u32x2 r = __builtin_amdgcn_permlane16_swap(__float_as_uint(x), __float_as_uint(x), false, false); return fmaxf(__uint_as_float(r[0]), __uint_as_float(r[1])); }
__device__ __forceinline__ float xmax32(float x) { const u32x2 r = __builtin_amdgcn_permlane32_swap(__float_as_uint(x), __float_as_uint(x), false, false); return fmaxf(__uint_as_float(r[0]), __uint_as_float(r[1])); }
__device__ __forceinline__ float silu_f(float a) { return a * __builtin_amdgcn_rcpf(1.0f + __expf(-a)); }
#define LDS_WAIT() asm volatile("s_waitcnt lgkmcnt(0)" ::: "memory")

#define XB_TMO      128
#define XB_XCNT(j)  (256  + 64 * (j))
#define XB_XSUB(j)  (1280 + 64 * (j))
#define XB_XGEN(j)  (2304 + 64 * (j))
#define XB_TOP      3328
#define XB_TOPGEN   3392
#define XCD_BAR_WORDS 3456
#define XB_SPIN_CAP (1u << 18)
__device__ __forceinline__ unsigned xb_ld(unsigned* p)              { return __hip_atomic_load(p, __ATOMIC_RELAXED, __HIP_MEMORY_SCOPE_AGENT); }
__device__ __forceinline__ unsigned xb_add(unsigned* p, unsigned v) { return __hip_atomic_fetch_add(p, v, __ATOMIC_RELAXED, __HIP_MEMORY_SCOPE_AGENT); }
__device__ __forceinline__ unsigned xb_xcc_id() { return (unsigned)__builtin_amdgcn_s_getreg((3 << 11) | 20) & 0xFu; }
#define XB_SPIN(cond, bar) do { unsigned _sp = 0; while (cond) { __builtin_amdgcn_s_sleep(1); \
    if ((++_sp & 255u) == 0u) { if (xb_ld(&(bar)[XB_TMO])) break; if (_sp > XB_SPIN_CAP) { atomicAdd(&(bar)[XB_TMO], 1u); break; } } } } while (0)
struct XcdBarrier { unsigned* bar; unsigned x; volatile LAS unsigned* st; };
__device__ __forceinline__ XcdBarrier xcd_barrier_post(unsigned* bar, volatile LAS unsigned* st, int tid) {
    XcdBarrier b; b.bar = bar; b.x = xb_xcc_id(); b.st = st;
    if (tid == 0) (void)xb_add(&bar[XB_XCNT(b.x)], 1u);
    return b;
}
__device__ __forceinline__ void xcd_barrier_complete(unsigned* bar, unsigned x, unsigned G, unsigned& nloc, unsigned& nx) {
    unsigned sum, cnt, mine, sp = 0u;
    for (;;) {
        sum = 0u; cnt = 0u; mine = 0u;
#pragma unroll
        for (unsigned j = 0; j < 16; ++j) { const unsigned c = xb_ld(&bar[XB_XCNT(j)]); sum += c; cnt += (c > 0u) ? 1u : 0u; mine = (j == x) ? c : mine; }
        if (sum == G) break;
        __builtin_amdgcn_s_sleep(1);
        if ((++sp & 255u) == 0u) { if (xb_ld(&bar[XB_TMO])) break; if (sp > XB_SPIN_CAP) { atomicAdd(&bar[XB_TMO], 1u); break; } }
    }
    nloc = mine > 0u ? mine : 1u; nx = cnt > 0u ? cnt : 1u;
}
__device__ __forceinline__ void xcd_barrier(const XcdBarrier& b, int tid, unsigned G) {
    asm volatile("s_waitcnt vmcnt(0)" ::: "memory");
    __syncthreads();
    if (tid == 0) {
        unsigned* bar = b.bar;
        __builtin_amdgcn_s_waitcnt(0);
        unsigned nloc = b.st[0], nx = b.st[1];
        if (nloc == 0u) { xcd_barrier_complete(bar, b.x, G, nloc, nx); b.st[0] = nloc; b.st[1] = nx; }
        const unsigned old = xb_add(&bar[XB_XSUB(b.x)], 1u);
        const unsigned gen = old / nloc;
        if (old + 1u == (gen + 1u) * nloc) {
            __builtin_amdgcn_fence(__ATOMIC_RELEASE, "agent");
            asm volatile("s_waitcnt vmcnt(0)" ::: "memory");
            const unsigned og = xb_add(&bar[XB_TOP], 1u);
            const unsigned tg = og / nx;
            if (og + 1u == (tg + 1u) * nx) xb_add(&bar[XB_TOPGEN], 1u);
            else XB_SPIN(xb_ld(&bar[XB_TOPGEN]) == tg, bar);
            __builtin_amdgcn_fence(__ATOMIC_ACQUIRE, "agent");
            xb_add(&bar[XB_XGEN(b.x)], 1u);
            asm volatile("s_waitcnt vmcnt(0)" ::: "memory");
        } else {
            XB_SPIN(xb_ld(&bar[XB_XGEN(b.x)]) == gen, bar);
            __builtin_amdgcn_fence(__ATOMIC_ACQUIRE, "agent");
            asm volatile("s_waitcnt vmcnt(0)" ::: "memory");
        }
    }
    __syncthreads();
}


namespace pg8 {
constexpr int BM = 256, BK = 64, HALF = 128, HTB = HALF * BK * 2, STAGE_BYTES = 8 * HTB, NXCD = 8, WGM = 8;
__device__ __forceinline__ int lds_byte(int r, int c) { const int st = (r >> 4) * 2 + (c >> 5), rr = r & 15, cc = c & 31, ob = rr * 64 + cc * 2; return st * 1024 + (ob ^ (((ob >> 9) & 1) << 5)); }
__device__ __forceinline__ void stage_rc(int b, int& R, int& C) { const int st = b / 1024, sb = b % 1024, swz = sb ^ (((sb >> 9) & 1) << 5); R = (st >> 1) * 16 + swz / 64; C = (st & 1) * 32 + (swz % 64) / 2; }
__device__ __forceinline__ int perm32(int rho) { const int n = rho >> 4, i = rho & 15; return 8 * (i >> 2) + 4 * n + (i & 3); }
struct Unit { int pm, pn, kt0, nt, ks; };
struct Gemm { const bf16_t* A; const bf16_t* Bt; int M, N, K, lda; };
struct StaticOrder {
    int nM, nN, nwg, G, c, ntk;
    __device__ void init(int M, int N, int G_, int c_) { nM = M / BM; nN = N / BM; nwg = nM * nN; G = G_; c = c_; ntk = 0; }
    __device__ void setk(int K) { ntk = K / BK; }
    __device__ bool next(int i, Unit& u) const {
        const long L = (long)i * G + c; if (L >= nwg) return false;
        int wgid = (int)L; { const int q = nwg / NXCD, r = nwg % NXCD, xcd = wgid % NXCD, off = wgid / NXCD; wgid = (xcd < r ? xcd * (q + 1) : r * (q + 1) + (xcd - r) * q) + off; }
        const int nig = WGM * nN, gid = wgid / nig, fm = gid * WGM, gsz = (nM - fm) < WGM ? (nM - fm) : WGM;
        u.pm = fm + ((wgid % nig) % gsz); u.pn = (wgid % nig) / gsz; u.kt0 = 0; u.nt = ntk; u.ks = -1; return true;
    }
};
template <int NSL> struct SplitOrder {
    int G, c, ntk;
    __device__ void init(int K, int G_, int c_) { G = G_; c = c_; ntk = K / BK; }
    __device__ bool next(int i, Unit& u) const {
        const int L = i * G + c;
        if (L >= 256 + 32 * NSL) return false;
        if (L < 256) {
            const int xcd = L & 7, off = L >> 3;
            u.pm = 8 * xcd + (off & 7); u.pn = off >> 3; u.kt0 = 0; u.nt = ntk; u.ks = -1;
        } else {
            const int j = L - 256, ks = j % NSL, tile = j / NSL;
            const int np = ntk / 2, q = np / NSL, r = np % NSL;
            const int p0 = ks * q + (ks < r ? ks : r), pc = q + (ks < r ? 1 : 0);
            u.pm = 64 + (tile >> 2); u.pn = tile & 3; u.kt0 = 2 * p0; u.nt = 2 * pc; u.ks = ks;
        }
        return true;
    }
};

template <class Epi, class Sched>
__device__ __forceinline__ void gemm_phase(LAS unsigned char* lds, const Gemm g, const Sched& S, const Epi& E, const int tid_in) {
    const int tid = tid_in, wid = __builtin_amdgcn_readfirstlane(tid >> 6), lane = tid & 63, wr = wid >> 2, wc = wid & 3, fr = lane & 15, fq = lane >> 4;
    const int K = g.K, lda = g.lda;
    unsigned voffA[2], voffB[2];
#pragma unroll
    for (int i = 0; i < 2; ++i) { int R, C; stage_rc(tid * 16 + i * 8192, R, C); const int Rb = Epi::PERM ? ((R & ~31) + perm32(R & 31)) : R;
        voffA[i] = (unsigned)(R * lda + C) * 2u; voffB[i] = (unsigned)(Rb * K + C) * 2u; }
    const size_t kstep = (size_t)(BK * 2);
    const size_t hstepA = (size_t)HALF * lda * 2, hstepB = (size_t)HALF * K * 2;
    const size_t tstepA = 2 * hstepA, tstepB = 2 * hstepB;
    const unsigned ldsw = (unsigned)wid * 1024u;
    const int aoff = lds_byte(wr * 64 + fr, fq * 8), boff = lds_byte(wc * 32 + fr, fq * 8);
#define PG8_SA(b, h) (((b) * 2 + (h)) * HTB)
#define PG8_SB(b, h) ((4 + (b) * 2 + (h)) * HTB)
#define PG8_STAGE(bufoff, gbase, voff) do { _Pragma("unroll") for (int _i = 0; _i < 2; ++_i) \
        __builtin_amdgcn_global_load_lds((const unsigned*)((const char*)(gbase) + (voff)[_i]), (LAS unsigned*)(lds + (bufoff) + ldsw + _i * 8192), 16, 0, 0); } while (0)
#define PG8_LDA(dst, b, h) do { _Pragma("unroll") for (int m = 0; m < 4; ++m) _Pragma("unroll") for (int k = 0; k < 2; ++k) dst[m][k] = *(const LAS bf16x8*)(lds + PG8_SA(b, h) + aoff + m * 2048 + k * 1024); } while (0)
#define PG8_LDB(dst, b, h) do { _Pragma("unroll") for (int n = 0; n < 2; ++n) _Pragma("unroll") for (int k = 0; k < 2; ++k) dst[n][k] = *(const LAS bf16x8*)(lds + PG8_SB(b, h) + boff + n * 2048 + k * 1024); } while (0)
#define PG8_MMA(ai, bj, At, Bt) do { __builtin_amdgcn_s_setprio(1); _Pragma("unroll") for (int m = 0; m < 4; ++m) _Pragma("unroll") for (int n = 0; n < 2; ++n) _Pragma("unroll") for (int k = 0; k < 2; ++k) \
        acc[ai][bj][m][n] = __builtin_amdgcn_mfma_f32_16x16x32_bf16(Bt[n][k], At[m][k], acc[ai][bj][m][n], 0, 0, 0); __builtin_amdgcn_s_setprio(0); } while (0)
#define PG8_WAIT_V(n) asm volatile("s_waitcnt vmcnt(" #n ")" ::: "memory")
#define PG8_WAIT_L(n) asm volatile("s_waitcnt lgkmcnt(" #n ")" ::: "memory")
#define PG8_BAR __builtin_amdgcn_s_barrier()
#define PG8_SCHED __builtin_amdgcn_sched_barrier(0)
    Unit cur, nxt; int ui = 0;
    if (!S.next(0, cur)) return;
    f32x4 acc[2][2][4][2];
#pragma unroll
    for (int a = 0; a < 2; ++a)
#pragma unroll
        for (int b = 0; b < 2; ++b)
#pragma unroll
            for (int m = 0; m < 4; ++m)
#pragma unroll
                for (int n = 0; n < 2; ++n) acc[a][b][m][n] = (f32x4){0.f, 0.f, 0.f, 0.f};
    bf16x8 At[4][2], B0[2][2], B1[2][2];
    const char* cA = (const char*)g.A + (size_t)cur.pm * tstepA + (size_t)cur.kt0 * kstep; const char* cB = (const char*)g.Bt + (size_t)cur.pn * tstepB + (size_t)cur.kt0 * kstep;
    PG8_STAGE(PG8_SB(0, 0), cB, voffB); PG8_STAGE(PG8_SB(0, 1), cB + hstepB, voffB); PG8_STAGE(PG8_SA(0, 0), cA, voffA); PG8_STAGE(PG8_SA(0, 1), cA + hstepA, voffA);
    if (wr == 1) PG8_BAR;
    PG8_WAIT_V(2); PG8_BAR;
    PG8_STAGE(PG8_SB(1, 0), cB + kstep, voffB); PG8_STAGE(PG8_SA(1, 0), cA + kstep, voffA); PG8_STAGE(PG8_SB(1, 1), cB + hstepB + kstep, voffB);
    PG8_WAIT_V(6); PG8_BAR;
    for (;;) {
        const bool has_next = S.next(ui + 1, nxt);
        const char* nA = has_next ? (const char*)g.A + (size_t)nxt.pm * tstepA + (size_t)nxt.kt0 * kstep : cA; const char* nB = has_next ? (const char*)g.Bt + (size_t)nxt.pn * tstepB + (size_t)nxt.kt0 * kstep : cB;
        const int nt = cur.nt;
        for (int t = 0; t < nt; t += 2) {
            const bool last = (t == nt - 2);
            const char* a1 = cA + (size_t)(t + 1) * kstep;
            const char* a2 = last ? nA : cA + (size_t)(t + 2) * kstep; const char* b2 = last ? nB : cB + (size_t)(t + 2) * kstep;
            const char* a3 = a2 + kstep; const char* b3 = b2 + kstep;
            PG8_LDB(B0, 0, 0); PG8_LDB(B1, 0, 1); PG8_SCHED; PG8_LDA(At, 0, 0); PG8_STAGE(PG8_SA(1, 1), a1 + hstepA, voffA);
            PG8_WAIT_V(8); PG8_WAIT_L(0); PG8_BAR; PG8_MMA(0, 0, At, B0); PG8_MMA(0, 1, At, B1); PG8_BAR; PG8_SCHED;
            PG8_LDA(At, 0, 1); PG8_STAGE(PG8_SB(0, 0), b2, voffB); PG8_STAGE(PG8_SB(0, 1), b2 + hstepB, voffB); PG8_STAGE(PG8_SA(0, 0), a2, voffA);
            PG8_WAIT_V(8); PG8_WAIT_L(0); PG8_BAR; PG8_MMA(1, 0, At, B0); PG8_MMA(1, 1, At, B1); PG8_BAR; PG8_SCHED;
            PG8_LDB(B0, 1, 0); PG8_LDB(B1, 1, 1); PG8_SCHED; PG8_LDA(At, 1, 0); PG8_STAGE(PG8_SA(0, 1), a2 + hstepA, voffA);
            PG8_WAIT_V(8); PG8_WAIT_L(0); PG8_BAR; PG8_MMA(0, 0, At, B0); PG8_MMA(0, 1, At, B1); PG8_BAR; PG8_SCHED;
            PG8_LDA(At, 1, 1); PG8_STAGE(PG8_SB(1, 0), b3, voffB); PG8_STAGE(PG8_SB(1, 1), b3 + hstepB, voffB); PG8_STAGE(PG8_SA(1, 0), a3, voffA);
            PG8_WAIT_V(8); PG8_WAIT_L(0); PG8_BAR; PG8_MMA(1, 0, At, B0); PG8_MMA(1, 1, At, B1); PG8_BAR; PG8_SCHED;
        }
        if (wr == 0) PG8_BAR;
        E(acc, cur, wr, wc, fr, fq);
        if (!has_next) break;
#pragma unroll
        for (int a = 0; a < 2; ++a)
#pragma unroll
            for (int b = 0; b < 2; ++b)
#pragma unroll
                for (int m = 0; m < 4; ++m)
#pragma unroll
                    for (int n = 0; n < 2; ++n) acc[a][b][m][n] = (f32x4){0.f, 0.f, 0.f, 0.f};
        cur = nxt; cA = nA; cB = nB; ++ui;
        if (wr == 1) PG8_BAR;
    }
    PG8_WAIT_V(0);
    PG8_BAR;
#undef PG8_SA
#undef PG8_SB
#undef PG8_STAGE
#undef PG8_LDA
#undef PG8_LDB
#undef PG8_MMA
#undef PG8_WAIT_V
#undef PG8_WAIT_L
#undef PG8_BAR
#undef PG8_SCHED
}
}
using pg8::Unit;
typedef f32x4 AccT[2][2][4][2];

struct EpiSwiglu {
    static constexpr bool PERM = true;
    bf16_t* O;
    __device__ __forceinline__ void operator()(const AccT& acc, const Unit& u, int wr, int wc, int fr, int fq) const {
        const int row0 = u.pm * 256 + wr * 64 + fr, col0 = u.pn * 128 + wc * 32 + 8 * fq;
#pragma unroll
        for (int ai = 0; ai < 2; ++ai)
#pragma unroll
            for (int m = 0; m < 4; ++m) {
                bf16_t* rowp = O + (size_t)(row0 + ai * 128 + m * 16) * FF + col0;
                const f32x4 a0 = acc[ai][0][m][0], a1 = acc[ai][0][m][1], u0 = acc[ai][1][m][0], u1 = acc[ai][1][m][1];
                u32x4 w;
                w.x = cvt_pk_bf16(silu_f(a0[0]) * u0[0], silu_f(a0[1]) * u0[1]);
                w.y = cvt_pk_bf16(silu_f(a0[2]) * u0[2], silu_f(a0[3]) * u0[3]);
                w.z = cvt_pk_bf16(silu_f(a1[0]) * u1[0], silu_f(a1[1]) * u1[1]);
                w.w = cvt_pk_bf16(silu_f(a1[2]) * u1[2], silu_f(a1[3]) * u1[3]);
                *(u32x4*)rowp = w;
            }
    }
};
struct EpiResid {
    static constexpr bool PERM = false;
    float* lat; const float* modl; int gidx; float w; const float* bias;
    __device__ __forceinline__ void operator()(const AccT& acc, const Unit& u, int wr, int wc, int fr, int fq) const {
        const int mr = (u.pm < 64) ? (u.pm >> 3) : 8;
        const int row0 = u.pm * 256 + wr * 64 + fr, col0 = u.pn * 256 + wc * 32 + 4 * fq;
        const float* gate = modl + (size_t)mr * NMODC + gidx * 1024 + col0;
        float* base = lat + (size_t)row0 * D + col0;
        f32x4 xa[8], xb[8];
#pragma unroll
        for (int i = 0; i < 8; ++i) xa[i] = *(const f32x4*)(base + (size_t)((i >> 2) * 128 + (i & 3) * 16) * D);
#pragma unroll
        for (int k = 0; k < 4; ++k) {
            const int bj = k >> 1, n = k & 1, co = bj * 128 + n * 16;
            if (k < 3) { const int co2 = ((k + 1) >> 1) * 128 + ((k + 1) & 1) * 16;
#pragma unroll
                for (int i = 0; i < 8; ++i) xb[i] = *(const f32x4*)(base + (size_t)((i >> 2) * 128 + (i & 3) * 16) * D + co2); }
            const f32x4 gv = (*(const f32x4*)(gate + co) + 1.0f) * w;
            const f32x4 bv = bias ? *(const f32x4*)(bias + col0 + co) : (f32x4){0.f, 0.f, 0.f, 0.f};
            __builtin_amdgcn_sched_barrier(0);
#pragma unroll
            for (int i = 0; i < 8; ++i) { const int ai = i >> 2, m = i & 3;
                *(f32x4*)(base + (size_t)(ai * 128 + m * 16) * D + co) = xa[i] * DN_ALPHA + gv * (acc[ai][bj][m][n] + bv); }
#pragma unroll
            for (int i = 0; i < 8; ++i) xa[i] = xb[i];
        }
    }
};
struct EpiResidSplit {
    static constexpr bool PERM = false;
    EpiResid r; float* slabs;
    __device__ __forceinline__ void operator()(const AccT& acc, const Unit& u, int wr, int wc, int fr, int fq) const {
        if (u.ks < 0) { r(acc, u, wr, wc, fr, fq); return; }
        const int row0 = u.pm * 256 + wr * 64 + fr, col0 = u.pn * 256 + wc * 32 + 4 * fq;
        float* sb = slabs + ((size_t)u.ks * TC + (row0 - TL)) * D + col0;
#pragma unroll
        for (int ai = 0; ai < 2; ++ai)
#pragma unroll
            for (int m = 0; m < 4; ++m)
#pragma unroll
                for (int bj = 0; bj < 2; ++bj)
#pragma unroll
                    for (int n = 0; n < 2; ++n) *(f32x4*)(sb + (size_t)(ai * 128 + m * 16) * D + bj * 128 + n * 16) = acc[ai][bj][m][n];
    }
};
struct EpiQK {
    static constexpr bool PERM = false;
    bf16_t* O; const float* tab;
    __device__ __forceinline__ void operator()(const AccT& acc, const Unit& u, int wr, int wc, int fr, int fq) const {
        const int row0 = u.pm * 256 + wr * 64 + fr, col0 = u.pn * 256 + wc * 32 + 8 * fq;
        const int axis = wc & 1;
        if (u.pm < 64) {
            f32x4 cs, sn, csn, snn;
            { const int t = row0 & 2047; const int pos = axis ? (t & 63) : (t >> 6);
              cs = *(const f32x4*)(tab + pos * 16 + 4 * fq); sn = *(const f32x4*)(tab + 1024 + pos * 16 + 4 * fq); csn = cs; snn = sn; }
#pragma unroll
            for (int i = 0; i < 8; ++i) {
                const int ai = i >> 2, m = i & 3;
                const int r = row0 + ai * 128 + m * 16;
                if (i < 7) { const int r2 = row0 + ((i + 1) >> 2) * 128 + ((i + 1) & 3) * 16; const int t = r2 & 2047; const int pos = axis ? (t & 63) : (t >> 6);
                    csn = *(const f32x4*)(tab + pos * 16 + 4 * fq); snn = *(const f32x4*)(tab + 1024 + pos * 16 + 4 * fq); }
                bf16_t* rowp = O + (size_t)r * 2048 + col0;
#pragma unroll
                for (int bj = 0; bj < 2; ++bj) {
                    const f32x4 x1 = acc[ai][bj][m][0], x2 = acc[ai][bj][m][1];
                    const f32x4 o1 = x1 * cs - x2 * sn, o2 = x2 * cs + x1 * sn;
                    u32x4 w; w.x = cvt_pk_bf16(o1[0], o1[1]); w.y = cvt_pk_bf16(o1[2], o1[3]); w.z = cvt_pk_bf16(o2[0], o2[1]); w.w = cvt_pk_bf16(o2[2], o2[3]);
                    *(u32x4*)(rowp + bj * 128) = w;
                }
                cs = csn; sn = snn;
            }
        } else {
#pragma unroll
            for (int i = 0; i < 8; ++i) {
                const int ai = i >> 2, m = i & 3;
                bf16_t* rowp = O + (size_t)(row0 + ai * 128 + m * 16) * 2048 + col0;
#pragma unroll
                for (int bj = 0; bj < 2; ++bj) {
                    const f32x4 x1 = acc[ai][bj][m][0], x2 = acc[ai][bj][m][1];
                    u32x4 w; w.x = cvt_pk_bf16(x1[0], x1[1]); w.y = cvt_pk_bf16(x1[2], x1[3]); w.z = cvt_pk_bf16(x2[0], x2[1]); w.w = cvt_pk_bf16(x2[2], x2[3]);
                    *(u32x4*)(rowp + bj * 128) = w;
                }
            }
        }
    }
};
struct EpiB {
    static constexpr bool PERM = true;
    bf16_t* O; int ldc; const float* bias; int ncols;
    __device__ __forceinline__ void operator()(const AccT& acc, const Unit& u, int wr, int wc, int fr, int fq) const {
        const int row0 = u.pm * 256 + wr * 64 + fr, col0 = u.pn * 256 + wc * 32 + 8 * fq;
        bf16_t* base = O + (size_t)row0 * ldc + col0;
#pragma unroll
        for (int bj = 0; bj < 2; ++bj) {
            if (col0 + bj * 128 < ncols) {
                f32x4 b0 = (f32x4){0.f, 0.f, 0.f, 0.f}, b1 = (f32x4){0.f, 0.f, 0.f, 0.f};
                if (bias) { b0 = *(const f32x4*)(bias + col0 + bj * 128); b1 = *(const f32x4*)(bias + col0 + bj * 128 + 4); }
#pragma unroll
                for (int ai = 0; ai < 2; ++ai)
#pragma unroll
                    for (int m = 0; m < 4; ++m) {
                        const f32x4 v0 = acc[ai][bj][m][0] + b0, v1 = acc[ai][bj][m][1] + b1;
                        u32x4 w; w.x = cvt_pk_bf16(v0[0], v0[1]); w.y = cvt_pk_bf16(v0[2], v0[3]); w.z = cvt_pk_bf16(v1[0], v1[1]); w.w = cvt_pk_bf16(v1[2], v1[3]);
                        *(u32x4*)(base + (size_t)(ai * 128 + m * 16) * ldc + bj * 128) = w;
                    }
            }
            asm volatile("" ::: "memory");
        }
    }
};

__device__ __forceinline__ void transpose_tile(const float* W, int ldw, bf16_t* WT, int ldt, int k0, int n0, int drow0, LAS float* scr, int lane) {
    f32x4 wv[8];
#pragma unroll
    for (int i = 0; i < 8; ++i) wv[i] = *(const f32x4*)(W + (size_t)(k0 + 8 * i + (lane >> 3)) * ldw + n0 + 4 * (lane & 7));
#pragma unroll
    for (int i = 0; i < 8; ++i) { LAS float* dd = scr + (8 * i + (lane >> 3)) * 33 + 4 * (lane & 7); dd[0] = wv[i][0]; dd[1] = wv[i][1]; dd[2] = wv[i][2]; dd[3] = wv[i][3]; }
    LDS_WAIT();
    const int c = lane & 7;
#pragma unroll
    for (int j = 0; j < 4; ++j) { const int n = (lane >> 3) + 8 * j; const LAS float* s = scr + (8 * c) * 33 + n;
        u32x4 o; o.x = cvt_pk_bf16(s[0 * 33], s[1 * 33]); o.y = cvt_pk_bf16(s[2 * 33], s[3 * 33]); o.z = cvt_pk_bf16(s[4 * 33], s[5 * 33]); o.w = cvt_pk_bf16(s[6 * 33], s[7 * 33]);
        *(u32x4*)(WT + (size_t)(drow0 + n) * ldt + k0 + 8 * c) = o; }
    LDS_WAIT();
}

__device__ __forceinline__ void hyena_filter_pos(const PV& P, int pos, int lane) {
    const float* fw_in = P.in(18);
    const float* fw_mid = P.in(19);
    const float* fb = P.in(20);
    const float* ffreq = P.in(21);
    const float* fw_out = P.in(22);
    int L, n, RL; bf16_t* kf;
    if (pos < SEQ) { L = SEQ; n = pos; RL = 4096; kf = (bf16_t*)(P.ws() + OFF_KLAT); } else { L = CTXL; n = pos - SEQ; RL = 512; kf = (bf16_t*)(P.ws() + OFF_KCTX); }
    const float t = (float)n / (float)(L - 1);
    const float w = 6.283185307179586f * (float)n / (float)L;
    float zv = 0.f;
    if (lane == 0) zv = t;
    else if (lane < 17) { const float f = 1e-4f + (float)(lane - 1) * ((15.0f - 1e-4f) / 15.0f); zv = cosf(f * w); }
    else if (lane < 33) { const float f = 1e-4f + (float)(lane - 17) * ((15.0f - 1e-4f) / 15.0f); zv = -sinf(f * w); }
    const float fr = ffreq[lane];
    float a = fb[lane];
    for (int k = 0; k < 33; ++k) a += __shfl(zv, k) * fw_in[k * 64 + lane];
    float h = sinf(fr * a);
    a = fb[64 + lane];
    for (int k = 0; k < 64; ++k) a += __shfl(h, k) * fw_mid[k * 64 + lane];
    h = sinf(fr * a);
    a = fb[128 + lane];
    for (int k = 0; k < 64; ++k) a += __shfl(h, k) * fw_mid[4096 + k * 64 + lane];
    h = sinf(fr * a);
    f32x4 o[8];
#pragma unroll
    for (int i = 0; i < 8; ++i) o[i] = (f32x4){0.f, 0.f, 0.f, 0.f};
    for (int k = 0; k < 64; ++k) {
        const float hk = __shfl(h, k);
        const f32x4* wr = (const f32x4*)(fw_out + (size_t)k * 2048) + lane;
#pragma unroll
        for (int i = 0; i < 8; ++i) o[i] += hk * wr[64 * i];
    }
    const float dmin = -15.350567286626973f, dmax = -3.0701134573253945f;
#pragma unroll
    for (int i = 0; i < 8; ++i) {
        const int c = lane * 4 + 256 * i; const int dir = c >> 10, d0 = c & 1023;
        f32x4 r;
#pragma unroll
        for (int j = 0; j < 4; ++j) { const float dl = fabsf(dmin + (float)(d0 + j) * ((dmax - dmin) / 1023.0f)); r[j] = o[i][j] * (expf(-t * dl) + 0.05f); }
        const int idx = dir == 0 ? (L - 1 - n) : (L - 1 + n);
        if (dir == 0 || n >= 1) {
#pragma unroll
            for (int j = 0; j < 4; ++j) { float v = r[j]; if (dir == 0 && n == 0) v += P.in(23)[d0 + j];
                kf[(size_t)(d0 + j) * RL + idx] = (bf16_t)(cvt_pk_bf16(v, 0.f) & 0xffffu); }
        }
    }
}

__device__ __forceinline__ void phase_prologue(const PV& P, LAS unsigned char* lds) {
    const int tid = P.tid, lane = tid & 63, wave = __builtin_amdgcn_readfirstlane(tid >> 6), G = P.gsz;
    unsigned char* ws = P.ws();
    {
        LAS float* sv = (LAS float*)lds;
        LAS float* red = (LAS float*)(lds + 9 * 1024 * 4);
        const float* cin = P.in(1); const float* cctx = P.in(3);
        for (int i = tid; i < 9 * 1024; i += 512) { const float v = (i < 8192) ? cin[i] : cctx[i - 8192]; sv[i] = v / (1.0f + expf(-v)); }
        __syncthreads();
        const float* ada_w = P.in(4); const float* ada_b = P.in(5);
        float* mod = (float*)(ws + OFF_MOD);
        for (int uidx = P.bid; uidx < 288; uidx += G) {
            const int l = uidx / 72, cb = uidx % 72, cn = tid & 127, kq = tid >> 7;
            const float* wp = ada_w + (size_t)l * 1024 * NMODC + (size_t)(256 * kq) * NMODC + 128 * cb + cn;
            float acc[9];
#pragma unroll
            for (int r = 0; r < 9; ++r) acc[r] = 0.f;
#pragma unroll 4
            for (int k = 0; k < 256; ++k) {
                const float wv = wp[(size_t)k * NMODC];
#pragma unroll
                for (int r = 0; r < 9; ++r) acc[r] += sv[r * 1024 + 256 * kq + k] * wv;
            }
#pragma unroll
            for (int r = 0; r < 9; ++r) red[(kq * 9 + r) * 128 + cn] = acc[r];
            __syncthreads();
            for (int o = tid; o < 9 * 128; o += 512) { const int r = o >> 7, c2 = o & 127;
                const float s = red[(0 * 9 + r) * 128 + c2] + red[(1 * 9 + r) * 128 + c2] + red[(2 * 9 + r) * 128 + c2] + red[(3 * 9 + r) * 128 + c2];
                mod[((size_t)l * 9 + r) * NMODC + 128 * cb + c2] = s + ada_b[(size_t)l * NMODC + 128 * cb + c2]; }
            __syncthreads();
        }
    }
    if (P.bid == 0) { unsigned* bw = (unsigned*)(ws + OFF_BAR); for (int i = tid; i < XCD_BAR_WORDS; i += 512) bw[i] = 0u; }
    if (P.bid == G - 1) {
        float* tab = (float*)(ws + OFF_ROPE);
        for (int i = tid; i < 1024; i += 512) { const int pos = i >> 4, f = i & 15; const float inv = powf(10000.0f, -(float)f / 16.0f); const float ang = (float)pos * inv; tab[i] = cosf(ang); tab[1024 + i] = sinf(ang); }
    }
    __syncthreads();
    LAS float* scr = (LAS float*)(lds + wave * 16384);
    const int gw = P.bid * 8 + wave, NGW = G * 8;
    constexpr int I_13 = 8 * 16 * 176, I_2 = 8 * 44 * 32, I_QKV = 2 * 16 * 96, I_O = 2 * 16 * 32, I_HI = 16 * 96, I_HO = 16 * 32, I_SI = 16 * 162, I_SO = 32 * 32, I_PAD = 192, I_F = SEQ + CTXL;
    constexpr int NIT = I_13 + I_2 + I_QKV + I_O + I_HI + I_HO + I_SI + I_SO + I_PAD + I_F;
    for (int it = gw; it < NIT; it += NGW) {
        int r = it;
        if (r < I_13) { const int q = r / 2816, rr = r % 2816, kb = rr / 176, nb = rr % 176, n0 = 32 * nb; const int half = n0 >= FF ? 1 : 0, jn = n0 - half * FF;
            transpose_tile(P.in(8) + (size_t)q * 1024 * 5632, 5632, (bf16_t*)(ws + OFF_W13T) + (size_t)q * 5632 * 1024, 1024, 64 * kb, n0, 256 * (jn >> 7) + 128 * half + (jn & 127), scr, lane); continue; } r -= I_13;
        if (r < I_2) { const int q = r / 1408, rr = r % 1408, kb = rr / 32, nb = rr % 32;
            transpose_tile(P.in(9) + (size_t)q * FF * 1024, 1024, (bf16_t*)(ws + OFF_W2T) + (size_t)q * 1024 * FF, FF, 64 * kb, 32 * nb, 32 * nb, scr, lane); continue; } r -= I_2;
        if (r < I_QKV) { const int q = r / 1536, rr = r % 1536, kb = rr / 96, nb = rr % 96, n0 = 32 * nb;
            if (n0 < 2048) transpose_tile(P.in(10) + (size_t)q * 1024 * 3072, 3072, (bf16_t*)(ws + OFF_WQKT) + (size_t)q * 2048 * 1024, 1024, 64 * kb, n0, n0, scr, lane);
            else transpose_tile(P.in(10) + (size_t)q * 1024 * 3072, 3072, (bf16_t*)(ws + OFF_WVT) + (size_t)q * 1024 * 1024, 1024, 64 * kb, n0, n0 - 2048, scr, lane);
            continue; } r -= I_QKV;
        if (r < I_O) { const int q = r / 512, rr = r % 512, kb = rr / 32, nb = rr % 32;
            transpose_tile(P.in(11) + (size_t)q * 1024 * 1024, 1024, (bf16_t*)(ws + OFF_WOT) + (size_t)q * 1024 * 1024, 1024, 64 * kb, 32 * nb, 32 * nb, scr, lane); continue; } r -= I_O;
        if (r < I_HI) { const int kb = r / 96, nb = r % 96;
            transpose_tile(P.in(14), 3072, (bf16_t*)(ws + OFF_WHIT), 1024, 64 * kb, 32 * nb, 32 * nb, scr, lane); continue; } r -= I_HI;
        if (r < I_HO) { const int kb = r / 32, nb = r % 32;
            transpose_tile(P.in(24), 1024, (bf16_t*)(ws + OFF_WHOT), 1024, 64 * kb, 32 * nb, 32 * nb, scr, lane); continue; } r -= I_HO;
        if (r < I_SI) { const int kb = r / 162, nb = r % 162;
            transpose_tile(P.in(26), SSM_IN, (bf16_t*)(ws + OFF_WSIT), 1024, 64 * kb, 32 * nb, 32 * nb, scr, lane); continue; } r -= I_SI;
        if (r < I_SO) { const int kb = r / 32, nb = r % 32;
            transpose_tile(P.in(33), 1024, (bf16_t*)(ws + OFF_WSOT), 2048, 64 * kb, 32 * nb, 32 * nb, scr, lane); continue; } r -= I_SO;
        if (r < I_PAD) { u32x4* p = (u32x4*)((bf16_t*)(ws + OFF_WSIT) + (size_t)(SSM_IN + r) * 1024); unsigned zz = 0u; asm volatile("" : "+v"(zz)); const u32x4 z = (u32x4){zz, zz, zz, zz}; p[lane] = z; p[64 + lane] = z; continue; } r -= I_PAD;
        hyena_filter_pos(P, r, lane);
    }
}

__device__ __forceinline__ void ln_rows(f32x4 (&v)[4], const float* g, const float* b, int lane) {
    float s = 0.f;
#pragma unroll
    for (int j = 0; j < 4; ++j) s += (v[j][0] + v[j][1]) + (v[j][2] + v[j][3]);
    const float mean = wave_sum(s) * (1.f / D); float s2 = 0.f;
#pragma unroll
    for (int j = 0; j < 4; ++j) { v[j] = v[j] - mean; s2 += (v[j][0] * v[j][0] + v[j][1] * v[j][1]) + (v[j][2] * v[j][2] + v[j][3] * v[j][3]); }
    const float rstd = 1.0f / sqrtf(wave_sum(s2) * (1.f / D) + LN_EPS);
#pragma unroll
    for (int j = 0; j < 4; ++j) { const f32x4 gg = *((const f32x4*)g + lane + 64 * j), bb = *((const f32x4*)b + lane + 64 * j); v[j] = v[j] * rstd * gg + bb; }
}
__device__ __forceinline__ void write_hb(const f32x4 (&v)[4], const float* shift, const float* scale, bf16_t* hrow, int lane) {
#pragma unroll
    for (int j = 0; j < 4; ++j) { const f32x4 sh = *((const f32x4*)shift + lane + 64 * j), sc = *((const f32x4*)scale + lane + 64 * j);
        const f32x4 o = v[j] * (sc + 1.0f) + sh; u32x2 w; w.x = cvt_pk_bf16(o[0], o[1]); w.y = cvt_pk_bf16(o[2], o[3]);
        *((u32x2*)hrow + lane + 64 * j) = w; }
}
__device__ __forceinline__ int mod_row(int r) { return r < TL ? (r >> 11) : 8; }

__device__ __forceinline__ void phase_init(const PV& P) {
    const int lane = P.tid & 63, wave = P.tid >> 6, gw = P.bid * 8 + wave, NGW = P.gsz * 8;
    float* lat = (float*)(P.ws() + OFF_LAT); bf16_t* hb = (bf16_t*)(P.ws() + OFF_HB); const float* mod = (const float*)(P.ws() + OFF_MOD);
    f32x4 nv[4];
    if (gw < TA) { const float* s0 = gw < TL ? P.in(0) + (size_t)gw * D : P.in(2) + (size_t)(gw - TL) * D;
#pragma unroll
        for (int j = 0; j < 4; ++j) nv[j] = *((const f32x4*)s0 + lane + 64 * j); }
    for (int r = gw; r < TA; r += NGW) {
        f32x4 v[4];
#pragma unroll
        for (int j = 0; j < 4; ++j) v[j] = nv[j];
        if (r + NGW < TA) { const int r2 = r + NGW; const float* s2 = r2 < TL ? P.in(0) + (size_t)r2 * D : P.in(2) + (size_t)(r2 - TL) * D;
#pragma unroll
            for (int j = 0; j < 4; ++j) nv[j] = *((const f32x4*)s2 + lane + 64 * j); }
#pragma unroll
        for (int j = 0; j < 4; ++j) *((f32x4*)(lat + (size_t)r * D) + lane + 64 * j) = v[j];
        const float* m = mod + (size_t)mod_row(r) * NMODC;
        write_hb(v, m, m + 1024, hb + (size_t)r * D, lane);
    }
}
__device__ __forceinline__ void phase_ln(const PV& P, int M, const float* g, const float* b, const float* nmod  , int qshift, float* outp,
                                         const float* slabs, const float* gate8  , float wres) {
    const int lane = P.tid & 63, wave = P.tid >> 6, gw = P.bid * 8 + wave, NGW = P.gsz * 8;
    float* lat = (float*)(P.ws() + OFF_LAT); bf16_t* hb = (bf16_t*)(P.ws() + OFF_HB);
    f32x4 gg[4], bb[4];
#pragma unroll
    for (int j = 0; j < 4; ++j) { gg[j] = *((const f32x4*)g + lane + 64 * j); bb[j] = *((const f32x4*)b + lane + 64 * j); }
    f32x4 nv[4];
    if (gw < M) {
#pragma unroll
        for (int j = 0; j < 4; ++j) nv[j] = *((const f32x4*)(lat + (size_t)gw * D) + lane + 64 * j);
    }
    for (int r = gw; r < M; r += NGW) {
        float* row = lat + (size_t)r * D;
        f32x4 v[4];
#pragma unroll
        for (int j = 0; j < 4; ++j) v[j] = nv[j];
        if (r + NGW < M) {
#pragma unroll
            for (int j = 0; j < 4; ++j) nv[j] = *((const f32x4*)(lat + (size_t)(r + NGW) * D) + lane + 64 * j);
        }
        if (slabs && r >= TL) {
#pragma unroll
            for (int j = 0; j < 4; ++j) {
                f32x4 s = (f32x4){0.f, 0.f, 0.f, 0.f};
#pragma unroll
                for (int k = 0; k < 8; ++k) s += *((const f32x4*)(slabs + ((size_t)k * TC + (r - TL)) * D) + lane + 64 * j);
                const f32x4 gt = *((const f32x4*)gate8 + lane + 64 * j);
                v[j] = v[j] * DN_ALPHA + (gt + 1.0f) * wres * s;
            }
        }
        f32x4 shv[4], scv[4];
        if (!outp) { const float* m = nmod + (size_t)mod_row(r) * NMODC + qshift * 1024;
#pragma unroll
            for (int j = 0; j < 4; ++j) { shv[j] = *((const f32x4*)m + lane + 64 * j); scv[j] = *((const f32x4*)(m + 1024) + lane + 64 * j); } }
        {
            float s = 0.f;
#pragma unroll
            for (int j = 0; j < 4; ++j) s += (v[j][0] + v[j][1]) + (v[j][2] + v[j][3]);
            const float mean = wave_sum(s) * (1.f / D); float s2 = 0.f;
#pragma unroll
            for (int j = 0; j < 4; ++j) { v[j] = v[j] - mean; s2 += (v[j][0] * v[j][0] + v[j][1] * v[j][1]) + (v[j][2] * v[j][2] + v[j][3] * v[j][3]); }
            const float rstd = 1.0f / sqrtf(wave_sum(s2) * (1.f / D) + LN_EPS);
#pragma unroll
            for (int j = 0; j < 4; ++j) v[j] = v[j] * rstd * gg[j] + bb[j];
        }
        if (outp) {
#pragma unroll
            for (int j = 0; j < 4; ++j) *((f32x4*)(outp + (size_t)r * D) + lane + 64 * j) = v[j];
        } else {
#pragma unroll
            for (int j = 0; j < 4; ++j) *((f32x4*)row + lane + 64 * j) = v[j];
#pragma unroll
            for (int j = 0; j < 4; ++j) { const f32x4 o = v[j] * (scv[j] + 1.0f) + shv[j]; u32x2 w; w.x = cvt_pk_bf16(o[0], o[1]); w.y = cvt_pk_bf16(o[2], o[3]);
                *((u32x2*)(hb + (size_t)r * D) + lane + 64 * j) = w; }
        }
    }
}

__device__ __forceinline__ void phase_attention(const PV& P, LAS unsigned char* lds, int j_attn, float lam_init, bool ctx_q) {
    const int tid = P.tid, lane = tid & 63, wave = __builtin_amdgcn_readfirstlane(tid >> 6), g = lane >> 4, q16 = lane & 15;
    const bf16_t* qk = (const bf16_t*)(P.ws() + OFF_QK); const bf16_t* vt = (const bf16_t*)(P.ws() + OFF_VT); bf16_t* ao = (bf16_t*)(P.ws() + OFF_AO);
    const float* lam = P.in(12) + j_attn * 256; const float* subg = P.in(13) + j_attn * 128;
    const float lam_full = expf(wave_sum(lam[lane] * lam[64 + lane])) - expf(wave_sum(lam[128 + lane] * lam[192 + lane])) + lam_init;
    constexpr int KROW = 272, VROW = 144;
    constexpr int ABUF = 64 * KROW + 128 * VROW;
    const float sc = 0.125f * 1.4426950408889634f;
    const int NU = 1024 + (ctx_q ? 128 : 0);
    for (int uidx = P.bid; uidx < NU; uidx += P.gsz) {
        int b, h, qrow0, ntiles;
        if (uidx < 1024) { b = uidx >> 7; h = (uidx >> 4) & 7; qrow0 = b * SEQ + (uidx & 15) * 128; ntiles = 36; }
        else { const int u2 = uidx - 1024; b = u2 >> 4; h = (u2 >> 1) & 7; qrow0 = TL + b * CTXL + (u2 & 1) * 128; ntiles = 4; }
        bf16x8 qf[2][2];
        { const bf16_t* qp = qk + (size_t)(qrow0 + wave * 16 + q16) * 2048 + h * 128 + 8 * g;
#pragma unroll
          for (int mp = 0; mp < 2; ++mp)
#pragma unroll
              for (int kk = 0; kk < 2; ++kk) { const u32x4 qw = *(const u32x4*)(qp + mp * 64 + kk * 32); u32x4 qs;
#pragma unroll
                  for (int e = 0; e < 4; ++e) qs[e] = cvt_pk_bf16_m(bflo(qw[e]) * sc, bfhi(qw[e]) * sc);
                  qf[mp][kk] = __builtin_bit_cast(bf16x8, qs); } }
        f32x4 accO[2][8];
#pragma unroll
        for (int mp = 0; mp < 2; ++mp)
#pragma unroll
            for (int nt = 0; nt < 8; ++nt) accO[mp][nt] = (f32x4){0.f, 0.f, 0.f, 0.f};
        float mrun[2] = {-INFINITY, -INFINITY}, lrun[2] = {0.f, 0.f};
        u32x4 stg[4];
        auto tile_tok = [&](int i) { return i < 4 ? TL + b * CTXL + 64 * i : b * SEQ + 64 * (i - 4); };
#define ATT_LOAD(i) do { const int tok = tile_tok(i); \
            _Pragma("unroll") for (int c2 = 0; c2 < 2; ++c2) { const int c = tid + 512 * c2; \
                stg[c2] = *(const u32x4*)(qk + (size_t)(tok + (c >> 4)) * 2048 + 1024 + h * 128 + (c & 15) * 8); \
                stg[2 + c2] = *(const u32x4*)(vt + (size_t)(h * 128 + (c >> 3)) * TA + tok + (c & 7) * 8); } } while (0)
#define ATT_STORE(bi) do { LAS unsigned char* Kw = lds + (bi) * ABUF; LAS unsigned char* Vw = Kw + 64 * KROW; \
            _Pragma("unroll") for (int c2 = 0; c2 < 2; ++c2) { const int c = tid + 512 * c2; \
                *(LAS u32x4*)(Kw + (c >> 4) * KROW + (c & 15) * 16) = stg[c2]; \
                *(LAS u32x4*)(Vw + (c >> 3) * VROW + (c & 7) * 16) = stg[2 + c2]; } } while (0)
        ATT_LOAD(0);
        ATT_STORE(0);
        __syncthreads();
        for (int it = 0; it < ntiles; ++it) {
            const LAS unsigned char* Kl = lds + (it & 1) * ABUF; const LAS unsigned char* Vl = Kl + 64 * KROW;
            if (it + 1 < ntiles) ATT_LOAD(it + 1);
            bf16x8 pf[2][2];
            const LAS unsigned char* kbase = Kl + (8 * (q16 >> 2) + (q16 & 3)) * KROW + 16 * g;
#define ATT_KF(mp, kt, kk) (*(const LAS bf16x8*)(kbase + (32 * ((kt) >> 1) + 4 * ((kt) & 1)) * KROW + (mp) * 128 + (kk) * 64))
            bf16x8 kf[2][8];
#pragma unroll
            for (int f = 0; f < 8; ++f) kf[0][f] = ATT_KF(0, f >> 1, f & 1);
#pragma unroll
            for (int mp = 0; mp < 2; ++mp) {
                f32x4 s[4];
                if (mp == 0) {
#pragma unroll
                    for (int f = 0; f < 8; ++f) kf[1][f] = ATT_KF(1, f >> 1, f & 1);
                    __builtin_amdgcn_sched_barrier(0);
                }
#pragma unroll
                for (int kk = 0; kk < 2; ++kk)
#pragma unroll
                    for (int kt = 0; kt < 4; ++kt) {
                        if (kk == 0) s[kt] = (f32x4){0.f, 0.f, 0.f, 0.f};
                        s[kt] = __builtin_amdgcn_mfma_f32_16x16x32_bf16(kf[mp][2 * kt + kk], qf[mp][kk], s[kt], 0, 0, 0);
                    }
                float mx = -INFINITY;
#pragma unroll
                for (int kt = 0; kt < 4; ++kt) mx = fmaxf(mx, fmaxf(fmaxf(s[kt][0], s[kt][1]), fmaxf(s[kt][2], s[kt][3])));
                mx = xmax32(xmax16(mx));
                const float mnew = fmaxf(mrun[mp], mx);
                const float alpha = __builtin_amdgcn_exp2f(mrun[mp] - mnew);
                mrun[mp] = mnew;
                float ps = 0.f;
#pragma unroll
                for (int kt = 0; kt < 4; ++kt) {
#pragma unroll
                    for (int j = 0; j < 4; ++j) { const float p = __builtin_amdgcn_exp2f(s[kt][j] - mnew); s[kt][j] = p; ps += p; }
                }
                lrun[mp] = lrun[mp] * alpha + ps;
                if (__any(alpha != 1.0f)) {
#pragma unroll
                    for (int nt = 0; nt < 8; ++nt) accO[mp][nt] = accO[mp][nt] * alpha;
                }
#pragma unroll
                for (int kb = 0; kb < 2; ++kb) {
                    u32x4 w;
                    w.x = cvt_pk_bf16_m(s[2 * kb][0], s[2 * kb][1]); w.y = cvt_pk_bf16_m(s[2 * kb][2], s[2 * kb][3]);
                    w.z = cvt_pk_bf16_m(s[2 * kb + 1][0], s[2 * kb + 1][1]); w.w = cvt_pk_bf16_m(s[2 * kb + 1][2], s[2 * kb + 1][3]);
                    pf[mp][kb] = __builtin_bit_cast(bf16x8, w);
                }
            }
            {
                const LAS unsigned char* vbase = Vl + q16 * VROW + 16 * g;
#define ATT_VF(f) (*(const LAS bf16x8*)(vbase + ((f) >> 1) * 16 * VROW + ((f) & 1) * 64))
                bf16x8 va[4], vn[4];
#pragma unroll
                for (int f = 0; f < 4; ++f) va[f] = ATT_VF(f);
#pragma unroll
                for (int grp = 0; grp < 4; ++grp) {
                    if (grp < 3) {
#pragma unroll
                        for (int f = 0; f < 4; ++f) vn[f] = ATT_VF(4 * (grp + 1) + f);
                    }
                    __builtin_amdgcn_sched_barrier(0);
#pragma unroll
                    for (int f = 0; f < 4; ++f) { const int nt = 2 * grp + (f >> 1), kb = f & 1;
                        accO[0][nt] = __builtin_amdgcn_mfma_f32_16x16x32_bf16(va[f], pf[0][kb], accO[0][nt], 0, 0, 0);
                        accO[1][nt] = __builtin_amdgcn_mfma_f32_16x16x32_bf16(va[f], pf[1][kb], accO[1][nt], 0, 0, 0); }
#pragma unroll
                    for (int f = 0; f < 4; ++f) va[f] = vn[f];
                }
#undef ATT_VF
            }
#undef ATT_KF
            if (it + 1 < ntiles) ATT_STORE((it + 1) & 1);
            __syncthreads();
        }
#undef ATT_LOAD
#undef ATT_STORE
        float l0 = lrun[0]; l0 += __shfl_xor(l0, 16); l0 += __shfl_xor(l0, 32);
        float l1 = lrun[1]; l1 += __shfl_xor(l1, 16); l1 += __shfl_xor(l1, 32);
        const float i0 = 1.0f / l0, i1 = lam_full / l1;
        float ss = 0.f;
#pragma unroll
        for (int nt = 0; nt < 8; ++nt) { accO[0][nt] = accO[0][nt] * i0 - accO[1][nt] * i1;
            ss += (accO[0][nt][0] * accO[0][nt][0] + accO[0][nt][1] * accO[0][nt][1]) + (accO[0][nt][2] * accO[0][nt][2] + accO[0][nt][3] * accO[0][nt][3]); }
        ss += __shfl_xor(ss, 16); ss += __shfl_xor(ss, 32);
        const float rs = (1.0f / sqrtf(ss * (1.0f / 128.0f) + LN_EPS)) * (1.0f - lam_init);
        bf16_t* op = ao + (size_t)(qrow0 + wave * 16 + q16) * D + h * 128 + 4 * g;
#pragma unroll
        for (int nt = 0; nt < 8; ++nt) { const f32x4 gg = *(const f32x4*)(subg + 16 * nt + 4 * g); const f32x4 o = accO[0][nt] * rs * gg;
            u32x2 w; w.x = cvt_pk_bf16(o[0], o[1]); w.y = cvt_pk_bf16(o[2], o[3]); *(u32x2*)(op + 16 * nt) = w; }
    }
}

__device__ __forceinline__ void phase_hy_short(const PV& P, LAS unsigned char* lds) {
    const bf16_t* hu = (const bf16_t*)(P.ws() + OFF_HU); float* x0o = (float*)(P.ws() + OFF_HX0); bf16_t* vT = (bf16_t*)(P.ws() + OFF_HVT);
    const float* cw = P.in(16); const float* cb = P.in(17);
    const int tid = P.tid;
    constexpr int RS = 264;
    const bool hoist = (P.gsz & 7) == 0;
    f32x4 hw0[3], hw1[3], hw2[3], hbb[3];
    { const int dq0 = 128 * (P.bid & 7) + 4 * (tid & 31);
#pragma unroll
      for (int part = 0; part < 3; ++part) { const int c = part * 1024 + dq0;
          hw0[part] = *(const f32x4*)(cw + c); hw1[part] = *(const f32x4*)(cw + 3072 + c); hw2[part] = *(const f32x4*)(cw + 6144 + c); hbb[part] = *(const f32x4*)(cb + c); } }
    for (int uidx = P.bid; uidx < 8 * 36 * 8; uidx += P.gsz) {
        const int db = uidx & 7, sb = (uidx >> 3) % 36, b = uidx / 288;
        const bool isl = sb < 32; const int L = isl ? SEQ : CTXL, t0 = isl ? 64 * sb : 64 * (sb - 32), rbase = isl ? b * SEQ : TL + b * CTXL, toff = isl ? 0 : SEQ;
#pragma unroll
        for (int k = 0; k < 4; ++k) {
            const int idx = tid + 512 * k, tl = idx >> 5, d4 = idx & 31, t = t0 + tl, r = rbase + t, dq = 128 * db + 4 * d4;
            const bool hp = t > 0, hn = t < L - 1;
            float res[3][4];
#pragma unroll
            for (int part = 0; part < 3; ++part) {
                const int c = part * 1024 + dq;
                const u32x2 z2 = (u32x2){0u, 0u};
                const u32x2 um = hp ? *(const u32x2*)(hu + (size_t)(r - 1) * 3072 + c) : z2;
                const u32x2 u0 = *(const u32x2*)(hu + (size_t)r * 3072 + c);
                const u32x2 up = hn ? *(const u32x2*)(hu + (size_t)(r + 1) * 3072 + c) : z2;
                f32x4 w0 = hw0[part], w1 = hw1[part], w2 = hw2[part], bb = hbb[part];
                if (!hoist) { w0 = *(const f32x4*)(cw + c); w1 = *(const f32x4*)(cw + 3072 + c); w2 = *(const f32x4*)(cw + 6144 + c); bb = *(const f32x4*)(cb + c); }
                res[part][0] = bb[0] + bflo(um.x) * w0[0] + bflo(u0.x) * w1[0] + bflo(up.x) * w2[0];
                res[part][1] = bb[1] + bfhi(um.x) * w0[1] + bfhi(u0.x) * w1[1] + bfhi(up.x) * w2[1];
                res[part][2] = bb[2] + bflo(um.y) * w0[2] + bflo(u0.y) * w1[2] + bflo(up.y) * w2[2];
                res[part][3] = bb[3] + bfhi(um.y) * w0[3] + bfhi(u0.y) * w1[3] + bfhi(up.y) * w2[3];
            }
            *(f32x4*)(x0o + (size_t)r * D + dq) = (f32x4){res[0][0], res[0][1], res[0][2], res[0][3]};
            u32x2 w; w.x = cvt_pk_bf16(res[2][0] * res[1][0], res[2][1] * res[1][1]); w.y = cvt_pk_bf16(res[2][2] * res[1][2], res[2][3] * res[1][3]);
            *(LAS u32x2*)(lds + tl * RS + d4 * 8) = w;
        }
        __syncthreads();
#pragma unroll
        for (int k = 0; k < 2; ++k) {
            const int idx = tid + 512 * k, tk = idx & 7, dl = idx >> 3;
            unsigned e[8];
#pragma unroll
            for (int j = 0; j < 8; ++j) e[j] = *(const LAS bf16_t*)(lds + (8 * tk + j) * RS + dl * 2);
            u32x4 w; w.x = e[0] | (e[1] << 16); w.y = e[2] | (e[3] << 16); w.z = e[4] | (e[5] << 16); w.w = e[6] | (e[7] << 16);
            *(u32x4*)(vT + ((size_t)(128 * db + dl) * NB + b) * HLT + toff + t0 + 8 * tk) = w;
        }
        __syncthreads();
    }
}

__device__ __forceinline__ void phase_hy_conv(const PV& P, LAS unsigned char* lds) {
    const bf16_t* vT = (const bf16_t*)(P.ws() + OFF_HVT); bf16_t* yT = (bf16_t*)(P.ws() + OFF_HYT);
    const int tid = P.tid, lane = tid & 63, wave = __builtin_amdgcn_readfirstlane(tid >> 6), g = lane >> 4, q16 = lane & 15;
    constexpr int R0_OFF = 0, R1_OFF = 8208, VT_OFF = 16416, VRS = 4112;
    for (int uidx = P.bid; uidx < 2048; uidx += P.gsz) {
        const bool isl = uidx < 1024; const int d = uidx & 1023;
        const int L = isl ? SEQ : CTXL, RL = isl ? 4096 : 512, toff = isl ? 0 : SEQ;
        const bf16_t* rsrc = isl ? (const bf16_t*)(P.ws() + OFF_KLAT) + (size_t)d * 4096 : (const bf16_t*)(P.ws() + OFF_KCTX) + (size_t)d * 512;
        for (int i = tid; i < RL / 8; i += 512) *(LAS u32x4*)(lds + R0_OFF + i * 16) = *(const u32x4*)(rsrc + 8 * i);
        for (int i = tid; i < L; i += 512) { const int bb = i / (L / 8), c = i % (L / 8);
            *(LAS u32x4*)(lds + VT_OFF + bb * VRS + c * 16) = *(const u32x4*)(vT + ((size_t)d * NB + bb) * HLT + toff + 8 * c); }
        __syncthreads();
        for (int k = tid; k < RL / 2; k += 512) {
            const unsigned hi = *(const LAS unsigned*)(lds + R0_OFF + 4 * k), lo = k > 0 ? *(const LAS unsigned*)(lds + R0_OFF + 4 * k - 4) : 0u;
            *(LAS unsigned*)(lds + R1_OFF + 4 * k) = __builtin_amdgcn_alignbit(hi, lo, 16);
        }
        __syncthreads();
        const int ntile = L / 16, nsb = L / 32, C = L - 1;
        const int tau0 = (wave & 1) + 32 * (wave >> 1);
        if (tau0 < ntile) {
            const int base0 = C - 16 * tau0 - q16 + 8 * g;
            const int sel = (q16 & 1) ? R0_OFF : (R1_OFF + 2);
#define HC_FRAG(dst, f) do { int eb = base0 - 32 * (f); eb = eb < 0 ? (eb & 1) : eb; const LAS unsigned* p_ = (const LAS unsigned*)(lds + sel + eb * 2); \
            u32x4 w_; w_.x = p_[0]; w_.y = p_[1]; w_.z = p_[2]; w_.w = p_[3]; dst = __builtin_bit_cast(bf16x8, w_); } while (0)
            f32x4 acc[16]; bf16x8 fr[16];
#pragma unroll
            for (int i = 0; i < 16; ++i) acc[i] = (f32x4){0.f, 0.f, 0.f, 0.f};
#pragma unroll
            for (int i = 1; i < 16; ++i) HC_FRAG(fr[i], i);
            const LAS unsigned char* vrow = lds + VT_OFF + (q16 & 7) * VRS + 16 * g;
            for (int sb0 = 0; sb0 < nsb; sb0 += 16) {
#pragma unroll
                for (int u = 0; u < 16; ++u) {
                    const int sbk = sb0 + u;
                    if (sbk < nsb) {
                        HC_FRAG(fr[(16 - u) & 15], -sbk);
                        const bf16x8 bv = *(const LAS bf16x8*)(vrow + sbk * 64);
#pragma unroll
                        for (int i = 0; i < 16; ++i) acc[i] = __builtin_amdgcn_mfma_f32_16x16x32_bf16(fr[(i - u) & 15], bv, acc[i], 0, 0, 0);
                    }
                }
            }
#undef HC_FRAG
            if (q16 < 8) {
                bf16_t* yp = yT + ((size_t)d * NB + q16) * HLT + toff + 4 * g;
#pragma unroll
                for (int i = 0; i < 16; ++i) { const int tau = tau0 + 2 * i;
                    if (tau < ntile) { u32x2 w; w.x = cvt_pk_bf16(acc[i][0], acc[i][1]); w.y = cvt_pk_bf16(acc[i][2], acc[i][3]); *(u32x2*)(yp + 16 * tau) = w; } }
            }
        }
        __syncthreads();
    }
}

__device__ __forceinline__ void phase_hy_gate(const PV& P, LAS unsigned char* lds) {
    const bf16_t* yT = (const bf16_t*)(P.ws() + OFF_HYT); const float* x0 = (const float*)(P.ws() + OFF_HX0); bf16_t* gout = (bf16_t*)(P.ws() + OFF_HG);
    const int tid = P.tid;
    constexpr int RS = 264;
    for (int uidx = P.bid; uidx < 8 * 36 * 8; uidx += P.gsz) {
        const int db = uidx & 7, sb = (uidx >> 3) % 36, b = uidx / 288;
        const bool isl = sb < 32; const int t0 = isl ? 64 * sb : 64 * (sb - 32), rbase = isl ? b * SEQ : TL + b * CTXL, toff = isl ? 0 : SEQ;
#pragma unroll
        for (int k = 0; k < 2; ++k) {
            const int idx = tid + 512 * k, tk = idx & 7, dl = idx >> 3;
            const u32x4 w = *(const u32x4*)(yT + ((size_t)(128 * db + dl) * NB + b) * HLT + toff + t0 + 8 * tk);
#pragma unroll
            for (int j = 0; j < 4; ++j) { *(LAS bf16_t*)(lds + (8 * tk + 2 * j) * RS + dl * 2) = (bf16_t)(w[j] & 0xffffu); *(LAS bf16_t*)(lds + (8 * tk + 2 * j + 1) * RS + dl * 2) = (bf16_t)(w[j] >> 16); }
        }
        __syncthreads();
#pragma unroll
        for (int k = 0; k < 4; ++k) {
            const int idx = tid + 512 * k, tl = idx >> 5, d4 = idx & 31, r = rbase + t0 + tl, dq = 128 * db + 4 * d4;
            const u32x2 yv = *(const LAS u32x2*)(lds + tl * RS + d4 * 8);
            const f32x4 xv = *(const f32x4*)(x0 + (size_t)r * D + dq);
            u32x2 w; w.x = cvt_pk_bf16(bflo(yv.x) * xv[0], bfhi(yv.x) * xv[1]); w.y = cvt_pk_bf16(bflo(yv.y) * xv[2], bfhi(yv.y) * xv[3]);
            *(u32x2*)(gout + (size_t)r * D + dq) = w;
        }
        __syncthreads();
    }
}

__device__ __forceinline__ float softplus_f(float x) { return x > 20.f ? x : log1pf(expf(x)); }
__device__ __forceinline__ void phase_ssm_scan(const PV& P, LAS unsigned char* lds) {
    const bf16_t* zx = (const bf16_t*)(P.ws() + OFF_ZX); float* Y = (float*)(P.ws() + OFF_Y); const bf16_t* bcact = (const bf16_t*)(P.ws() + OFF_HB);
    const float* cw = P.in(27); const float* cb = P.in(28); const float* dtb = P.in(29); const float* alog = P.in(30); const float* dsk = P.in(31);
    const int tid = P.tid, lane = tid & 63, wave = __builtin_amdgcn_readfirstlane(tid >> 6), g = lane >> 4, q16 = lane & 15;
    constexpr int RS = 272;
    LAS unsigned char* BS = lds;
    LAS unsigned char* CS = lds + 128 * RS;
    LAS unsigned char* BT = lds + 256 * RS;
    LAS unsigned char* XT = lds + 384 * RS;
    LAS unsigned char* ST = lds + 448 * RS;
    LAS float* csf = (LAS float*)(lds + 512 * RS);
    LAS float* dtf = csf + 128;
    for (int uidx = P.bid; uidx < 256; uidx += P.gsz) {
        const int b = uidx >> 5, h = uidx & 31, grp = h >> 3;
        const float Dh = dsk[h];
        for (int dir = 0; dir < 2; ++dir) {
            const float av = -expf(alog[dir * 32 + h]), dtbias = dtb[dir * 32 + h];
            f32x4 st[4];
#pragma unroll
            for (int i = 0; i < 4; ++i) st[i] = (f32x4){0.f, 0.f, 0.f, 0.f};
            u32x4 rawX[2][3], rawC[8]; float dtr0 = 0.f, dtr1 = 0.f;
#define SC_GEO(cx, ccx, Lx, basex) const int ccx = (cx) < 2 ? (cx) : (cx) - 2, Lx = (cx) < 2 ? CTXL : SEQ, basex = (cx) < 2 ? TL + b * CTXL : b * SEQ
#define SC_ROWX(l, ccx, Lx) (dir == 0 ? 128 * (ccx) + (l) : (Lx) - 1 - 128 * (ccx) - (l))
#define SC_FETCH(ccx, Lx, basex) do { \
            _Pragma("unroll") for (int k = 0; k < 2; ++k) { const int it = tid + 512 * k; const int l = it & 127, gi = __builtin_amdgcn_readfirstlane(it >> 7); \
                const int t = SC_ROWX(l, ccx, Lx); const u32x4 z4 = (u32x4){0u, 0u, 0u, 0u}; \
                const bf16_t* bp = zx + (size_t)((basex) + t) * SSM_IN + 2048 + h * 64 + 8 * gi; \
                rawX[k][0] = t > 0 ? *(const u32x4*)(bp - SSM_IN) : z4; rawX[k][1] = *(const u32x4*)bp; rawX[k][2] = t < (Lx) - 1 ? *(const u32x4*)(bp + SSM_IN) : z4; } \
            _Pragma("unroll") for (int k = 2; k < 10; ++k) { const int it = tid + 512 * k; const int l = it & 127, gi = __builtin_amdgcn_readfirstlane(it >> 7); \
                const int t = SC_ROWX(l, ccx, Lx); \
                const int bcol = gi < 24 ? grp * 128 + 8 * (gi - 8) : 512 + grp * 128 + 8 * (gi - 24); \
                rawC[k - 2] = *(const u32x4*)(bcact + (size_t)((basex) + t) * 1024 + bcol); } } while (0)
#define SC_FETCH_DT(ccx, Lx, basex) do { if (wave < 2) { \
                dtr0 = bf2f(zx[(size_t)((basex) + SC_ROWX(64 * wave + lane, ccx, Lx)) * SSM_IN + 5120 + dir * 32 + h]); \
                if (wave == 1) dtr1 = bf2f(zx[(size_t)((basex) + SC_ROWX(lane, ccx, Lx)) * SSM_IN + 5120 + dir * 32 + h]); } } while (0)
#define SC_STAGE() do { \
            _Pragma("unroll") for (int k = 0; k < 2; ++k) { const int it = tid + 512 * k; const int l = it & 127, gi = __builtin_amdgcn_readfirstlane(it >> 7); \
                float o[8]; const int xc = h * 64 + 8 * gi; \
                _Pragma("unroll") for (int e2 = 0; e2 < 4; ++e2) { \
                    const unsigned wm = rawX[k][0][e2], w0 = rawX[k][1][e2], wp = rawX[k][2][e2]; \
                    const f32x2 c0 = *(const f32x2*)(cw + xc + 2 * e2), c1 = *(const f32x2*)(cw + 3072 + xc + 2 * e2), c2 = *(const f32x2*)(cw + 6144 + xc + 2 * e2), cbv = *(const f32x2*)(cb + xc + 2 * e2); \
                    o[2 * e2] = silu_f(cbv[0] + bflo(wm) * c0[0] + bflo(w0) * c1[0] + bflo(wp) * c2[0]); \
                    o[2 * e2 + 1] = silu_f(cbv[1] + bfhi(wm) * c0[1] + bfhi(w0) * c1[1] + bfhi(wp) * c2[1]); } \
                const float dtl = dtf[l]; \
                _Pragma("unroll") for (int e = 0; e < 8; ++e) *(LAS bf16_t*)(XT + (8 * gi + e) * RS + l * 2) = (bf16_t)(cvt_pk_bf16(o[e] * dtl, 0.f) & 0xffffu); \
                if (dir == 0) { float* yq = Y + (size_t)(base + SC_ROW(l)) * 2048 + h * 64 + 8 * gi; \
                    *(f32x4*)yq = (f32x4){o[0] * Dh, o[1] * Dh, o[2] * Dh, o[3] * Dh}; *(f32x4*)(yq + 4) = (f32x4){o[4] * Dh, o[5] * Dh, o[6] * Dh, o[7] * Dh}; } } \
            _Pragma("unroll") for (int k = 2; k < 10; ++k) { const int it = tid + 512 * k; const int l = it & 127, gi = __builtin_amdgcn_readfirstlane(it >> 7); \
                const u32x4 w = rawC[k - 2]; \
                if (gi < 24) { \
                    const int n0 = 8 * (gi - 8); \
                    *(LAS u32x4*)(BS + l * RS + n0 * 2) = w; \
                    const float dec = __expf(cs127 - csf[l]); \
                    _Pragma("unroll") for (int e2 = 0; e2 < 4; ++e2) { \
                        *(LAS bf16_t*)(BT + (n0 + 2 * e2) * RS + l * 2) = (bf16_t)(cvt_pk_bf16(bflo(w[e2]) * dec, 0.f) & 0xffffu); \
                        *(LAS bf16_t*)(BT + (n0 + 2 * e2 + 1) * RS + l * 2) = (bf16_t)(cvt_pk_bf16(bfhi(w[e2]) * dec, 0.f) & 0xffffu); } \
                } else { \
                    *(LAS u32x4*)(CS + l * RS + 8 * (gi - 24) * 2) = w; \
                } } } while (0)
            { SC_GEO(0, cc0, L0, base0); SC_FETCH(cc0, L0, base0); SC_FETCH_DT(cc0, L0, base0); }
#pragma unroll 1
            for (int c = 0; c < 18; ++c) {
                SC_GEO(c, cc, L, base);
#define SC_ROW(l) SC_ROWX(l, cc, L)
                if (wave < 2) {
                    const int l = 64 * wave + lane;
                    const float dtv = softplus_f(dtr0 + dtbias);
                    float x = av * dtv;
#pragma unroll
                    for (int o = 1; o < 64; o <<= 1) { const float y = __shfl_up(x, o); if (lane >= o) x += y; }
                    if (wave == 1) { const float d0 = softplus_f(dtr1 + dtbias); x += wave_sum(av * d0); }
                    csf[l] = x; dtf[l] = dtv;
                }
                __syncthreads();
                const float cs127 = csf[127];
                SC_STAGE();
                asm volatile("s_waitcnt vmcnt(0)" ::: "memory");
                __syncthreads();
                if (c + 1 < 18) { SC_GEO(c + 1, ccn, Ln, basen); SC_FETCH(ccn, Ln, basen); SC_FETCH_DT(ccn, Ln, basen); }
                {
                    const int l = 16 * wave + q16;
                    const float csl = csf[l];
                    float* yp = Y + (size_t)(base + SC_ROW(l)) * 2048 + h * 64 + 4 * g;
                    f32x4 yold[4];
#pragma unroll
                    for (int pt = 0; pt < 4; ++pt) yold[pt] = (f32x4){0.f, 0.f, 0.f, 0.f};
                    if (dir == 1) {
#pragma unroll
                        for (int pt = 0; pt < 4; ++pt) yold[pt] = *(const f32x4*)(yp + 16 * pt);
                    }
                    bf16x8 cfrag[4];
#pragma unroll
                    for (int kk = 0; kk < 4; ++kk) cfrag[kk] = *(const LAS bf16x8*)(CS + l * RS + (8 * g + 32 * kk) * 2);
                    f32x4 acc[4];
#pragma unroll
                    for (int pt = 0; pt < 4; ++pt) acc[pt] = (f32x4){0.f, 0.f, 0.f, 0.f};
                    if (c > 0) {
                        const LAS unsigned char* sbase = ST + q16 * RS + 16 * g;
                        bf16x8 sa[4], sn[4];
#pragma unroll
                        for (int kk = 0; kk < 4; ++kk) sa[kk] = *(const LAS bf16x8*)(sbase + 64 * kk);
#pragma unroll
                        for (int pt = 0; pt < 4; ++pt) {
                            if (pt < 3) {
#pragma unroll
                                for (int kk = 0; kk < 4; ++kk) sn[kk] = *(const LAS bf16x8*)(sbase + (16 * (pt + 1)) * RS + 64 * kk);
                            }
                            __builtin_amdgcn_sched_barrier(0);
#pragma unroll
                            for (int kk = 0; kk < 4; ++kk) acc[pt] = __builtin_amdgcn_mfma_f32_16x16x32_bf16(sa[kk], cfrag[kk], acc[pt], 0, 0, 0);
#pragma unroll
                            for (int kk = 0; kk < 4; ++kk) sa[kk] = sn[kk];
                        }
                        const float el = __expf(csl);
#pragma unroll
                        for (int pt = 0; pt < 4; ++pt) acc[pt] = acc[pt] * el;
                    }
                    const int nblk = (wave >> 1) + 1;
                    for (int sb = 0; sb < nblk; ++sb) {
                        f32x4 gt[2];
                        bf16x8 bfr8[8], xfr[4];
#pragma unroll
                        for (int f = 0; f < 8; ++f) { const int kt = f >> 2, kk = f & 3; const int srow = 32 * sb + 8 * (q16 >> 2) + 4 * kt + (q16 & 3);
                            bfr8[f] = *(const LAS bf16x8*)(BS + srow * RS + (8 * g + 32 * kk) * 2); }
#pragma unroll
                        for (int pt = 0; pt < 4; ++pt) xfr[pt] = *(const LAS bf16x8*)(XT + (16 * pt + q16) * RS + (32 * sb + 8 * g) * 2);
                        __builtin_amdgcn_sched_barrier(0);
#pragma unroll
                        for (int kt = 0; kt < 2; ++kt) {
                            gt[kt] = (f32x4){0.f, 0.f, 0.f, 0.f};
#pragma unroll
                            for (int kk = 0; kk < 4; ++kk) gt[kt] = __builtin_amdgcn_mfma_f32_16x16x32_bf16(bfr8[4 * kt + kk], cfrag[kk], gt[kt], 0, 0, 0);
                        }
                        const f32x4 cs0 = *(const LAS f32x4*)(csf + 32 * sb + 8 * g), cs1 = *(const LAS f32x4*)(csf + 32 * sb + 8 * g + 4);
                        float mm[8];
#pragma unroll
                        for (int j = 0; j < 4; ++j) {
                            const int s0 = 32 * sb + 8 * g + j, s1 = s0 + 4;
                            mm[j] = (s0 <= l) ? gt[0][j] * __expf(fminf(csl - cs0[j], 0.f)) : 0.f;
                            mm[4 + j] = (s1 <= l) ? gt[1][j] * __expf(fminf(csl - cs1[j], 0.f)) : 0.f;
                        }
                        u32x4 w; w.x = cvt_pk_bf16_m(mm[0], mm[1]); w.y = cvt_pk_bf16_m(mm[2], mm[3]); w.z = cvt_pk_bf16_m(mm[4], mm[5]); w.w = cvt_pk_bf16_m(mm[6], mm[7]);
                        const bf16x8 pm = __builtin_bit_cast(bf16x8, w);
#pragma unroll
                        for (int pt = 0; pt < 4; ++pt) acc[pt] = __builtin_amdgcn_mfma_f32_16x16x32_bf16(xfr[pt], pm, acc[pt], 0, 0, 0);
                    }
#pragma unroll
                    for (int pt = 0; pt < 4; ++pt) { if (dir == 0) yold[pt] = *(const f32x4*)(yp + 16 * pt); *(f32x4*)(yp + 16 * pt) = yold[pt] + acc[pt]; }
                }
                asm volatile("s_waitcnt vmcnt(0)" ::: "memory");
                __syncthreads();
                {
                    const float ec = __expf(cs127);
#pragma unroll
                    for (int pt = 0; pt < 4; ++pt) st[pt] = st[pt] * ec;
                    {
                        bf16x8 btf[4], xa[4], xn[4];
#pragma unroll
                        for (int kk = 0; kk < 4; ++kk) btf[kk] = *(const LAS bf16x8*)(BT + (16 * wave + q16) * RS + (8 * g + 32 * kk) * 2);
#pragma unroll
                        for (int pt = 0; pt < 4; ++pt) xa[pt] = *(const LAS bf16x8*)(XT + (16 * pt + q16) * RS + (8 * g) * 2);
#pragma unroll
                        for (int kk = 0; kk < 4; ++kk) {
                            if (kk < 3) {
#pragma unroll
                                for (int pt = 0; pt < 4; ++pt) xn[pt] = *(const LAS bf16x8*)(XT + (16 * pt + q16) * RS + (8 * g + 32 * (kk + 1)) * 2);
                            }
                            __builtin_amdgcn_sched_barrier(0);
#pragma unroll
                            for (int pt = 0; pt < 4; ++pt) st[pt] = __builtin_amdgcn_mfma_f32_16x16x32_bf16(xa[pt], btf[kk], st[pt], 0, 0, 0);
#pragma unroll
                            for (int pt = 0; pt < 4; ++pt) xa[pt] = xn[pt];
                        }
                    }
#pragma unroll
                    for (int pt = 0; pt < 4; ++pt)
#pragma unroll
                        for (int j = 0; j < 4; ++j) *(LAS bf16_t*)(ST + (16 * pt + 4 * g + j) * RS + (16 * wave + q16) * 2) = (bf16_t)(cvt_pk_bf16(st[pt][j], 0.f) & 0xffffu);
                }
                __syncthreads();
#undef SC_ROW
            }
#undef SC_GEO
#undef SC_ROWX
#undef SC_FETCH
#undef SC_FETCH_DT
#undef SC_STAGE
        }
    }
}
__device__ __forceinline__ void phase_ssm_bc(const PV& P) {
    const bf16_t* zx = (const bf16_t*)(P.ws() + OFF_ZX); bf16_t* bc = (bf16_t*)(P.ws() + OFF_HB);
    const float* cw = P.in(27); const float* cb = P.in(28);
    const int tid = P.tid, c8 = (tid & 127) * 8, rsub = tid >> 7;
    f32x4 w0[2], w1[2], w2[2], bb[2];
#pragma unroll
    for (int q = 0; q < 2; ++q) { w0[q] = *(const f32x4*)(cw + 2048 + c8 + 4 * q); w1[q] = *(const f32x4*)(cw + 3072 + 2048 + c8 + 4 * q); w2[q] = *(const f32x4*)(cw + 6144 + 2048 + c8 + 4 * q); bb[q] = *(const f32x4*)(cb + 2048 + c8 + 4 * q); }
    const int rstep = P.gsz * 4;
    u32x4 nm, n0, np;
#define BC_LOAD(rr) do { int t_, L_; if ((rr) < TL) { t_ = (rr) & (SEQ - 1); L_ = SEQ; } else { t_ = ((rr) - TL) & (CTXL - 1); L_ = CTXL; } \
        const bf16_t* bp_ = zx + (size_t)(rr) * SSM_IN + 4096 + c8; const u32x4 z4_ = (u32x4){0u, 0u, 0u, 0u}; \
        nm = t_ > 0 ? *(const u32x4*)(bp_ - SSM_IN) : z4_; n0 = *(const u32x4*)bp_; np = t_ < L_ - 1 ? *(const u32x4*)(bp_ + SSM_IN) : z4_; } while (0)
    if (P.bid * 4 + rsub < TA) BC_LOAD(P.bid * 4 + rsub);
    for (int r = P.bid * 4 + rsub; r < TA; r += rstep) {
        const u32x4 um = nm, u0 = n0, up = np;
        if (r + rstep < TA) BC_LOAD(r + rstep);
        float o[8];
#pragma unroll
        for (int e2 = 0; e2 < 4; ++e2) { const int q = e2 >> 1, k = (e2 & 1) * 2;
            o[2 * e2] = silu_f(bb[q][k] + bflo(um[e2]) * w0[q][k] + bflo(u0[e2]) * w1[q][k] + bflo(up[e2]) * w2[q][k]);
            o[2 * e2 + 1] = silu_f(bb[q][k + 1] + bfhi(um[e2]) * w0[q][k + 1] + bfhi(u0[e2]) * w1[q][k + 1] + bfhi(up[e2]) * w2[q][k + 1]); }
        u32x4 w; w.x = cvt_pk_bf16(o[0], o[1]); w.y = cvt_pk_bf16(o[2], o[3]); w.z = cvt_pk_bf16(o[4], o[5]); w.w = cvt_pk_bf16(o[6], o[7]);
        *(u32x4*)(bc + (size_t)r * 1024 + c8) = w;
    }
#undef BC_LOAD
}
__device__ __forceinline__ void phase_ssm_gate(const PV& P) {
    const bf16_t* zx = (const bf16_t*)(P.ws() + OFF_ZX); float* Y = (float*)(P.ws() + OFF_Y); const float* ng = P.in(32);
    const int lane = P.tid & 63, wave = P.tid >> 6, gw = P.bid * 8 + wave, NGW = P.gsz * 8;
    f32x4 ngv[8];
#pragma unroll
    for (int j = 0; j < 8; ++j) ngv[j] = *((const f32x4*)ng + lane + 64 * j);
    f32x4 ny[8]; u32x2 nz[8];
    if (gw < TA) {
#pragma unroll
        for (int j = 0; j < 8; ++j) { ny[j] = *((const f32x4*)(Y + (size_t)gw * 2048) + lane + 64 * j); nz[j] = *((const u32x2*)(zx + (size_t)gw * SSM_IN) + lane + 64 * j); }
    }
    for (int r = gw; r < TA; r += NGW) {
        float* yrow = Y + (size_t)r * 2048;
        f32x4 v[8], cy[8]; u32x2 cz[8];
#pragma unroll
        for (int j = 0; j < 8; ++j) { cy[j] = ny[j]; cz[j] = nz[j]; }
        if (r + NGW < TA) {
#pragma unroll
            for (int j = 0; j < 8; ++j) { ny[j] = *((const f32x4*)(Y + (size_t)(r + NGW) * 2048) + lane + 64 * j); nz[j] = *((const u32x2*)(zx + (size_t)(r + NGW) * SSM_IN) + lane + 64 * j); }
        }
#pragma unroll
        for (int j = 0; j < 8; ++j) { const f32x4 y = cy[j]; const u32x2 zz = cz[j];
            v[j][0] = y[0] * silu_f(bflo(zz.x)); v[j][1] = y[1] * silu_f(bfhi(zz.x)); v[j][2] = y[2] * silu_f(bflo(zz.y)); v[j][3] = y[3] * silu_f(bfhi(zz.y)); }
        float rs[4];
#pragma unroll
        for (int gq = 0; gq < 4; ++gq) { float s = 0.f;
#pragma unroll
            for (int jj = 0; jj < 2; ++jj) { const f32x4 x = v[2 * gq + jj]; s += (x[0] * x[0] + x[1] * x[1]) + (x[2] * x[2] + x[3] * x[3]); }
            rs[gq] = 1.0f / sqrtf(wave_sum(s) * (1.0f / 512.0f) + LN_EPS); }
        bf16_t* orow = (bf16_t*)yrow;
#pragma unroll
        for (int j = 0; j < 8; ++j) { const f32x4 o = v[j] * rs[j >> 1] * ngv[j];
            u32x2 w; w.x = cvt_pk_bf16(o[0], o[1]); w.y = cvt_pk_bf16(o[2], o[3]); *((u32x2*)orow + lane + 64 * j) = w; }
    }
}


#ifndef REP_ATT
#define REP_ATT 1
#endif
#ifndef REP_HL
#define REP_HL 1
#endif
#ifndef REP_SCAN
#define REP_SCAN 1
#endif
#ifndef REP_FFN1
#define REP_FFN1 1
#endif
#ifndef REP_PRO
#define REP_PRO 1
#endif
#ifndef PROBE_STAGE_MASK
#define PROBE_STAGE_MASK 0
#endif
#ifndef PROBE_KIND_MASK
#define PROBE_KIND_MASK 7
#endif
__global__ void __launch_bounds__(512, 2) fwd_megakernel(Params PK) {
    extern __shared__ __attribute__((aligned(16))) unsigned char shm[];
    LAS unsigned char* lds = (LAS unsigned char*)shm;
    cg::grid_group grid = cg::this_grid();
    bool first = true;
    const int ph_lo = PK.ph_lo, ph_hi = PK.ph_hi;
    volatile LAS unsigned* bst = (volatile LAS unsigned*)(lds + LDS_BYTES - 64);
    if (threadIdx.x < 2) bst[threadIdx.x] = 0u;
    __syncthreads();
    XcdBarrier xbar; xbar.bar = nullptr; xbar.x = 0u; xbar.st = bst;
    int nseam = 0;
    int prep = 0;
    for (int ph = ph_lo; ph < ph_hi; ) {
        int layer = 0, st = -1;
        if (ph >= 2) { layer = (ph - 2) / 12; st = (ph - 2) % 12; }
        const int kind = layer % 3, jm = layer / 3;
        if (ph >= 2 && ((st == 5 || st == 6) && kind == 0)) { ++ph; continue; }
        if (!first) {
            if (nseam == 0) { grid.sync(); xbar = xcd_barrier_post((unsigned*)(PK.ws + OFF_BAR), bst, (int)threadIdx.x); }
            else xcd_barrier(xbar, (int)threadIdx.x, gridDim.x);
            ++nseam;
        }
        first = false;
        PV P; P.ka = (KArg)__builtin_amdgcn_kernarg_segment_ptr();
        asm volatile("" : "+s"(P.ka));
        { int t_ = threadIdx.x, b_ = blockIdx.x, g_ = gridDim.x; asm volatile("" : "+v"(t_)); asm volatile("" : "+s"(b_)); asm volatile("" : "+s"(g_)); P.tid = t_; P.bid = b_; P.gsz = g_; }
        const int G = P.gsz, bid = P.bid;
        unsigned char* ws = P.ws();
        float* lat = (float*)(ws + OFF_LAT); const bf16_t* hb = (const bf16_t*)(ws + OFF_HB); const float* mod = (const float*)(ws + OFF_MOD);
        if (ph == 0) { for (int rep = 0; rep < REP_PRO; ++rep) { phase_prologue(P, lds); __syncthreads(); } ++ph; continue; }
        if (ph == 1) { phase_init(P); ++ph; continue; }
        const bool lastl = (layer == 3);
        const float* modl = mod + (size_t)layer * 9 * NMODC;
        const int Mpost = lastl ? TL : TA;
        pg8::StaticOrder S;
        switch (st) {
        case 0: case 9: {
            const int s = st == 0 ? 0 : 1; const int M = (st == 9) ? Mpost : TA;
            pg8::Gemm g{hb, (const bf16_t*)(ws + OFF_W13T) + (size_t)(layer * 2 + s) * 5632 * 1024, M, 5632, 1024, 1024};
            S.init(M, 5632, G, bid); S.setk(1024); EpiSwiglu E{(bf16_t*)(ws + OFF_ACT)};
            for (int rep = 0; rep < REP_FFN1; ++rep) pg8::gemm_phase(lds, g, S, E, P.tid);
        } break;
        case 1: case 10: {
            const int s = st == 1 ? 0 : 1; const int M = (st == 10) ? Mpost : TA;
            pg8::Gemm g{(const bf16_t*)(ws + OFF_ACT), (const bf16_t*)(ws + OFF_W2T) + (size_t)(layer * 2 + s) * 1024 * FF, M, 1024, FF, FF};
            EpiResid E{lat, modl, s == 0 ? 2 : 8, 0.5f, nullptr};
            if (M == TA) { pg8::SplitOrder<8> S2; S2.init(FF, G, bid); EpiResidSplit E2{E, (float*)(ws + OFF_SLAB)}; pg8::gemm_phase(lds, g, S2, E2, P.tid); }
            else { S.init(M, 1024, G, bid); S.setk(FF); pg8::gemm_phase(lds, g, S, E, P.tid); }
        } break;
        case 2: case 8: case 11: {
            const int lidx = st == 2 ? 0 : (st == 8 ? 1 : 2);
            const bool fin = (st == 11) && lastl;
            const int Mln = st == 2 ? TA : (st == 8 ? Mpost : (lastl ? TL : TA));
            const float* nm = st == 11 ? modl + (size_t)9 * NMODC : modl;
            const int qs = st == 2 ? 3 : (st == 8 ? 6 : 0);
            const bool comb = (st == 2) || (st == 11 && !lastl);
            const float* sl = comb ? (const float*)(ws + OFF_SLAB) : nullptr;
            const float* g8 = modl + (size_t)8 * NMODC + (st == 2 ? 2 : 8) * 1024;
            phase_ln(P, Mln, P.in(6) + (size_t)(layer * 3 + lidx) * D, P.in(7) + (size_t)(layer * 3 + lidx) * D, nm, qs, fin ? P.out() : nullptr, sl, g8, 0.5f);
        } break;
        case 3: {
            if (kind == 0) {
                { pg8::Gemm g{hb, (const bf16_t*)(ws + OFF_WQKT) + (size_t)jm * 2048 * 1024, TA, 2048, 1024, 1024};
                  S.init(TA, 2048, G, bid); S.setk(1024); EpiQK E{(bf16_t*)(ws + OFF_QK), (const float*)(ws + OFF_ROPE)};
                  pg8::gemm_phase(lds, g, S, E, P.tid); }
                { pg8::Gemm g{(const bf16_t*)(ws + OFF_WVT) + (size_t)jm * 1024 * 1024, hb, 1024, TA, 1024, 1024};
                  S.init(1024, TA, G, bid); S.setk(1024); EpiB E{(bf16_t*)(ws + OFF_VT), TA, nullptr, TA};
                  pg8::gemm_phase(lds, g, S, E, P.tid); }
            } else if (kind == 1) {
                pg8::Gemm g{hb, (const bf16_t*)(ws + OFF_WHIT), TA, 3072, 1024, 1024};
                S.init(TA, 3072, G, bid); S.setk(1024); EpiB E{(bf16_t*)(ws + OFF_HU), 3072, P.in(15), 3072};
                pg8::gemm_phase(lds, g, S, E, P.tid);
            } else {
                pg8::Gemm g{hb, (const bf16_t*)(ws + OFF_WSIT), TA, SSM_INP, 1024, 1024};
                S.init(TA, SSM_INP, G, bid); S.setk(1024); EpiB E{(bf16_t*)(ws + OFF_ZX), SSM_IN, nullptr, SSM_IN};
                pg8::gemm_phase(lds, g, S, E, P.tid);
            }
        } break;
        case 4: {
            if (kind == 0) { for (int rep = 0; rep < REP_ATT; ++rep) phase_attention(P, lds, jm, layer == 0 ? 0.2f : (0.8f - 0.6f * 0.40656965974059917f), !lastl); }
            else if (kind == 1) phase_hy_short(P, lds);
            else phase_ssm_bc(P);
        } break;
        case 5: {
            if (kind == 1) phase_hy_conv(P, lds);
            else phase_ssm_scan(P, lds);
        } break;
        case 6: if (kind == 1) phase_hy_gate(P, lds); else phase_ssm_gate(P); break;
        case 7: {
            const bf16_t* Ap = kind == 0 ? (const bf16_t*)(ws + OFF_AO) : (kind == 1 ? (const bf16_t*)(ws + OFF_HG) : (const bf16_t*)(ws + OFF_Y));
            const bf16_t* Bp = kind == 0 ? (const bf16_t*)(ws + OFF_WOT) + (size_t)jm * 1024 * 1024 : (kind == 1 ? (const bf16_t*)(ws + OFF_WHOT) : (const bf16_t*)(ws + OFF_WSOT));
            const int Mo = kind == 0 ? Mpost : TA, Ko = kind == 2 ? 2048 : 1024, ldo = kind == 2 ? 4096 : 1024;
            const float* bo = kind == 1 ? P.in(25) : nullptr;
            pg8::Gemm g{Ap, Bp, Mo, 1024, Ko, ldo};
            S.init(Mo, 1024, G, bid); S.setk(Ko); EpiResid E{lat, modl, 5, 1.0f, bo};
            pg8::gemm_phase(lds, g, S, E, P.tid);
        } break;
        default: break;
        }
        if (PROBE_STAGE_MASK && ((PROBE_STAGE_MASK >> st) & 1) && ((PROBE_KIND_MASK >> kind) & 1) && prep == 0) prep = 1; else { prep = 0; ++ph; }
    }
}

extern "C" void kernel_launch(void* const* d_in, const int* in_sizes, int n_in, void* d_out, int out_size, void* d_ws, size_t ws_size, hipStream_t stream) {
    static int grid = 0;
    if (grid == 0) {
        if (n_in != 34 || ws_size < WS_END) { fprintf(stderr, "kernel_launch: unexpected n_in %d or ws_size %zu (< %zu)\n", n_in, ws_size, (size_t)WS_END); grid = -1; return; }
        int dev = 0, cus = 0, per_cu = 0;
        (void)hipGetDevice(&dev);
        (void)hipDeviceGetAttribute(&cus, hipDeviceAttributeMultiprocessorCount, dev);
        if (hipFuncSetAttribute((const void*)fwd_megakernel, hipFuncAttributeMaxDynamicSharedMemorySize, LDS_BYTES) != hipSuccess) { fprintf(stderr, "kernel_launch: hipFuncSetAttribute failed\n"); }
        (void)hipOccupancyMaxActiveBlocksPerMultiprocessor(&per_cu, (const void*)fwd_megakernel, 512, LDS_BYTES);
        (void)hipGetLastError();
        if (per_cu < 1) { fprintf(stderr, "kernel_launch: occupancy query says %d blocks per CU\n", per_cu); per_cu = 1; }
        grid = cus;
    }
    if (grid < 0) return;
    Params p{};
    for (int i = 0; i < 34; ++i) p.in[i] = (const float*)d_in[i];
    p.out = (float*)d_out; p.ws = (unsigned char*)d_ws; p.ph_lo = 0; p.ph_hi = 2 + 48;
    void* args[] = {&p};
    hipError_t e = hipLaunchCooperativeKernel((const void*)fwd_megakernel, dim3(grid), dim3(512), args, LDS_BYTES, stream);
    if (e != hipSuccess) fprintf(stderr, "cooperative launch failed: %s (grid %d)\n", hipGetErrorString(e), grid);
}
```

```cpp
#include <hip/hip_runtime.h>
#include <hip/hip_cooperative_groups.h>
#include <cstdio>
namespace cg = cooperative_groups;

#define LAS __attribute__((address_space(3)))
typedef unsigned short bf16_t;
typedef short bf16x8 __attribute__((ext_vector_type(8)));
typedef float f32x4 __attribute__((ext_vector_type(4)));
typedef float f32x2 __attribute__((ext_vector_type(2)));
typedef unsigned u32x4 __attribute__((ext_vector_type(4)));
typedef unsigned u32x2 __attribute__((ext_vector_type(2)));

constexpr int D = 1024, FF = 2816, TL = 16384, TC = 2048, TA = 18432, SEQ = 2048, CTXL = 256, NB = 8;
constexpr int NMODC = 9216;
constexpr float DN_ALPHA = 1.681792830507429f;
constexpr float LN_EPS = 1e-5f;
constexpr int SSM_IN = 5184, SSM_INP = 5376;

constexpr size_t al256(size_t x) { return (x + 255) & ~(size_t)255; }
constexpr size_t OFF_MOD = 0;
constexpr size_t OFF_ROPE = OFF_MOD + al256((size_t)4 * 9 * NMODC * 4);
constexpr size_t OFF_BAR = OFF_ROPE + al256(2 * 1024 * 4);
constexpr size_t OFF_KLAT = OFF_BAR + 16384;
constexpr size_t OFF_KCTX = OFF_KLAT + (size_t)4096 * 1024 * 4;
constexpr size_t OFF_W13T = OFF_KCTX + (size_t)512 * 1024 * 4;
constexpr size_t OFF_W2T = OFF_W13T + (size_t)8 * 5632 * 1024 * 2;
constexpr size_t OFF_WQKT = OFF_W2T + (size_t)8 * 1024 * 2816 * 2;
constexpr size_t OFF_WVT = OFF_WQKT + (size_t)2 * 2048 * 1024 * 2;
constexpr size_t OFF_WOT = OFF_WVT + (size_t)2 * 1024 * 1024 * 2;
constexpr size_t OFF_WHIT = OFF_WOT + (size_t)2 * 1024 * 1024 * 2;
constexpr size_t OFF_WHOT = OFF_WHIT + (size_t)3072 * 1024 * 2;
constexpr size_t OFF_WSIT = OFF_WHOT + (size_t)1024 * 1024 * 2;
constexpr size_t OFF_WSOT = OFF_WSIT + (size_t)SSM_INP * 1024 * 2;
constexpr size_t OFF_LAT = OFF_WSOT + (size_t)1024 * 2048 * 2;
constexpr size_t OFF_HB = OFF_LAT + (size_t)TA * D * 4;
constexpr size_t OFF_BIG = OFF_HB + (size_t)TA * D * 2;
constexpr size_t OFF_ACT = OFF_BIG;
constexpr size_t OFF_SLAB = OFF_ACT + al256((size_t)TA * FF * 2);
constexpr size_t OFF_QK = OFF_BIG;
constexpr size_t OFF_VT = OFF_QK + (size_t)TA * 2048 * 2;
constexpr size_t OFF_AO = OFF_VT + (size_t)1024 * TA * 2;
constexpr size_t OFF_HU = OFF_BIG;
constexpr int HLT = SEQ + CTXL;
constexpr size_t OFF_HX0 = OFF_HU + (size_t)TA * 3072 * 2;
constexpr size_t OFF_HVT = OFF_HX0 + (size_t)TA * D * 4;
constexpr size_t OFF_HYT = OFF_HVT + (size_t)D * NB * HLT * 2;
constexpr size_t OFF_HG = OFF_HYT + (size_t)D * NB * HLT * 2;
constexpr size_t OFF_ZX = OFF_BIG;
constexpr size_t OFF_Y = OFF_ZX + al256((size_t)TA * SSM_IN * 2);
constexpr size_t WS_END = OFF_Y + (size_t)TA * 2048 * 4;
static_assert(OFF_HG + (size_t)TA * D * 2 <= WS_END && OFF_SLAB + (size_t)8 * TC * D * 4 <= WS_END, "ws map");
static_assert(WS_END < (size_t)720 * 1000 * 1000, "ws budget");

constexpr int LDS_BYTES = 142336;

struct Params { const float* in[34]; float* out; unsigned char* ws; int ph_lo, ph_hi; };
typedef const __attribute__((address_space(4))) unsigned char* KArg;
struct PV {
    KArg ka; int tid, bid, gsz;
    __device__ __forceinline__ const float* in(int k) const { return *(const float* const __attribute__((address_space(4)))*)(ka + 8 * k); }
    __device__ __forceinline__ float* out() const { return *(float* const __attribute__((address_space(4)))*)(ka + 8 * 34); }
    __device__ __forceinline__ unsigned char* ws() const { return *(unsigned char* const __attribute__((address_space(4)))*)(ka + 8 * 35); }
};

typedef __bf16 bf16x2_t __attribute__((ext_vector_type(2)));
__device__ __forceinline__ unsigned cvt_pk_bf16(float lo, float hi) { const f32x2 v = {lo, hi}; const bf16x2_t r = __builtin_convertvector(v, bf16x2_t); return __builtin_bit_cast(unsigned, r); }
__device__ __forceinline__ unsigned cvt_pk_bf16_m(float lo, float hi) { return cvt_pk_bf16(lo, hi); }
__device__ __forceinline__ float bf2f(unsigned short b) { return __uint_as_float(((unsigned)b) << 16); }
__device__ __forceinline__ float bflo(unsigned w) { return __uint_as_float(w << 16); }
__device__ __forceinline__ float bfhi(unsigned w) { return __uint_as_float(w & 0xffff0000u); }
__device__ __forceinline__ float wave_sum(float v) {
#pragma unroll
    for (int o = 1; o < 64; o <<= 1) v += __shfl_xor(v, o);
    return v;
}
__device__ __forceinline__ float xmax16(float x) { const u32x2 r = __builtin_amdgcn_permlane16_swap(__float_as_uint(x), __float_as_uint(x), false, false); return fmaxf(__uint_as_float(r[0]), __uint_as_float(r[1])); }
__device__ __forceinline__ float xmax32(float x) { const u32x2 r = __builtin_amdgcn_permlane32_swap(__float_as_uint(x), __float_as_uint(x), false, false); return fmaxf(__uint_as_float(r[0]), __uint_as_float(r[1])); }
__device__ __forceinline__ float silu_f(float a) { return a * __builtin_amdgcn_rcpf(1.0f + __expf(-a)); }
#define LDS_WAIT() asm volatile("s_waitcnt lgkmcnt(0)" ::: "memory")

#define XB_TMO      128
#define XB_XCNT(j)  (256  + 64 * (j))
#define XB_XSUB(j)  (1280 + 64 * (j))
#define XB_XGEN(j)  (2304 + 64 * (j))
#define XB_TOP      3328
#define XB_TOPGEN   3392
#define XCD_BAR_WORDS 3456
#define XB_SPIN_CAP (1u << 18)
__device__ __forceinline__ unsigned xb_ld(unsigned* p)              { return __hip_atomic_load(p, __ATOMIC_RELAXED, __HIP_MEMORY_SCOPE_AGENT); }
__device__ __forceinline__ unsigned xb_add(unsigned* p, unsigned v) { return __hip_atomic_fetch_add(p, v, __ATOMIC_RELAXED, __HIP_MEMORY_SCOPE_AGENT); }
__device__ __forceinline__ unsigned xb_xcc_id() { return (unsigned)__builtin_amdgcn_s_getreg((3 << 11) | 20) & 0xFu; }
#define XB_SPIN(cond, bar) do { unsigned _sp = 0; while (cond) { __builtin_amdgcn_s_sleep(1); \
    if ((++_sp & 255u) == 0u) { if (xb_ld(&(bar)[XB_TMO])) break; if (_sp > XB_SPIN_CAP) { atomicAdd(&(bar)[XB_TMO], 1u); break; } } } } while (0)
struct XcdBarrier { unsigned* bar; unsigned x; volatile LAS unsigned* st; };
__device__ __forceinline__ XcdBarrier xcd_barrier_post(unsigned* bar, volatile LAS unsigned* st, int tid) {
    XcdBarrier b; b.bar = bar; b.x = xb_xcc_id(); b.st = st;
    if (tid == 0) (void)xb_add(&bar[XB_XCNT(b.x)], 1u);
    return b;
}
__device__ __forceinline__ void xcd_barrier_complete(unsigned* bar, unsigned x, unsigned G, unsigned& nloc, unsigned& nx) {
    unsigned sum, cnt, mine, sp = 0u;
    for (;;) {
        sum = 0u; cnt = 0u; mine = 0u;
#pragma unroll
        for (unsigned j = 0; j < 16; ++j) { const unsigned c = xb_ld(&bar[XB_XCNT(j)]); sum += c; cnt += (c > 0u) ? 1u : 0u; mine = (j == x) ? c : mine; }
        if (sum == G) break;
        __builtin_amdgcn_s_sleep(1);
        if ((++sp & 255u) == 0u) { if (xb_ld(&bar[XB_TMO])) break; if (sp > XB_SPIN_CAP) { atomicAdd(&bar[XB_TMO], 1u); break; } }
    }
    nloc = mine > 0u ? mine : 1u; nx = cnt > 0u ? cnt : 1u;
}
__device__ __forceinline__ void xcd_barrier(const XcdBarrier& b, int tid, unsigned G) {
    asm volatile("s_waitcnt vmcnt(0)" ::: "memory");
    __syncthreads();
    if (tid == 0) {
        unsigned* bar = b.bar;
        __builtin_amdgcn_s_waitcnt(0);
        unsigned nloc = b.st[0], nx = b.st[1];
        if (nloc == 0u) { xcd_barrier_complete(bar, b.x, G, nloc, nx); b.st[0] = nloc; b.st[1] = nx; }
        const unsigned old = xb_add(&bar[XB_XSUB(b.x)], 1u);
        const unsigned gen = old / nloc;
        if (old + 1u == (gen + 1u) * nloc) {
            __builtin_amdgcn_fence(__ATOMIC_RELEASE, "agent");
            asm volatile("s_waitcnt vmcnt(0)" ::: "memory");
            const unsigned og = xb_add(&bar[XB_TOP], 1u);
            const unsigned tg = og / nx;
            if (og + 1u == (tg + 1u) * nx) xb_add(&bar[XB_TOPGEN], 1u);
            else XB_SPIN(xb_ld(&bar[XB_TOPGEN]) == tg, bar);
            __builtin_amdgcn_fence(__ATOMIC_ACQUIRE, "agent");
            xb_add(&bar[XB_XGEN(b.x)], 1u);
            asm volatile("s_waitcnt vmcnt(0)" ::: "memory");
        } else {
            XB_SPIN(xb_ld(&bar[XB_XGEN(b.x)]) == gen, bar);
            __builtin_amdgcn_fence(__ATOMIC_ACQUIRE, "agent");
            asm volatile("s_waitcnt vmcnt(0)" ::: "memory");
        }
    }
    __syncthreads();
}


namespace pg8 {
constexpr int BM = 256, BK = 64, HALF = 128, HTB = HALF * BK * 2, STAGE_BYTES = 8 * HTB, NXCD = 8, WGM = 8;
__device__ __forceinline__ int lds_byte(int r, int c) { const int st = (r >> 4) * 2 + (c >> 5), rr = r & 15, cc = c & 31, ob = rr * 64 + cc * 2; return st * 1024 + (ob ^ (((ob >> 9) & 1) << 5)); }
__device__ __forceinline__ void stage_rc(int b, int& R, int& C) { const int st = b / 1024, sb = b % 1024, swz = sb ^ (((sb >> 9) & 1) << 5); R = (st >> 1) * 16 + swz / 64; C = (st & 1) * 32 + (swz % 64) / 2; }
__device__ __forceinline__ int perm32(int rho) { const int n = rho >> 4, i = rho & 15; return 8 * (i >> 2) + 4 * n + (i & 3); }
struct Unit { int pm, pn, kt0, nt, ks; };
struct Gemm { const bf16_t* A; const bf16_t* Bt; int M, N, K, lda; };
struct StaticOrder {
    int nM, nN, nwg, G, c, ntk;
    __device__ void init(int M, int N, int G_, int c_) { nM = M / BM; nN = N / BM; nwg = nM * nN; G = G_; c = c_; ntk = 0; }
    __device__ void setk(int K) { ntk = K / BK; }
    __device__ bool next(int i, Unit& u) const {
        const long L = (long)i * G + c; if (L >= nwg) return false;
        int wgid = (int)L; { const int q = nwg / NXCD, r = nwg % NXCD, xcd = wgid % NXCD, off = wgid / NXCD; wgid = (xcd < r ? xcd * (q + 1) : r * (q + 1) + (xcd - r) * q) + off; }
        const int nig = WGM * nN, gid = wgid / nig, fm = gid * WGM, gsz = (nM - fm) < WGM ? (nM - fm) : WGM;
        u.pm = fm + ((wgid % nig) % gsz); u.pn = (wgid % nig) / gsz; u.kt0 = 0; u.nt = ntk; u.ks = -1; return true;
    }
};
template <int NSL> struct SplitOrder {
    int G, c, ntk;
    __device__ void init(int K, int G_, int c_) { G = G_; c = c_; ntk = K / BK; }
    __device__ bool next(int i, Unit& u) const {
        const int L = i * G + c;
        if (L >= 256 + 32 * NSL) return false;
        if (L < 256) {
            const int xcd = L & 7, off = L >> 3;
            u.pm = 8 * xcd + (off & 7); u.pn = off >> 3; u.kt0 = 0; u.nt = ntk; u.ks = -1;
        } else {
            const int j = L - 256, ks = j % NSL, tile = j / NSL;
            const int np = ntk / 2, q = np / NSL, r = np % NSL;
            const int p0 = ks * q + (ks < r ? ks : r), pc = q + (ks < r ? 1 : 0);
            u.pm = 64 + (tile >> 2); u.pn = tile & 3; u.kt0 = 2 * p0; u.nt = 2 * pc; u.ks = ks;
        }
        return true;
    }
};

template <class Epi, class Sched>
__device__ __forceinline__ void gemm_phase(LAS unsigned char* lds, const Gemm g, const Sched& S, const Epi& E, const int tid_in) {
    const int tid = tid_in, wid = __builtin_amdgcn_readfirstlane(tid >> 6), lane = tid & 63, wr = wid >> 2, wc = wid & 3, fr = lane & 15, fq = lane >> 4;
    const int K = g.K, lda = g.lda;
    unsigned voffA[2], voffB[2];
#pragma unroll
    for (int i = 0; i < 2; ++i) { int R, C; stage_rc(tid * 16 + i * 8192, R, C); const int Rb = Epi::PERM ? ((R & ~31) + perm32(R & 31)) : R;
        voffA[i] = (unsigned)(R * lda + C) * 2u; voffB[i] = (unsigned)(Rb * K + C) * 2u; }
    const size_t kstep = (size_t)(BK * 2);
    const size_t hstepA = (size_t)HALF * lda * 2, hstepB = (size_t)HALF * K * 2;
    const size_t tstepA = 2 * hstepA, tstepB = 2 * hstepB;
    const unsigned ldsw = (unsigned)wid * 1024u;
    const int aoff = lds_byte(wr * 64 + fr, fq * 8), boff = lds_byte(wc * 32 + fr, fq * 8);
#define PG8_SA(b, h) (((b) * 2 + (h)) * HTB)
#define PG8_SB(b, h) ((4 + (b) * 2 + (h)) * HTB)
#define PG8_STAGE(bufoff, gbase, voff) do { _Pragma("unroll") for (int _i = 0; _i < 2; ++_i) \
        __builtin_amdgcn_global_load_lds((const unsigned*)((const char*)(gbase) + (voff)[_i]), (LAS unsigned*)(lds + (bufoff) + ldsw + _i * 8192), 16, 0, 0); } while (0)
#define PG8_LDA(dst, b, h) do { _Pragma("unroll") for (int m = 0; m < 4; ++m) _Pragma("unroll") for (int k = 0; k < 2; ++k) dst[m][k] = *(const LAS bf16x8*)(lds + PG8_SA(b, h) + aoff + m * 2048 + k * 1024); } while (0)
#define PG8_LDB(dst, b, h) do { _Pragma("unroll") for (int n = 0; n < 2; ++n) _Pragma("unroll") for (int k = 0; k < 2; ++k) dst[n][k] = *(const LAS bf16x8*)(lds + PG8_SB(b, h) + boff + n * 2048 + k * 1024); } while (0)
#define PG8_MMA(ai, bj, At, Bt) do { __builtin_amdgcn_s_setprio(1); _Pragma("unroll") for (int m = 0; m < 4; ++m) _Pragma("unroll") for (int n = 0; n < 2; ++n) _Pragma("unroll") for (int k = 0; k < 2; ++k) \
        acc[ai][bj][m][n] = __builtin_amdgcn_mfma_f32_16x16x32_bf16(Bt[n][k], At[m][k], acc[ai][bj][m][n], 0, 0, 0); __builtin_amdgcn_s_setprio(0); } while (0)
#define PG8_WAIT_V(n) asm volatile("s_waitcnt vmcnt(" #n ")" ::: "memory")
#define PG8_WAIT_L(n) asm volatile("s_waitcnt lgkmcnt(" #n ")" ::: "memory")
#define PG8_BAR __builtin_amdgcn_s_barrier()
#define PG8_SCHED __builtin_amdgcn_sched_barrier(0)
    Unit cur, nxt; int ui = 0;
    if (!S.next(0, cur)) return;
    f32x4 acc[2][2][4][2];
#pragma unroll
    for (int a = 0; a < 2; ++a)
#pragma unroll
        for (int b = 0; b < 2; ++b)
#pragma unroll
            for (int m = 0; m < 4; ++m)
#pragma unroll
                for (int n = 0; n < 2; ++n) acc[a][b][m][n] = (f32x4){0.f, 0.f, 0.f, 0.f};
    bf16x8 At[4][2], B0[2][2], B1[2][2];
    const char* cA = (const char*)g.A + (size_t)cur.pm * tstepA + (size_t)cur.kt0 * kstep; const char* cB = (const char*)g.Bt + (size_t)cur.pn * tstepB + (size_t)cur.kt0 * kstep;
    PG8_STAGE(PG8_SB(0, 0), cB, voffB); PG8_STAGE(PG8_SB(0, 1), cB + hstepB, voffB); PG8_STAGE(PG8_SA(0, 0), cA, voffA); PG8_STAGE(PG8_SA(0, 1), cA + hstepA, voffA);
    if (wr == 1) PG8_BAR;
    PG8_WAIT_V(2); PG8_BAR;
    PG8_STAGE(PG8_SB(1, 0), cB + kstep, voffB); PG8_STAGE(PG8_SA(1, 0), cA + kstep, voffA); PG8_STAGE(PG8_SB(1, 1), cB + hstepB + kstep, voffB);
    PG8_WAIT_V(6); PG8_BAR;
    for (;;) {
        const bool has_next = S.next(ui + 1, nxt);
        const char* nA = has_next ? (const char*)g.A + (size_t)nxt.pm * tstepA + (size_t)nxt.kt0 * kstep : cA; const char* nB = has_next ? (const char*)g.Bt + (size_t)nxt.pn * tstepB + (size_t)nxt.kt0 * kstep : cB;
        const int nt = cur.nt;
        for (int t = 0; t < nt; t += 2) {
            const bool last = (t == nt - 2);
            const char* a1 = cA + (size_t)(t + 1) * kstep;
            const char* a2 = last ? nA : cA + (size_t)(t + 2) * kstep; const char* b2 = last ? nB : cB + (size_t)(t + 2) * kstep;
            const char* a3 = a2 + kstep; const char* b3 = b2 + kstep;
            PG8_LDB(B0, 0, 0); PG8_LDB(B1, 0, 1); PG8_SCHED; PG8_LDA(At, 0, 0); PG8_STAGE(PG8_SA(1, 1), a1 + hstepA, voffA);
            PG8_WAIT_V(8); PG8_WAIT_L(0); PG8_BAR; PG8_MMA(0, 0, At, B0); PG8_MMA(0, 1, At, B1); PG8_BAR; PG8_SCHED;
            PG8_LDA(At, 0, 1); PG8_STAGE(PG8_SB(0, 0), b2, voffB); PG8_STAGE(PG8_SB(0, 1), b2 + hstepB, voffB); PG8_STAGE(PG8_SA(0, 0), a2, voffA);
            PG8_WAIT_V(8); PG8_WAIT_L(0); PG8_BAR; PG8_MMA(1, 0, At, B0); PG8_MMA(1, 1, At, B1); PG8_BAR; PG8_SCHED;
            PG8_LDB(B0, 1, 0); PG8_LDB(B1, 1, 1); PG8_SCHED; PG8_LDA(At, 1, 0); PG8_STAGE(PG8_SA(0, 1), a2 + hstepA, voffA);
            PG8_WAIT_V(8); PG8_WAIT_L(0); PG8_BAR; PG8_MMA(0, 0, At, B0); PG8_MMA(0, 1, At, B1); PG8_BAR; PG8_SCHED;
            PG8_LDA(At, 1, 1); PG8_STAGE(PG8_SB(1, 0), b3, voffB); PG8_STAGE(PG8_SB(1, 1), b3 + hstepB, voffB); PG8_STAGE(PG8_SA(1, 0), a3, voffA);
            PG8_WAIT_V(8); PG8_WAIT_L(0); PG8_BAR; PG8_MMA(1, 0, At, B0); PG8_MMA(1, 1, At, B1); PG8_BAR; PG8_SCHED;
        }
        if (wr == 0) PG8_BAR;
        E(acc, cur, wr, wc, fr, fq);
        if (!has_next) break;
#pragma unroll
        for (int a = 0; a < 2; ++a)
#pragma unroll
            for (int b = 0; b < 2; ++b)
#pragma unroll
                for (int m = 0; m < 4; ++m)
#pragma unroll
                    for (int n = 0; n < 2; ++n) acc[a][b][m][n] = (f32x4){0.f, 0.f, 0.f, 0.f};
        cur = nxt; cA = nA; cB = nB; ++ui;
        if (wr == 1) PG8_BAR;
    }
    PG8_WAIT_V(0);
    PG8_BAR;
#undef PG8_SA
#undef PG8_SB
#undef PG8_STAGE
#undef PG8_LDA
#undef PG8_LDB
#undef PG8_MMA
#undef PG8_WAIT_V
#undef PG8_WAIT_L
#undef PG8_BAR
#undef PG8_SCHED
}
}
using pg8::Unit;
typedef f32x4 AccT[2][2][4][2];

struct EpiSwiglu {
    static constexpr bool PERM = true;
    bf16_t* O;
    __device__ __forceinline__ void operator()(const AccT& acc, const Unit& u, int wr, int wc, int fr, int fq) const {
        const int row0 = u.pm * 256 + wr * 64 + fr, col0 = u.pn * 128 + wc * 32 + 8 * fq;
#pragma unroll
        for (int ai = 0; ai < 2; ++ai)
#pragma unroll
            for (int m = 0; m < 4; ++m) {
                bf16_t* rowp = O + (size_t)(row0 + ai * 128 + m * 16) * FF + col0;
                const f32x4 a0 = acc[ai][0][m][0], a1 = acc[ai][0][m][1], u0 = acc[ai][1][m][0], u1 = acc[ai][1][m][1];
                u32x4 w;
                w.x = cvt_pk_bf16(silu_f(a0[0]) * u0[0], silu_f(a0[1]) * u0[1]);
                w.y = cvt_pk_bf16(silu_f(a0[2]) * u0[2], silu_f(a0[3]) * u0[3]);
                w.z = cvt_pk_bf16(silu_f(a1[0]) * u1[0], silu_f(a1[1]) * u1[1]);
                w.w = cvt_pk_bf16(silu_f(a1[2]) * u1[2], silu_f(a1[3]) * u1[3]);
                *(u32x4*)rowp = w;
            }
    }
};
struct EpiResid {
    static constexpr bool PERM = false;
    float* lat; const float* modl; int gidx; float w; const float* bias;
    __device__ __forceinline__ void operator()(const AccT& acc, const Unit& u, int wr, int wc, int fr, int fq) const {
        const int mr = (u.pm < 64) ? (u.pm >> 3) : 8;
        const int row0 = u.pm * 256 + wr * 64 + fr, col0 = u.pn * 256 + wc * 32 + 4 * fq;
        const float* gate = modl + (size_t)mr * NMODC + gidx * 1024 + col0;
        float* base = lat + (size_t)row0 * D + col0;
        f32x4 xa[8], xb[8];
#pragma unroll
        for (int i = 0; i < 8; ++i) xa[i] = *(const f32x4*)(base + (size_t)((i >> 2) * 128 + (i & 3) * 16) * D);
#pragma unroll
        for (int k = 0; k < 4; ++k) {
            const int bj = k >> 1, n = k & 1, co = bj * 128 + n * 16;
            if (k < 3) { const int co2 = ((k + 1) >> 1) * 128 + ((k + 1) & 1) * 16;
#pragma unroll
                for (int i = 0; i < 8; ++i) xb[i] = *(const f32x4*)(base + (size_t)((i >> 2) * 128 + (i & 3) * 16) * D + co2); }
            const f32x4 gv = (*(const f32x4*)(gate + co) + 1.0f) * w;
            const f32x4 bv = bias ? *(const f32x4*)(bias + col0 + co) : (f32x4){0.f, 0.f, 0.f, 0.f};
            __builtin_amdgcn_sched_barrier(0);
#pragma unroll
            for (int i = 0; i < 8; ++i) { const int ai = i >> 2, m = i & 3;
                *(f32x4*)(base + (size_t)(ai * 128 + m * 16) * D + co) = xa[i] * DN_ALPHA + gv * (acc[ai][bj][m][n] + bv); }
#pragma unroll
            for (int i = 0; i < 8; ++i) xa[i] = xb[i];
        }
    }
};
struct EpiResidSplit {
    static constexpr bool PERM = false;
    EpiResid r; float* slabs;
    __device__ __forceinline__ void operator()(const AccT& acc, const Unit& u, int wr, int wc, int fr, int fq) const {
        if (u.ks < 0) { r(acc, u, wr, wc, fr, fq); return; }
        const int row0 = u.pm * 256 + wr * 64 + fr, col0 = u.pn * 256 + wc * 32 + 4 * fq;
        float* sb = slabs + ((size_t)u.ks * TC + (row0 - TL)) * D + col0;
#pragma unroll
        for (int ai = 0; ai < 2; ++ai)
#pragma unroll
            for (int m = 0; m < 4; ++m)
#pragma unroll
                for (int bj = 0; bj < 2; ++bj)
#pragma unroll
                    for (int n = 0; n < 2; ++n) *(f32x4*)(sb + (size_t)(ai * 128 + m * 16) * D + bj * 128 + n * 16) = acc[ai][bj][m][n];
    }
};
struct EpiQK {
    static constexpr bool PERM = false;
    bf16_t* O; const float* tab;
    __device__ __forceinline__ void operator()(const AccT& acc, const Unit& u, int wr, int wc, int fr, int fq) const {
        const int row0 = u.pm * 256 + wr * 64 + fr, col0 = u.pn * 256 + wc * 32 + 8 * fq;
        const int axis = wc & 1;
        if (u.pm < 64) {
            f32x4 cs, sn, csn, snn;
            { const int t = row0 & 2047; const int pos = axis ? (t & 63) : (t >> 6);
              cs = *(const f32x4*)(tab + pos * 16 + 4 * fq); sn = *(const f32x4*)(tab + 1024 + pos * 16 + 4 * fq); csn = cs; snn = sn; }
#pragma unroll
            for (int i = 0; i < 8; ++i) {
                const int ai = i >> 2, m = i & 3;
                const int r = row0 + ai * 128 + m * 16;
                if (i < 7) { const int r2 = row0 + ((i + 1) >> 2) * 128 + ((i + 1) & 3) * 16; const int t = r2 & 2047; const int pos = axis ? (t & 63) : (t >> 6);
                    csn = *(const f32x4*)(tab + pos * 16 + 4 * fq); snn = *(const f32x4*)(tab + 1024 + pos * 16 + 4 * fq); }
                bf16_t* rowp = O + (size_t)r * 2048 + col0;
#pragma unroll
                for (int bj = 0; bj < 2; ++bj) {
                    const f32x4 x1 = acc[ai][bj][m][0], x2 = acc[ai][bj][m][1];
                    const f32x4 o1 = x1 * cs - x2 * sn, o2 = x2 * cs + x1 * sn;
                    u32x4 w; w.x = cvt_pk_bf16(o1[0], o1[1]); w.y = cvt_pk_bf16(o1[2], o1[3]); w.z = cvt_pk_bf16(o2[0], o2[1]); w.w = cvt_pk_bf16(o2[2], o2[3]);
                    *(u32x4*)(rowp + bj * 128) = w;
                }
                cs = csn; sn = snn;
            }
        } else {
#pragma unroll
            for (int i = 0; i < 8; ++i) {
                const int ai = i >> 2, m = i & 3;
                bf16_t* rowp = O + (size_t)(row0 + ai * 128 + m * 16) * 2048 + col0;
#pragma unroll
                for (int bj = 0; bj < 2; ++bj) {
                    const f32x4 x1 = acc[ai][bj][m][0], x2 = acc[ai][bj][m][1];
                    u32x4 w; w.x = cvt_pk_bf16(x1[0], x1[1]); w.y = cvt_pk_bf16(x1[2], x1[3]); w.z = cvt_pk_bf16(x2[0], x2[1]); w.w = cvt_pk_bf16(x2[2], x2[3]);
                    *(u32x4*)(rowp + bj * 128) = w;
                }
            }
        }
    }
};
struct EpiB {
    static constexpr bool PERM = true;
    bf16_t* O; int ldc; const float* bias; int ncols;
    __device__ __forceinline__ void operator()(const AccT& acc, const Unit& u, int wr, int wc, int fr, int fq) const {
        const int row0 = u.pm * 256 + wr * 64 + fr, col0 = u.pn * 256 + wc * 32 + 8 * fq;
        bf16_t* base = O + (size_t)row0 * ldc + col0;
#pragma unroll
        for (int bj = 0; bj < 2; ++bj) {
            if (col0 + bj * 128 < ncols) {
                f32x4 b0 = (f32x4){0.f, 0.f, 0.f, 0.f}, b1 = (f32x4){0.f, 0.f, 0.f, 0.f};
                if (bias) { b0 = *(const f32x4*)(bias + col0 + bj * 128); b1 = *(const f32x4*)(bias + col0 + bj * 128 + 4); }
#pragma unroll
                for (int ai = 0; ai < 2; ++ai)
#pragma unroll
                    for (int m = 0; m < 4; ++m) {
                        const f32x4 v0 = acc[ai][bj][m][0] + b0, v1 = acc[ai][bj][m][1] + b1;
                        u32x4 w; w.x = cvt_pk_bf16(v0[0], v0[1]); w.y = cvt_pk_bf16(v0[2], v0[3]); w.z = cvt_pk_bf16(v1[0], v1[1]); w.w = cvt_pk_bf16(v1[2], v1[3]);
                        *(u32x4*)(base + (size_t)(ai * 128 + m * 16) * ldc + bj * 128) = w;
                    }
            }
            asm volatile("" ::: "memory");
        }
    }
};

__device__ __forceinline__ void transpose_tile(const float* W, int ldw, bf16_t* WT, int ldt, int k0, int n0, int drow0, LAS float* scr, int lane) {
    f32x4 wv[8];
#pragma unroll
    for (int i = 0; i < 8; ++i) wv[i] = *(const f32x4*)(W + (size_t)(k0 + 8 * i + (lane >> 3)) * ldw + n0 + 4 * (lane & 7));
#pragma unroll
    for (int i = 0; i < 8; ++i) { LAS float* dd = scr + (8 * i + (lane >> 3)) * 33 + 4 * (lane & 7); dd[0] = wv[i][0]; dd[1] = wv[i][1]; dd[2] = wv[i][2]; dd[3] = wv[i][3]; }
    LDS_WAIT();
    const int c = lane & 7;
#pragma unroll
    for (int j = 0; j < 4; ++j) { const int n = (lane >> 3) + 8 * j; const LAS float* s = scr + (8 * c) * 33 + n;
        u32x4 o; o.x = cvt_pk_bf16(s[0 * 33], s[1 * 33]); o.y = cvt_pk_bf16(s[2 * 33], s[3 * 33]); o.z = cvt_pk_bf16(s[4 * 33], s[5 * 33]); o.w = cvt_pk_bf16(s[6 * 33], s[7 * 33]);
        *(u32x4*)(WT + (size_t)(drow0 + n) * ldt + k0 + 8 * c) = o; }
    LDS_WAIT();
}

__device__ __forceinline__ void hyena_filter_pos(const PV& P, int pos, int lane) {
    const float* fw_in = P.in(18);
    const float* fw_mid = P.in(19);
    const float* fb = P.in(20);
    const float* ffreq = P.in(21);
    const float* fw_out = P.in(22);
    int L, n, RL; bf16_t* kf;
    if (pos < SEQ) { L = SEQ; n = pos; RL = 4096; kf = (bf16_t*)(P.ws() + OFF_KLAT); } else { L = CTXL; n = pos - SEQ; RL = 512; kf = (bf16_t*)(P.ws() + OFF_KCTX); }
    const float t = (float)n / (float)(L - 1);
    const float w = 6.283185307179586f * (float)n / (float)L;
    float zv = 0.f;
    if (lane == 0) zv = t;
    else if (lane < 17) { const float f = 1e-4f + (float)(lane - 1) * ((15.0f - 1e-4f) / 15.0f); zv = cosf(f * w); }
    else if (lane < 33) { const float f = 1e-4f + (float)(lane - 17) * ((15.0f - 1e-4f) / 15.0f); zv = -sinf(f * w); }
    const float fr = ffreq[lane];
    float a = fb[lane];
    for (int k = 0; k < 33; ++k) a += __shfl(zv, k) * fw_in[k * 64 + lane];
    float h = sinf(fr * a);
    a = fb[64 + lane];
    for (int k = 0; k < 64; ++k) a += __shfl(h, k) * fw_mid[k * 64 + lane];
    h = sinf(fr * a);
    a = fb[128 + lane];
    for (int k = 0; k < 64; ++k) a += __shfl(h, k) * fw_mid[4096 + k * 64 + lane];
    h = sinf(fr * a);
    f32x4 o[8];
#pragma unroll
    for (int i = 0; i < 8; ++i) o[i] = (f32x4){0.f, 0.f, 0.f, 0.f};
    for (int k = 0; k < 64; ++k) {
        const float hk = __shfl(h, k);
        const f32x4* wr = (const f32x4*)(fw_out + (size_t)k * 2048) + lane;
#pragma unroll
        for (int i = 0; i < 8; ++i) o[i] += hk * wr[64 * i];
    }
    const float dmin = -15.350567286626973f, dmax = -3.0701134573253945f;
#pragma unroll
    for (int i = 0; i < 8; ++i) {
        const int c = lane * 4 + 256 * i; const int dir = c >> 10, d0 = c & 1023;
        f32x4 r;
#pragma unroll
        for (int j = 0; j < 4; ++j) { const float dl = fabsf(dmin + (float)(d0 + j) * ((dmax - dmin) / 1023.0f)); r[j] = o[i][j] * (expf(-t * dl) + 0.05f); }
        const int idx = dir == 0 ? (L - 1 - n) : (L - 1 + n);
        if (dir == 0 || n >= 1) {
#pragma unroll
            for (int j = 0; j < 4; ++j) { float v = r[j]; if (dir == 0 && n == 0) v += P.in(23)[d0 + j];
                kf[(size_t)(d0 + j) * RL + idx] = (bf16_t)(cvt_pk_bf16(v, 0.f) & 0xffffu); }
        }
    }
}

__device__ __forceinline__ void phase_prologue(const PV& P, LAS unsigned char* lds) {
    const int tid = P.tid, lane = tid & 63, wave = __builtin_amdgcn_readfirstlane(tid >> 6), G = P.gsz;
    unsigned char* ws = P.ws();
    {
        LAS float* sv = (LAS float*)lds;
        LAS float* red = (LAS float*)(lds + 9 * 1024 * 4);
        const float* cin = P.in(1); const float* cctx = P.in(3);
        for (int i = tid; i < 9 * 1024; i += 512) { const float v = (i < 8192) ? cin[i] : cctx[i - 8192]; sv[i] = v / (1.0f + expf(-v)); }
        __syncthreads();
        const float* ada_w = P.in(4); const float* ada_b = P.in(5);
        float* mod = (float*)(ws + OFF_MOD);
        for (int uidx = P.bid; uidx < 288; uidx += G) {
            const int l = uidx / 72, cb = uidx % 72, cn = tid & 127, kq = tid >> 7;
            const float* wp = ada_w + (size_t)l * 1024 * NMODC + (size_t)(256 * kq) * NMODC + 128 * cb + cn;
            float acc[9];
#pragma unroll
            for (int r = 0; r < 9; ++r) acc[r] = 0.f;
#pragma unroll 4
            for (int k = 0; k < 256; ++k) {
                const float wv = wp[(size_t)k * NMODC];
#pragma unroll
                for (int r = 0; r < 9; ++r) acc[r] += sv[r * 1024 + 256 * kq + k] * wv;
            }
#pragma unroll
            for (int r = 0; r < 9; ++r) red[(kq * 9 + r) * 128 + cn] = acc[r];
            __syncthreads();
            for (int o = tid; o < 9 * 128; o += 512) { const int r = o >> 7, c2 = o & 127;
                const float s = red[(0 * 9 + r) * 128 + c2] + red[(1 * 9 + r) * 128 + c2] + red[(2 * 9 + r) * 128 + c2] + red[(3 * 9 + r) * 128 + c2];
                mod[((size_t)l * 9 + r) * NMODC + 128 * cb + c2] = s + ada_b[(size_t)l * NMODC + 128 * cb + c2]; }
            __syncthreads();
        }
    }
    if (P.bid == 0) { unsigned* bw = (unsigned*)(ws + OFF_BAR); for (int i = tid; i < XCD_BAR_WORDS; i += 512) bw[i] = 0u; }
    if (P.bid == G - 1) {
        float* tab = (float*)(ws + OFF_ROPE);
        for (int i = tid; i < 1024; i += 512) { const int pos = i >> 4, f = i & 15; const float inv = powf(10000.0f, -(float)f / 16.0f); const float ang = (float)pos * inv; tab[i] = cosf(ang); tab[1024 + i] = sinf(ang); }
    }
    __syncthreads();
    LAS float* scr = (LAS float*)(lds + wave * 16384);
    const int gw = P.bid * 8 + wave, NGW = G * 8;
    constexpr int I_13 = 8 * 16 * 176, I_2 = 8 * 44 * 32, I_QKV = 2 * 16 * 96, I_O = 2 * 16 * 32, I_HI = 16 * 96, I_HO = 16 * 32, I_SI = 16 * 162, I_SO = 32 * 32, I_PAD = 192, I_F = SEQ + CTXL;
    constexpr int NIT = I_13 + I_2 + I_QKV + I_O + I_HI + I_HO + I_SI + I_SO + I_PAD + I_F;
    for (int it = gw; it < NIT; it += NGW) {
        int r = it;
        if (r < I_13) { const int q = r / 2816, rr = r % 2816, kb = rr / 176, nb = rr % 176, n0 = 32 * nb; const int half = n0 >= FF ? 1 : 0, jn = n0 - half * FF;
            transpose_tile(P.in(8) + (size_t)q * 1024 * 5632, 5632, (bf16_t*)(ws + OFF_W13T) + (size_t)q * 5632 * 1024, 1024, 64 * kb, n0, 256 * (jn >> 7) + 128 * half + (jn & 127), scr, lane); continue; } r -= I_13;
        if (r < I_2) { const int q = r / 1408, rr = r % 1408, kb = rr / 32, nb = rr % 32;
            transpose_tile(P.in(9) + (size_t)q * FF * 1024, 1024, (bf16_t*)(ws + OFF_W2T) + (size_t)q * 1024 * FF, FF, 64 * kb, 32 * nb, 32 * nb, scr, lane); continue; } r -= I_2;
        if (r < I_QKV) { const int q = r / 1536, rr = r % 1536, kb = rr / 96, nb = rr % 96, n0 = 32 * nb;
            if (n0 < 2048) transpose_tile(P.in(10) + (size_t)q * 1024 * 3072, 3072, (bf16_t*)(ws + OFF_WQKT) + (size_t)q * 2048 * 1024, 1024, 64 * kb, n0, n0, scr, lane);
            else transpose_tile(P.in(10) + (size_t)q * 1024 * 3072, 3072, (bf16_t*)(ws + OFF_WVT) + (size_t)q * 1024 * 1024, 1024, 64 * kb, n0, n0 - 2048, scr, lane);
            continue; } r -= I_QKV;
        if (r < I_O) { const int q = r / 512, rr = r % 512, kb = rr / 32, nb = rr % 32;
            transpose_tile(P.in(11) + (size_t)q * 1024 * 1024, 1024, (bf16_t*)(ws + OFF_WOT) + (size_t)q * 1024 * 1024, 1024, 64 * kb, 32 * nb, 32 * nb, scr, lane); continue; } r -= I_O;
        if (r < I_HI) { const int kb = r / 96, nb = r % 96;
            transpose_tile(P.in(14), 3072, (bf16_t*)(ws + OFF_WHIT), 1024, 64 * kb, 32 * nb, 32 * nb, scr, lane); continue; } r -= I_HI;
        if (r < I_HO) { const int kb = r / 32, nb = r % 32;
            transpose_tile(P.in(24), 1024, (bf16_t*)(ws + OFF_WHOT), 1024, 64 * kb, 32 * nb, 32 * nb, scr, lane); continue; } r -= I_HO;
        if (r < I_SI) { const int kb = r / 162, nb = r % 162;
            transpose_tile(P.in(26), SSM_IN, (bf16_t*)(ws + OFF_WSIT), 1024, 64 * kb, 32 * nb, 32 * nb, scr, lane); continue; } r -= I_SI;
        if (r < I_SO) { const int kb = r / 32, nb = r % 32;
            transpose_tile(P.in(33), 1024, (bf16_t*)(ws + OFF_WSOT), 2048, 64 * kb, 32 * nb, 32 * nb, scr, lane); continue; } r -= I_SO;
        if (r < I_PAD) { u32x4* p = (u32x4*)((bf16_t*)(ws + OFF_WSIT) + (size_t)(SSM_IN + r) * 1024); unsigned zz = 0u; asm volatile("" : "+v"(zz)); const u32x4 z = (u32x4){zz, zz, zz, zz}; p[lane] = z; p[64 + lane] = z; continue; } r -= I_PAD;
        hyena_filter_pos(P, r, lane);
    }
}

__device__ __forceinline__ void ln_rows(f32x4 (&v)[4], const float* g, const float* b, int lane) {
    float s = 0.f;
#pragma unroll
    for (int j = 0; j < 4; ++j) s += (v[j][0] + v[j][1]) + (v[j][2] + v[j][3]);
    const float mean = wave_sum(s) * (1.f / D); float s2 = 0.f;
#pragma unroll
    for (int j = 0; j < 4; ++j) { v[j] = v[j] - mean; s2 += (v[j][0] * v[j][0] + v[j][1] * v[j][1]) + (v[j][2] * v[j][2] + v[j][3] * v[j][3]); }
    const float rstd = 1.0f / sqrtf(wave_sum(s2) * (1.f / D) + LN_EPS);
#pragma unroll
    for (int j = 0; j < 4; ++j) { const f32x4 gg = *((const f32x4*)g + lane + 64 * j), bb = *((const f32x4*)b + lane + 64 * j); v[j] = v[j] * rstd * gg + bb; }
}
__device__ __forceinline__ void write_hb(const f32x4 (&v)[4], const float* shift, const float* scale, bf16_t* hrow, int lane) {
#pragma unroll
    for (int j = 0; j < 4; ++j) { const f32x4 sh = *((const f32x4*)shift + lane + 64 * j), sc = *((const f32x4*)scale + lane + 64 * j);
        const f32x4 o = v[j] * (sc + 1.0f) + sh; u32x2 w; w.x = cvt_pk_bf16(o[0], o[1]); w.y = cvt_pk_bf16(o[2], o[3]);
        *((u32x2*)hrow + lane + 64 * j) = w; }
}
__device__ __forceinline__ int mod_row(int r) { return r < TL ? (r >> 11) : 8; }

__device__ __forceinline__ void phase_init(const PV& P) {
    const int lane = P.tid & 63, wave = P.tid >> 6, gw = P.bid * 8 + wave, NGW = P.gsz * 8;
    float* lat = (float*)(P.ws() + OFF_LAT); bf16_t* hb = (bf16_t*)(P.ws() + OFF_HB); const float* mod = (const float*)(P.ws() + OFF_MOD);
    f32x4 nv[4];
    if (gw < TA) { const float* s0 = gw < TL ? P.in(0) + (size_t)gw * D : P.in(2) + (size_t)(gw - TL) * D;
#pragma unroll
        for (int j = 0; j < 4; ++j) nv[j] = *((const f32x4*)s0 + lane + 64 * j); }
    for (int r = gw; r < TA; r += NGW) {
        f32x4 v[4];
#pragma unroll
        for (int j = 0; j < 4; ++j) v[j] = nv[j];
        if (r + NGW < TA) { const int r2 = r + NGW; const float* s2 = r2 < TL ? P.in(0) + (size_t)r2 * D : P.in(2) + (size_t)(r2 - TL) * D;
#pragma unroll
            for (int j = 0; j < 4; ++j) nv[j] = *((const f32x4*)s2 + lane + 64 * j); }
#pragma unroll
        for (int j = 0; j < 4; ++j) *((f32x4*)(lat + (size_t)r * D) + lane + 64 * j) = v[j];
        const float* m = mod + (size_t)mod_row(r) * NMODC;
        write_hb(v, m, m + 1024, hb + (size_t)r * D, lane);
    }
}
__device__ __forceinline__ void phase_ln(const PV& P, int M, const float* g, const float* b, const float* nmod  , int qshift, float* outp,
                                         const float* slabs, const float* gate8  , float wres) {
    const int lane = P.tid & 63, wave = P.tid >> 6, gw = P.bid * 8 + wave, NGW = P.gsz * 8;
    float* lat = (float*)(P.ws() + OFF_LAT); bf16_t* hb = (bf16_t*)(P.ws() + OFF_HB);
    f32x4 gg[4], bb[4];
#pragma unroll
    for (int j = 0; j < 4; ++j) { gg[j] = *((const f32x4*)g + lane + 64 * j); bb[j] = *((const f32x4*)b + lane + 64 * j); }
    f32x4 nv[4];
    if (gw < M) {
#pragma unroll
        for (int j = 0; j < 4; ++j) nv[j] = *((const f32x4*)(lat + (size_t)gw * D) + lane + 64 * j);
    }
    for (int r = gw; r < M; r += NGW) {
        float* row = lat + (size_t)r * D;
        f32x4 v[4];
#pragma unroll
        for (int j = 0; j < 4; ++j) v[j] = nv[j];
        if (r + NGW < M) {
#pragma unroll
            for (int j = 0; j < 4; ++j) nv[j] = *((const f32x4*)(lat + (size_t)(r + NGW) * D) + lane + 64 * j);
        }
        if (slabs && r >= TL) {
#pragma unroll
            for (int j = 0; j < 4; ++j) {
                f32x4 s = (f32x4){0.f, 0.f, 0.f, 0.f};
#pragma unroll
                for (int k = 0; k < 8; ++k) s += *((const f32x4*)(slabs + ((size_t)k * TC + (r - TL)) * D) + lane + 64 * j);
                const f32x4 gt = *((const f32x4*)gate8 + lane + 64 * j);
                v[j] = v[j] * DN_ALPHA + (gt + 1.0f) * wres * s;
            }
        }
        f32x4 shv[4], scv[4];
        if (!outp) { const float* m = nmod + (size_t)mod_row(r) * NMODC + qshift * 1024;
#pragma unroll
            for (int j = 0; j < 4; ++j) { shv[j] = *((const f32x4*)m + lane + 64 * j); scv[j] = *((const f32x4*)(m + 1024) + lane + 64 * j); } }
        {
            float s = 0.f;
#pragma unroll
            for (int j = 0; j < 4; ++j) s += (v[j][0] + v[j][1]) + (v[j][2] + v[j][3]);
            const float mean = wave_sum(s) * (1.f / D); float s2 = 0.f;
#pragma unroll
            for (int j = 0; j < 4; ++j) { v[j] = v[j] - mean; s2 += (v[j][0] * v[j][0] + v[j][1] * v[j][1]) + (v[j][2] * v[j][2] + v[j][3] * v[j][3]); }
            const float rstd = 1.0f / sqrtf(wave_sum(s2) * (1.f / D) + LN_EPS);
#pragma unroll
            for (int j = 0; j < 4; ++j) v[j] = v[j] * rstd * gg[j] + bb[j];
        }
        if (outp) {
#pragma unroll
            for (int j = 0; j < 4; ++j) *((f32x4*)(outp + (size_t)r * D) + lane + 64 * j) = v[j];
        } else {
#pragma unroll
            for (int j = 0; j < 4; ++j) *((f32x4*)row + lane + 64 * j) = v[j];
#pragma unroll
            for (int j = 0; j < 4; ++j) { const f32x4 o = v[j] * (scv[j] + 1.0f) + shv[j]; u32x2 w; w.x = cvt_pk_bf16(o[0], o[1]); w.y = cvt_pk_bf16(o[2], o[3]);
                *((u32x2*)(hb + (size_t)r * D) + lane + 64 * j) = w; }
        }
    }
}

__device__ __forceinline__ void phase_attention(const PV& P, LAS unsigned char* lds, int j_attn, float lam_init, bool ctx_q) {
    const int tid = P.tid, lane = tid & 63, wave = __builtin_amdgcn_readfirstlane(tid >> 6), g = lane >> 4, q16 = lane & 15;
    const bf16_t* qk = (const bf16_t*)(P.ws() + OFF_QK); const bf16_t* vt = (const bf16_t*)(P.ws() + OFF_VT); bf16_t* ao = (bf16_t*)(P.ws() + OFF_AO);
    const float* lam = P.in(12) + j_attn * 256; const float* subg = P.in(13) + j_attn * 128;
    const float lam_full = expf(wave_sum(lam[lane] * lam[64 + lane])) - expf(wave_sum(lam[128 + lane] * lam[192 + lane])) + lam_init;
    constexpr int KROW = 272, VROW = 144;
    constexpr int ABUF = 64 * KROW + 128 * VROW;
    const float sc = 0.125f * 1.4426950408889634f;
    const int NU = 1024 + (ctx_q ? 128 : 0);
    for (int uidx = P.bid; uidx < NU; uidx += P.gsz) {
        int b, h, qrow0, ntiles;
        if (uidx < 1024) { b = uidx >> 7; h = (uidx >> 4) & 7; qrow0 = b * SEQ + (uidx & 15) * 128; ntiles = 36; }
        else { const int u2 = uidx - 1024; b = u2 >> 4; h = (u2 >> 1) & 7; qrow0 = TL + b * CTXL + (u2 & 1) * 128; ntiles = 4; }
        bf16x8 qf[2][2];
        { const bf16_t* qp = qk + (size_t)(qrow0 + wave * 16 + q16) * 2048 + h * 128 + 8 * g;
#pragma unroll
          for (int mp = 0; mp < 2; ++mp)
#pragma unroll
              for (int kk = 0; kk < 2; ++kk) { const u32x4 qw = *(const u32x4*)(qp + mp * 64 + kk * 32); u32x4 qs;
#pragma unroll
                  for (int e = 0; e < 4; ++e) qs[e] = cvt_pk_bf16_m(bflo(qw[e]) * sc, bfhi(qw[e]) * sc);
                  qf[mp][kk] = __builtin_bit_cast(bf16x8, qs); } }
        f32x4 accO[2][8];
#pragma unroll
        for (int mp = 0; mp < 2; ++mp)
#pragma unroll
            for (int nt = 0; nt < 8; ++nt) accO[mp][nt] = (f32x4){0.f, 0.f, 0.f, 0.f};
        float mrun[2] = {-INFINITY, -INFINITY}, lrun[2] = {0.f, 0.f};
        u32x4 stg[4];
        auto tile_tok = [&](int i) { return i < 4 ? TL + b * CTXL + 64 * i : b * SEQ + 64 * (i - 4); };
#define ATT_LOAD(i) do { const int tok = tile_tok(i); \
            _Pragma("unroll") for (int c2 = 0; c2 < 2; ++c2) { const int c = tid + 512 * c2; \
                stg[c2] = *(const u32x4*)(qk + (size_t)(tok + (c >> 4)) * 2048 + 1024 + h * 128 + (c & 15) * 8); \
                stg[2 + c2] = *(const u32x4*)(vt + (size_t)(h * 128 + (c >> 3)) * TA + tok + (c & 7) * 8); } } while (0)
#define ATT_STORE(bi) do { LAS unsigned char* Kw = lds + (bi) * ABUF; LAS unsigned char* Vw = Kw + 64 * KROW; \
            _Pragma("unroll") for (int c2 = 0; c2 < 2; ++c2) { const int c = tid + 512 * c2; \
                *(LAS u32x4*)(Kw + (c >> 4) * KROW + (c & 15) * 16) = stg[c2]; \
                *(LAS u32x4*)(Vw + (c >> 3) * VROW + (c & 7) * 16) = stg[2 + c2]; } } while (0)
        ATT_LOAD(0);
        ATT_STORE(0);
        __syncthreads();
        for (int it = 0; it < ntiles; ++it) {
            const LAS unsigned char* Kl = lds + (it & 1) * ABUF; const LAS unsigned char* Vl = Kl + 64 * KROW;
            if (it + 1 < ntiles) ATT_LOAD(it + 1);
            bf16x8 pf[2][2];
            const LAS unsigned char* kbase = Kl + (8 * (q16 >> 2) + (q16 & 3)) * KROW + 16 * g;
#define ATT_KF(mp, kt, kk) (*(const LAS bf16x8*)(kbase + (32 * ((kt) >> 1) + 4 * ((kt) & 1)) * KROW + (mp) * 128 + (kk) * 64))
            bf16x8 kf[2][8];
#pragma unroll
            for (int f = 0; f < 8; ++f) kf[0][f] = ATT_KF(0, f >> 1, f & 1);
#pragma unroll
            for (int mp = 0; mp < 2; ++mp) {
                f32x4 s[4];
                if (mp == 0) {
#pragma unroll
                    for (int f = 0; f < 8; ++f) kf[1][f] = ATT_KF(1, f >> 1, f & 1);
                    __builtin_amdgcn_sched_barrier(0);
                }
#pragma unroll
                for (int kk = 0; kk < 2; ++kk)
#pragma unroll
                    for (int kt = 0; kt < 4; ++kt) {
                        if (kk == 0) s[kt] = (f32x4){0.f, 0.f, 0.f, 0.f};
                        s[kt] = __builtin_amdgcn_mfma_f32_16x16x32_bf16(kf[mp][2 * kt + kk], qf[mp][kk], s[kt], 0, 0, 0);
                    }
                float mx = -INFINITY;
#pragma unroll
                for (int kt = 0; kt < 4; ++kt) mx = fmaxf(mx, fmaxf(fmaxf(s[kt][0], s[kt][1]), fmaxf(s[kt][2], s[kt][3])));
                mx = xmax32(xmax16(mx));
                const float mnew = fmaxf(mrun[mp], mx);
                const float alpha = __builtin_amdgcn_exp2f(mrun[mp] - mnew);
                mrun[mp] = mnew;
                float ps = 0.f;
#pragma unroll
                for (int kt = 0; kt < 4; ++kt) {
#pragma unroll
                    for (int j = 0; j < 4; ++j) { const float p = __builtin_amdgcn_exp2f(s[kt][j] - mnew); s[kt][j] = p; ps += p; }
                }
                lrun[mp] = lrun[mp] * alpha + ps;
                if (__any(alpha != 1.0f)) {
#pragma unroll
                    for (int nt = 0; nt < 8; ++nt) accO[mp][nt] = accO[mp][nt] * alpha;
                }
#pragma unroll
                for (int kb = 0; kb < 2; ++kb) {
                    u32x4 w;
                    w.x = cvt_pk_bf16_m(s[2 * kb][0], s[2 * kb][1]); w.y = cvt_pk_bf16_m(s[2 * kb][2], s[2 * kb][3]);
                    w.z = cvt_pk_bf16_m(s[2 * kb + 1][0], s[2 * kb + 1][1]); w.w = cvt_pk_bf16_m(s[2 * kb + 1][2], s[2 * kb + 1][3]);
                    pf[mp][kb] = __builtin_bit_cast(bf16x8, w);
                }
            }
            {
                const LAS unsigned char* vbase = Vl + q16 * VROW + 16 * g;
#define ATT_VF(f) (*(const LAS bf16x8*)(vbase + ((f) >> 1) * 16 * VROW + ((f) & 1) * 64))
                bf16x8 va[4], vn[4];
#pragma unroll
                for (int f = 0; f < 4; ++f) va[f] = ATT_VF(f);
#pragma unroll
                for (int grp = 0; grp < 4; ++grp) {
                    if (grp < 3) {
#pragma unroll
                        for (int f = 0; f < 4; ++f) vn[f] = ATT_VF(4 * (grp + 1) + f);
                    }
                    __builtin_amdgcn_sched_barrier(0);
#pragma unroll
                    for (int f = 0; f < 4; ++f) { const int nt = 2 * grp + (f >> 1), kb = f & 1;
                        accO[0][nt] = __builtin_amdgcn_mfma_f32_16x16x32_bf16(va[f], pf[0][kb], accO[0][nt], 0, 0, 0);
                        accO[1][nt] = __builtin_amdgcn_mfma_f32_16x16x32_bf16(va[f], pf[1][kb], accO[1][nt], 0, 0, 0); }
#pragma unroll
                    for (int f = 0; f < 4; ++f) va[f] = vn[f];
                }
#undef ATT_VF
            }
#undef ATT_KF
            if (it + 1 < ntiles) ATT_STORE((it + 1) & 1);
            __syncthreads();
        }
#undef ATT_LOAD
#undef ATT_STORE
        float l0 = lrun[0]; l0 += __shfl_xor(l0, 16); l0 += __shfl_xor(l0, 32);
        float l1 = lrun[1]; l1 += __shfl_xor(l1, 16); l1 += __shfl_xor(l1, 32);
        const float i0 = 1.0f / l0, i1 = lam_full / l1;
        float ss = 0.f;
#pragma unroll
        for (int nt = 0; nt < 8; ++nt) { accO[0][nt] = accO[0][nt] * i0 - accO[1][nt] * i1;
            ss += (accO[0][nt][0] * accO[0][nt][0] + accO[0][nt][1] * accO[0][nt][1]) + (accO[0][nt][2] * accO[0][nt][2] + accO[0][nt][3] * accO[0][nt][3]); }
        ss += __shfl_xor(ss, 16); ss += __shfl_xor(ss, 32);
        const float rs = (1.0f / sqrtf(ss * (1.0f / 128.0f) + LN_EPS)) * (1.0f - lam_init);
        bf16_t* op = ao + (size_t)(qrow0 + wave * 16 + q16) * D + h * 128 + 4 * g;
#pragma unroll
        for (int nt = 0; nt < 8; ++nt) { const f32x4 gg = *(const f32x4*)(subg + 16 * nt + 4 * g); const f32x4 o = accO[0][nt] * rs * gg;
            u32x2 w; w.x = cvt_pk_bf16(o[0], o[1]); w.y = cvt_pk_bf16(o[2], o[3]); *(u32x2*)(op + 16 * nt) = w; }
    }
}

__device__ __forceinline__ void phase_hy_short(const PV& P, LAS unsigned char* lds) {
    const bf16_t* hu = (const bf16_t*)(P.ws() + OFF_HU); float* x0o = (float*)(P.ws() + OFF_HX0); bf16_t* vT = (bf16_t*)(P.ws() + OFF_HVT);
    const float* cw = P.in(16); const float* cb = P.in(17);
    const int tid = P.tid;
    constexpr int RS = 264;
    const bool hoist = (P.gsz & 7) == 0;
    f32x4 hw0[3], hw1[3], hw2[3], hbb[3];
    { const int dq0 = 128 * (P.bid & 7) + 4 * (tid & 31);
#pragma unroll
      for (int part = 0; part < 3; ++part) { const int c = part * 1024 + dq0;
          hw0[part] = *(const f32x4*)(cw + c); hw1[part] = *(const f32x4*)(cw + 3072 + c); hw2[part] = *(const f32x4*)(cw + 6144 + c); hbb[part] = *(const f32x4*)(cb + c); } }
    for (int uidx = P.bid; uidx < 8 * 36 * 8; uidx += P.gsz) {
        const int db = uidx & 7, sb = (uidx >> 3) % 36, b = uidx / 288;
        const bool isl = sb < 32; const int L = isl ? SEQ : CTXL, t0 = isl ? 64 * sb : 64 * (sb - 32), rbase = isl ? b * SEQ : TL + b * CTXL, toff = isl ? 0 : SEQ;
#pragma unroll
        for (int k = 0; k < 4; ++k) {
            const int idx = tid + 512 * k, tl = idx >> 5, d4 = idx & 31, t = t0 + tl, r = rbase + t, dq = 128 * db + 4 * d4;
            const bool hp = t > 0, hn = t < L - 1;
            float res[3][4];
#pragma unroll
            for (int part = 0; part < 3; ++part) {
                const int c = part * 1024 + dq;
                const u32x2 z2 = (u32x2){0u, 0u};
                const u32x2 um = hp ? *(const u32x2*)(hu + (size_t)(r - 1) * 3072 + c) : z2;
                const u32x2 u0 = *(const u32x2*)(hu + (size_t)r * 3072 + c);
                const u32x2 up = hn ? *(const u32x2*)(hu + (size_t)(r + 1) * 3072 + c) : z2;
                f32x4 w0 = hw0[part], w1 = hw1[part], w2 = hw2[part], bb = hbb[part];
                if (!hoist) { w0 = *(const f32x4*)(cw + c); w1 = *(const f32x4*)(cw + 3072 + c); w2 = *(const f32x4*)(cw + 6144 + c); bb = *(const f32x4*)(cb + c); }
                res[part][0] = bb[0] + bflo(um.x) * w0[0] + bflo(u0.x) * w1[0] + bflo(up.x) * w2[0];
                res[part][1] = bb[1] + bfhi(um.x) * w0[1] + bfhi(u0.x) * w1[1] + bfhi(up.x) * w2[1];
                res[part][2] = bb[2] + bflo(um.y) * w0[2] + bflo(u0.y) * w1[2] + bflo(up.y) * w2[2];
                res[part][3] = bb[3] + bfhi(um.y) * w0[3] + bfhi(u0.y) * w1[3] + bfhi(up.y) * w2[3];
            }
            *(f32x4*)(x0o + (size_t)r * D + dq) = (f32x4){res[0][0], res[0][1], res[0][2], res[0][3]};
            u32x2 w; w.x = cvt_pk_bf16(res[2][0] * res[1][0], res[2][1] * res[1][1]); w.y = cvt_pk_bf16(res[2][2] * res[1][2], res[2][3] * res[1][3]);
            *(LAS u32x2*)(lds + tl * RS + d4 * 8) = w;
        }
        __syncthreads();
#pragma unroll
        for (int k = 0; k < 2; ++k) {
            const int idx = tid + 512 * k, tk = idx & 7, dl = idx >> 3;
            unsigned e[8];
#pragma unroll
            for (int j = 0; j < 8; ++j) e[j] = *(const LAS bf16_t*)(lds + (8 * tk + j) * RS + dl * 2);
            u32x4 w; w.x = e[0] | (e[1] << 16); w.y = e[2] | (e[3] << 16); w.z = e[4] | (e[5] << 16); w.w = e[6] | (e[7] << 16);
            *(u32x4*)(vT + ((size_t)(128 * db + dl) * NB + b) * HLT + toff + t0 + 8 * tk) = w;
        }
        __syncthreads();
    }
}

__device__ __forceinline__ void phase_hy_conv(const PV& P, LAS unsigned char* lds) {
    const bf16_t* vT = (const bf16_t*)(P.ws() + OFF_HVT); bf16_t* yT = (bf16_t*)(P.ws() + OFF_HYT);
    const int tid = P.tid, lane = tid & 63, wave = __builtin_amdgcn_readfirstlane(tid >> 6), g = lane >> 4, q16 = lane & 15;
    constexpr int R0_OFF = 0, R1_OFF = 8208, VT_OFF = 16416, VRS = 4112;
    for (int uidx = P.bid; uidx < 2048; uidx += P.gsz) {
        const bool isl = uidx < 1024; const int d = uidx & 1023;
        const int L = isl ? SEQ : CTXL, RL = isl ? 4096 : 512, toff = isl ? 0 : SEQ;
        const bf16_t* rsrc = isl ? (const bf16_t*)(P.ws() + OFF_KLAT) + (size_t)d * 4096 : (const bf16_t*)(P.ws() + OFF_KCTX) + (size_t)d * 512;
        for (int i = tid; i < RL / 8; i += 512) *(LAS u32x4*)(lds + R0_OFF + i * 16) = *(const u32x4*)(rsrc + 8 * i);
        for (int i = tid; i < L; i += 512) { const int bb = i / (L / 8), c = i % (L / 8);
            *(LAS u32x4*)(lds + VT_OFF + bb * VRS + c * 16) = *(const u32x4*)(vT + ((size_t)d * NB + bb) * HLT + toff + 8 * c); }
        __syncthreads();
        for (int k = tid; k < RL / 2; k += 512) {
            const unsigned hi = *(const LAS unsigned*)(lds + R0_OFF + 4 * k), lo = k > 0 ? *(const LAS unsigned*)(lds + R0_OFF + 4 * k - 4) : 0u;
            *(LAS unsigned*)(lds + R1_OFF + 4 * k) = __builtin_amdgcn_alignbit(hi, lo, 16);
        }
        __syncthreads();
        const int ntile = L / 16, nsb = L / 32, C = L - 1;
        const int tau0 = (wave & 1) + 32 * (wave >> 1);
        if (tau0 < ntile) {
            const int base0 = C - 16 * tau0 - q16 + 8 * g;
            const int sel = (q16 & 1) ? R0_OFF : (R1_OFF + 2);
#define HC_FRAG(dst, f) do { int eb = base0 - 32 * (f); eb = eb < 0 ? (eb & 1) : eb; const LAS unsigned* p_ = (const LAS unsigned*)(lds + sel + eb * 2); \
            u32x4 w_; w_.x = p_[0]; w_.y = p_[1]; w_.z = p_[2]; w_.w = p_[3]; dst = __builtin_bit_cast(bf16x8, w_); } while (0)
            f32x4 acc[16]; bf16x8 fr[16];
#pragma unroll
            for (int i = 0; i < 16; ++i) acc[i] = (f32x4){0.f, 0.f, 0.f, 0.f};
#pragma unroll
            for (int i = 1; i < 16; ++i) HC_FRAG(fr[i], i);
            const LAS unsigned char* vrow = lds + VT_OFF + (q16 & 7) * VRS + 16 * g;
            for (int sb0 = 0; sb0 < nsb; sb0 += 16) {
#pragma unroll
                for (int u = 0; u < 16; ++u) {
                    const int sbk = sb0 + u;
                    if (sbk < nsb) {
                        HC_FRAG(fr[(16 - u) & 15], -sbk);
                        const bf16x8 bv = *(const LAS bf16x8*)(vrow + sbk * 64);
#pragma unroll
                        for (int i = 0; i < 16; ++i) acc[i] = __builtin_amdgcn_mfma_f32_16x16x32_bf16(fr[(i - u) & 15], bv, acc[i], 0, 0, 0);
                    }
                }
            }
#undef HC_FRAG
            if (q16 < 8) {
                bf16_t* yp = yT + ((size_t)d * NB + q16) * HLT + toff + 4 * g;
#pragma unroll
                for (int i = 0; i < 16; ++i) { const int tau = tau0 + 2 * i;
                    if (tau < ntile) { u32x2 w; w.x = cvt_pk_bf16(acc[i][0], acc[i][1]); w.y = cvt_pk_bf16(acc[i][2], acc[i][3]); *(u32x2*)(yp + 16 * tau) = w; } }
            }
        }
        __syncthreads();
    }
}

__device__ __forceinline__ void phase_hy_gate(const PV& P, LAS unsigned char* lds) {
    const bf16_t* yT = (const bf16_t*)(P.ws() + OFF_HYT); const float* x0 = (const float*)(P.ws() + OFF_HX0); bf16_t* gout = (bf16_t*)(P.ws() + OFF_HG);
    const int tid = P.tid;
    constexpr int RS = 264;
    for (int uidx = P.bid; uidx < 8 * 36 * 8; uidx += P.gsz) {
        const int db = uidx & 7, sb = (uidx >> 3) % 36, b = uidx / 288;
        const bool isl = sb < 32; const int t0 = isl ? 64 * sb : 64 * (sb - 32), rbase = isl ? b * SEQ : TL + b * CTXL, toff = isl ? 0 : SEQ;
        f32x4 xq[4];
#pragma unroll
        for (int k = 0; k < 4; ++k) { const int idx = tid + 512 * k, tl = idx >> 5, d4 = idx & 31; xq[k] = *(const f32x4*)(x0 + (size_t)(rbase + t0 + tl) * D + 128 * db + 4 * d4); }
#pragma unroll
        for (int k = 0; k < 2; ++k) {
            const int idx = tid + 512 * k, tk = idx & 7, dl = idx >> 3;
            const u32x4 w = *(const u32x4*)(yT + ((size_t)(128 * db + dl) * NB + b) * HLT + toff + t0 + 8 * tk);
#pragma unroll
            for (int j = 0; j < 4; ++j) { *(LAS bf16_t*)(lds + (8 * tk + 2 * j) * RS + dl * 2) = (bf16_t)(w[j] & 0xffffu); *(LAS bf16_t*)(lds + (8 * tk + 2 * j + 1) * RS + dl * 2) = (bf16_t)(w[j] >> 16); }
        }
        __syncthreads();
#pragma unroll
        for (int k = 0; k < 4; ++k) {
            const int idx = tid + 512 * k, tl = idx >> 5, d4 = idx & 31, r = rbase + t0 + tl, dq = 128 * db + 4 * d4;
            const u32x2 yv = *(const LAS u32x2*)(lds + tl * RS + d4 * 8);
            const f32x4 xv = xq[k];
            u32x2 w; w.x = cvt_pk_bf16(bflo(yv.x) * xv[0], bfhi(yv.x) * xv[1]); w.y = cvt_pk_bf16(bflo(yv.y) * xv[2], bfhi(yv.y) * xv[3]);
            *(u32x2*)(gout + (size_t)r * D + dq) = w;
        }
        __syncthreads();
    }
}

__device__ __forceinline__ float softplus_f(float x) { return x > 20.f ? x : log1pf(expf(x)); }
__device__ __forceinline__ void phase_ssm_scan(const PV& P, LAS unsigned char* lds) {
    const bf16_t* zx = (const bf16_t*)(P.ws() + OFF_ZX); float* Y = (float*)(P.ws() + OFF_Y); const bf16_t* bcact = (const bf16_t*)(P.ws() + OFF_HB);
    const float* cw = P.in(27); const float* cb = P.in(28); const float* dtb = P.in(29); const float* alog = P.in(30); const float* dsk = P.in(31);
    const int tid = P.tid, lane = tid & 63, wave = __builtin_amdgcn_readfirstlane(tid >> 6), g = lane >> 4, q16 = lane & 15;
    constexpr int RS = 272;
    LAS unsigned char* BS = lds;
    LAS unsigned char* CS = lds + 128 * RS;
    LAS unsigned char* BT = lds + 256 * RS;
    LAS unsigned char* XT = lds + 384 * RS;
    LAS unsigned char* ST = lds + 448 * RS;
    LAS float* csf = (LAS float*)(lds + 512 * RS);
    LAS float* dtf = csf + 128;
    LAS float* WX = (LAS float*)(lds + 512 * RS + 1024);
    for (int uidx = P.bid; uidx < 256; uidx += P.gsz) {
        const int b = uidx >> 5, h = uidx & 31, grp = h >> 3;
        const float Dh = dsk[h];
        __syncthreads();
        if (tid < 256) { const int tap = tid >> 6, cx = tid & 63; WX[tid] = tap < 3 ? cw[tap * 3072 + h * 64 + cx] : cb[h * 64 + cx]; }
        __syncthreads();
        for (int dir = 0; dir < 2; ++dir) {
            const float av = -expf(alog[dir * 32 + h]), dtbias = dtb[dir * 32 + h];
            f32x4 st[4];
#pragma unroll
            for (int i = 0; i < 4; ++i) st[i] = (f32x4){0.f, 0.f, 0.f, 0.f};
            u32x4 rawX[2][3], rawC[8]; float dtr0 = 0.f, dtr1 = 0.f;
#define SC_GEO(cx, ccx, Lx, basex) const int ccx = (cx) < 2 ? (cx) : (cx) - 2, Lx = (cx) < 2 ? CTXL : SEQ, basex = (cx) < 2 ? TL + b * CTXL : b * SEQ
#define SC_ROWX(l, ccx, Lx) (dir == 0 ? 128 * (ccx) + (l) : (Lx) - 1 - 128 * (ccx) - (l))
#define SC_FETCH(ccx, Lx, basex) do { \
            _Pragma("unroll") for (int k = 0; k < 2; ++k) { const int it = tid + 512 * k; const int l = it & 127, gi = __builtin_amdgcn_readfirstlane(it >> 7); \
                const int t = SC_ROWX(l, ccx, Lx); const u32x4 z4 = (u32x4){0u, 0u, 0u, 0u}; \
                const bf16_t* bp = zx + (size_t)((basex) + t) * SSM_IN + 2048 + h * 64 + 8 * gi; \
                rawX[k][0] = t > 0 ? *(const u32x4*)(bp - SSM_IN) : z4; rawX[k][1] = *(const u32x4*)bp; rawX[k][2] = t < (Lx) - 1 ? *(const u32x4*)(bp + SSM_IN) : z4; } \
            _Pragma("unroll") for (int k = 2; k < 10; ++k) { const int it = tid + 512 * k; const int l = it & 127, gi = __builtin_amdgcn_readfirstlane(it >> 7); \
                const int t = SC_ROWX(l, ccx, Lx); \
                const int bcol = gi < 24 ? grp * 128 + 8 * (gi - 8) : 512 + grp * 128 + 8 * (gi - 24); \
                rawC[k - 2] = *(const u32x4*)(bcact + (size_t)((basex) + t) * 1024 + bcol); } } while (0)
#define SC_FETCH_DT(ccx, Lx, basex) do { if (wave < 2) { \
                dtr0 = bf2f(zx[(size_t)((basex) + SC_ROWX(64 * wave + lane, ccx, Lx)) * SSM_IN + 5120 + dir * 32 + h]); \
                if (wave == 1) dtr1 = bf2f(zx[(size_t)((basex) + SC_ROWX(lane, ccx, Lx)) * SSM_IN + 5120 + dir * 32 + h]); } } while (0)
#define SC_STAGE() do { \
            _Pragma("unroll") for (int k = 0; k < 2; ++k) { const int it = tid + 512 * k; const int l = it & 127, gi = __builtin_amdgcn_readfirstlane(it >> 7); \
                float o[8]; \
                _Pragma("unroll") for (int e2 = 0; e2 < 4; ++e2) { \
                    const unsigned wm = rawX[k][0][e2], w0 = rawX[k][1][e2], wp = rawX[k][2][e2]; \
                    const f32x2 c0 = *(const LAS f32x2*)(WX + 8 * gi + 2 * e2), c1 = *(const LAS f32x2*)(WX + 64 + 8 * gi + 2 * e2), c2 = *(const LAS f32x2*)(WX + 128 + 8 * gi + 2 * e2), cbv = *(const LAS f32x2*)(WX + 192 + 8 * gi + 2 * e2); \
                    o[2 * e2] = silu_f(cbv[0] + bflo(wm) * c0[0] + bflo(w0) * c1[0] + bflo(wp) * c2[0]); \
                    o[2 * e2 + 1] = silu_f(cbv[1] + bfhi(wm) * c0[1] + bfhi(w0) * c1[1] + bfhi(wp) * c2[1]); } \
                const float dtl = dtf[l]; \
                _Pragma("unroll") for (int e = 0; e < 8; ++e) *(LAS bf16_t*)(XT + (8 * gi + e) * RS + l * 2) = (bf16_t)(cvt_pk_bf16(o[e] * dtl, 0.f) & 0xffffu); \
                if (dir == 0) { float* yq = Y + (size_t)(base + SC_ROW(l)) * 2048 + h * 64 + 8 * gi; \
                    *(f32x4*)yq = (f32x4){o[0] * Dh, o[1] * Dh, o[2] * Dh, o[3] * Dh}; *(f32x4*)(yq + 4) = (f32x4){o[4] * Dh, o[5] * Dh, o[6] * Dh, o[7] * Dh}; } } \
            _Pragma("unroll") for (int k = 2; k < 10; ++k) { const int it = tid + 512 * k; const int l = it & 127, gi = __builtin_amdgcn_readfirstlane(it >> 7); \
                const u32x4 w = rawC[k - 2]; \
                if (gi < 24) { \
                    const int n0 = 8 * (gi - 8); \
                    *(LAS u32x4*)(BS + l * RS + n0 * 2) = w; \
                    const float dec = __expf(cs127 - csf[l]); \
                    _Pragma("unroll") for (int e2 = 0; e2 < 4; ++e2) { \
                        *(LAS bf16_t*)(BT + (n0 + 2 * e2) * RS + l * 2) = (bf16_t)(cvt_pk_bf16(bflo(w[e2]) * dec, 0.f) & 0xffffu); \
                        *(LAS bf16_t*)(BT + (n0 + 2 * e2 + 1) * RS + l * 2) = (bf16_t)(cvt_pk_bf16(bfhi(w[e2]) * dec, 0.f) & 0xffffu); } \
                } else { \
                    *(LAS u32x4*)(CS + l * RS + 8 * (gi - 24) * 2) = w; \
                } } } while (0)
            { SC_GEO(0, cc0, L0, base0); SC_FETCH(cc0, L0, base0); SC_FETCH_DT(cc0, L0, base0); }
#pragma unroll 1
            for (int c = 0; c < 18; ++c) {
                SC_GEO(c, cc, L, base);
#define SC_ROW(l) SC_ROWX(l, cc, L)
                if (wave < 2) {
                    const int l = 64 * wave + lane;
                    const float dtv = softplus_f(dtr0 + dtbias);
                    float x = av * dtv;
#pragma unroll
                    for (int o = 1; o < 64; o <<= 1) { const float y = __shfl_up(x, o); if (lane >= o) x += y; }
                    if (wave == 1) { const float d0 = softplus_f(dtr1 + dtbias); x += wave_sum(av * d0); }
                    csf[l] = x; dtf[l] = dtv;
                }
                __syncthreads();
                const float cs127 = csf[127];
                SC_STAGE();
                asm volatile("s_waitcnt vmcnt(0)" ::: "memory");
                __syncthreads();
                if (c + 1 < 18) { SC_GEO(c + 1, ccn, Ln, basen); SC_FETCH(ccn, Ln, basen); SC_FETCH_DT(ccn, Ln, basen); }
                {
                    const int l = 16 * wave + q16;
                    const float csl = csf[l];
                    float* yp = Y + (size_t)(base + SC_ROW(l)) * 2048 + h * 64 + 4 * g;
                    f32x4 yold[4];
#pragma unroll
                    for (int pt = 0; pt < 4; ++pt) yold[pt] = (f32x4){0.f, 0.f, 0.f, 0.f};
                    if (dir == 1) {
#pragma unroll
                        for (int pt = 0; pt < 4; ++pt) yold[pt] = *(const f32x4*)(yp + 16 * pt);
                    }
                    bf16x8 cfrag[4];
#pragma unroll
                    for (int kk = 0; kk < 4; ++kk) cfrag[kk] = *(const LAS bf16x8*)(CS + l * RS + (8 * g + 32 * kk) * 2);
                    f32x4 acc[4];
#pragma unroll
                    for (int pt = 0; pt < 4; ++pt) acc[pt] = (f32x4){0.f, 0.f, 0.f, 0.f};
                    if (c > 0) {
                        const LAS unsigned char* sbase = ST + q16 * RS + 16 * g;
                        bf16x8 sa[4], sn[4];
#pragma unroll
                        for (int kk = 0; kk < 4; ++kk) sa[kk] = *(const LAS bf16x8*)(sbase + 64 * kk);
#pragma unroll
                        for (int pt = 0; pt < 4; ++pt) {
                            if (pt < 3) {
#pragma unroll
                                for (int kk = 0; kk < 4; ++kk) sn[kk] = *(const LAS bf16x8*)(sbase + (16 * (pt + 1)) * RS + 64 * kk);
                            }
                            __builtin_amdgcn_sched_barrier(0);
#pragma unroll
                            for (int kk = 0; kk < 4; ++kk) acc[pt] = __builtin_amdgcn_mfma_f32_16x16x32_bf16(sa[kk], cfrag[kk], acc[pt], 0, 0, 0);
#pragma unroll
                            for (int kk = 0; kk < 4; ++kk) sa[kk] = sn[kk];
                        }
                        const float el = __expf(csl);
#pragma unroll
                        for (int pt = 0; pt < 4; ++pt) acc[pt] = acc[pt] * el;
                    }
                    const int nblk = (wave >> 1) + 1;
                    for (int sb = 0; sb < nblk; ++sb) {
                        f32x4 gt[2];
                        bf16x8 bfr8[8], xfr[4];
#pragma unroll
                        for (int f = 0; f < 8; ++f) { const int kt = f >> 2, kk = f & 3; const int srow = 32 * sb + 8 * (q16 >> 2) + 4 * kt + (q16 & 3);
                            bfr8[f] = *(const LAS bf16x8*)(BS + srow * RS + (8 * g + 32 * kk) * 2); }
#pragma unroll
                        for (int pt = 0; pt < 4; ++pt) xfr[pt] = *(const LAS bf16x8*)(XT + (16 * pt + q16) * RS + (32 * sb + 8 * g) * 2);
                        __builtin_amdgcn_sched_barrier(0);
#pragma unroll
                        for (int kt = 0; kt < 2; ++kt) {
                            gt[kt] = (f32x4){0.f, 0.f, 0.f, 0.f};
#pragma unroll
                            for (int kk = 0; kk < 4; ++kk) gt[kt] = __builtin_amdgcn_mfma_f32_16x16x32_bf16(bfr8[4 * kt + kk], cfrag[kk], gt[kt], 0, 0, 0);
                        }
                        const f32x4 cs0 = *(const LAS f32x4*)(csf + 32 * sb + 8 * g), cs1 = *(const LAS f32x4*)(csf + 32 * sb + 8 * g + 4);
                        float mm[8];
#pragma unroll
                        for (int j = 0; j < 4; ++j) {
                            const int s0 = 32 * sb + 8 * g + j, s1 = s0 + 4;
                            mm[j] = (s0 <= l) ? gt[0][j] * __expf(fminf(csl - cs0[j], 0.f)) : 0.f;
                            mm[4 + j] = (s1 <= l) ? gt[1][j] * __expf(fminf(csl - cs1[j], 0.f)) : 0.f;
                        }
                        u32x4 w; w.x = cvt_pk_bf16_m(mm[0], mm[1]); w.y = cvt_pk_bf16_m(mm[2], mm[3]); w.z = cvt_pk_bf16_m(mm[4], mm[5]); w.w = cvt_pk_bf16_m(mm[6], mm[7]);
                        const bf16x8 pm = __builtin_bit_cast(bf16x8, w);
#pragma unroll
                        for (int pt = 0; pt < 4; ++pt) acc[pt] = __builtin_amdgcn_mfma_f32_16x16x32_bf16(xfr[pt], pm, acc[pt], 0, 0, 0);
                    }
#pragma unroll
                    for (int pt = 0; pt < 4; ++pt) { if (dir == 0) yold[pt] = *(const f32x4*)(yp + 16 * pt); *(f32x4*)(yp + 16 * pt) = yold[pt] + acc[pt]; }
                }
                asm volatile("s_waitcnt vmcnt(0)" ::: "memory");
                __syncthreads();
                {
                    const float ec = __expf(cs127);
#pragma unroll
                    for (int pt = 0; pt < 4; ++pt) st[pt] = st[pt] * ec;
                    {
                        bf16x8 btf[4], xa[4], xn[4];
#pragma unroll
                        for (int kk = 0; kk < 4; ++kk) btf[kk] = *(const LAS bf16x8*)(BT + (16 * wave + q16) * RS + (8 * g + 32 * kk) * 2);
#pragma unroll
                        for (int pt = 0; pt < 4; ++pt) xa[pt] = *(const LAS bf16x8*)(XT + (16 * pt + q16) * RS + (8 * g) * 2);
#pragma unroll
                        for (int kk = 0; kk < 4; ++kk) {
                            if (kk < 3) {
#pragma unroll
                                for (int pt = 0; pt < 4; ++pt) xn[pt] = *(const LAS bf16x8*)(XT + (16 * pt + q16) * RS + (8 * g + 32 * (kk + 1)) * 2);
                            }
                            __builtin_amdgcn_sched_barrier(0);
#pragma unroll
                            for (int pt = 0; pt < 4; ++pt) st[pt] = __builtin_amdgcn_mfma_f32_16x16x32_bf16(xa[pt], btf[kk], st[pt], 0, 0, 0);
#pragma unroll
                            for (int pt = 0; pt < 4; ++pt) xa[pt] = xn[pt];
                        }
                    }
#pragma unroll
                    for (int pt = 0; pt < 4; ++pt)
#pragma unroll
                        for (int j = 0; j < 4; ++j) *(LAS bf16_t*)(ST + (16 * pt + 4 * g + j) * RS + (16 * wave + q16) * 2) = (bf16_t)(cvt_pk_bf16(st[pt][j], 0.f) & 0xffffu);
                }
                __syncthreads();
#undef SC_ROW
            }
#undef SC_GEO
#undef SC_ROWX
#undef SC_FETCH
#undef SC_FETCH_DT
#undef SC_STAGE
        }
    }
}
__device__ __forceinline__ void phase_ssm_bc(const PV& P) {
    const bf16_t* zx = (const bf16_t*)(P.ws() + OFF_ZX); bf16_t* bc = (bf16_t*)(P.ws() + OFF_HB);
    const float* cw = P.in(27); const float* cb = P.in(28);
    const int tid = P.tid, c8 = (tid & 127) * 8, rsub = tid >> 7;
    f32x4 w0[2], w1[2], w2[2], bb[2];
#pragma unroll
    for (int q = 0; q < 2; ++q) { w0[q] = *(const f32x4*)(cw + 2048 + c8 + 4 * q); w1[q] = *(const f32x4*)(cw + 3072 + 2048 + c8 + 4 * q); w2[q] = *(const f32x4*)(cw + 6144 + 2048 + c8 + 4 * q); bb[q] = *(const f32x4*)(cb + 2048 + c8 + 4 * q); }
    const int rstep = P.gsz * 4;
    u32x4 nm, n0, np;
#define BC_LOAD(rr) do { int t_, L_; if ((rr) < TL) { t_ = (rr) & (SEQ - 1); L_ = SEQ; } else { t_ = ((rr) - TL) & (CTXL - 1); L_ = CTXL; } \
        const bf16_t* bp_ = zx + (size_t)(rr) * SSM_IN + 4096 + c8; const u32x4 z4_ = (u32x4){0u, 0u, 0u, 0u}; \
        nm = t_ > 0 ? *(const u32x4*)(bp_ - SSM_IN) : z4_; n0 = *(const u32x4*)bp_; np = t_ < L_ - 1 ? *(const u32x4*)(bp_ + SSM_IN) : z4_; } while (0)
    if (P.bid * 4 + rsub < TA) BC_LOAD(P.bid * 4 + rsub);
    for (int r = P.bid * 4 + rsub; r < TA; r += rstep) {
        const u32x4 um = nm, u0 = n0, up = np;
        if (r + rstep < TA) BC_LOAD(r + rstep);
        float o[8];
#pragma unroll
        for (int e2 = 0; e2 < 4; ++e2) { const int q = e2 >> 1, k = (e2 & 1) * 2;
            o[2 * e2] = silu_f(bb[q][k] + bflo(um[e2]) * w0[q][k] + bflo(u0[e2]) * w1[q][k] + bflo(up[e2]) * w2[q][k]);
            o[2 * e2 + 1] = silu_f(bb[q][k + 1] + bfhi(um[e2]) * w0[q][k + 1] + bfhi(u0[e2]) * w1[q][k + 1] + bfhi(up[e2]) * w2[q][k + 1]); }
        u32x4 w; w.x = cvt_pk_bf16(o[0], o[1]); w.y = cvt_pk_bf16(o[2], o[3]); w.z = cvt_pk_bf16(o[4], o[5]); w.w = cvt_pk_bf16(o[6], o[7]);
        *(u32x4*)(bc + (size_t)r * 1024 + c8) = w;
    }
#undef BC_LOAD
}
__device__ __forceinline__ void phase_ssm_gate(const PV& P) {
    const bf16_t* zx = (const bf16_t*)(P.ws() + OFF_ZX); float* Y = (float*)(P.ws() + OFF_Y); const float* ng = P.in(32);
    const int lane = P.tid & 63, wave = P.tid >> 6, gw = P.bid * 8 + wave, NGW = P.gsz * 8;
    f32x4 ngv[8];
#pragma unroll
    for (int j = 0; j < 8; ++j) ngv[j] = *((const f32x4*)ng + lane + 64 * j);
    f32x4 ny[8]; u32x2 nz[8];
    if (gw < TA) {
#pragma unroll
        for (int j = 0; j < 8; ++j) { ny[j] = *((const f32x4*)(Y + (size_t)gw * 2048) + lane + 64 * j); nz[j] = *((const u32x2*)(zx + (size_t)gw * SSM_IN) + lane + 64 * j); }
    }
    for (int r = gw; r < TA; r += NGW) {
        float* yrow = Y + (size_t)r * 2048;
        f32x4 v[8], cy[8]; u32x2 cz[8];
#pragma unroll
        for (int j = 0; j < 8; ++j) { cy[j] = ny[j]; cz[j] = nz[j]; }
        if (r + NGW < TA) {
#pragma unroll
            for (int j = 0; j < 8; ++j) { ny[j] = *((const f32x4*)(Y + (size_t)(r + NGW) * 2048) + lane + 64 * j); nz[j] = *((const u32x2*)(zx + (size_t)(r + NGW) * SSM_IN) + lane + 64 * j); }
        }
#pragma unroll
        for (int j = 0; j < 8; ++j) { const f32x4 y = cy[j]; const u32x2 zz = cz[j];
            v[j][0] = y[0] * silu_f(bflo(zz.x)); v[j][1] = y[1] * silu_f(bfhi(zz.x)); v[j][2] = y[2] * silu_f(bflo(zz.y)); v[j][3] = y[3] * silu_f(bfhi(zz.y)); }
        float rs[4];
#pragma unroll
        for (int gq = 0; gq < 4; ++gq) { float s = 0.f;
#pragma unroll
            for (int jj = 0; jj < 2; ++jj) { const f32x4 x = v[2 * gq + jj]; s += (x[0] * x[0] + x[1] * x[1]) + (x[2] * x[2] + x[3] * x[3]); }
            rs[gq] = 1.0f / sqrtf(wave_sum(s) * (1.0f / 512.0f) + LN_EPS); }
        bf16_t* orow = (bf16_t*)yrow;
#pragma unroll
        for (int j = 0; j < 8; ++j) { const f32x4 o = v[j] * rs[j >> 1] * ngv[j];
            u32x2 w; w.x = cvt_pk_bf16(o[0], o[1]); w.y = cvt_pk_bf16(o[2], o[3]); *((u32x2*)orow + lane + 64 * j) = w; }
    }
}


#ifndef REP_ATT
#define REP_ATT 1
#endif
#ifndef REP_HL
#define REP_HL 1
#endif
#ifndef REP_SCAN
#define REP_SCAN 1
#endif
#ifndef REP_FFN1
#define REP_FFN1 1
#endif
#ifndef REP_PRO
#define REP_PRO 1
#endif
#ifndef PROBE_STAGE_MASK
#define PROBE_STAGE_MASK 0
#endif
#ifndef PROBE_KIND_MASK
#define PROBE_KIND_MASK 7
#endif
__global__ void __launch_bounds__(512, 2) fwd_megakernel(Params PK) {
    extern __shared__ __attribute__((aligned(16))) unsigned char shm[];
    LAS unsigned char* lds = (LAS unsigned char*)shm;
    cg::grid_group grid = cg::this_grid();
    bool first = true;
    const int ph_lo = PK.ph_lo, ph_hi = PK.ph_hi;
    volatile LAS unsigned* bst = (volatile LAS unsigned*)(lds + LDS_BYTES - 64);
    if (threadIdx.x < 2) bst[threadIdx.x] = 0u;
    __syncthreads();
    XcdBarrier xbar; xbar.bar = nullptr; xbar.x = 0u; xbar.st = bst;
    int nseam = 0;
    int prep = 0;
    for (int ph = ph_lo; ph < ph_hi; ) {
        int layer = 0, st = -1;
        if (ph >= 2) { layer = (ph - 2) / 12; st = (ph - 2) % 12; }
        const int kind = layer % 3, jm = layer / 3;
        if (ph >= 2 && ((st == 5 || st == 6) && kind == 0)) { ++ph; continue; }
        if (!first) {
            if (nseam == 0) { grid.sync(); xbar = xcd_barrier_post((unsigned*)(PK.ws + OFF_BAR), bst, (int)threadIdx.x); }
            else xcd_barrier(xbar, (int)threadIdx.x, gridDim.x);
            ++nseam;
        }
        first = false;
        PV P; P.ka = (KArg)__builtin_amdgcn_kernarg_segment_ptr();
        asm volatile("" : "+s"(P.ka));
        { int t_ = threadIdx.x, b_ = blockIdx.x, g_ = gridDim.x; asm volatile("" : "+v"(t_)); asm volatile("" : "+s"(b_)); asm volatile("" : "+s"(g_)); P.tid = t_; P.bid = b_; P.gsz = g_; }
        const int G = P.gsz, bid = P.bid;
        unsigned char* ws = P.ws();
        float* lat = (float*)(ws + OFF_LAT); const bf16_t* hb = (const bf16_t*)(ws + OFF_HB); const float* mod = (const float*)(ws + OFF_MOD);
        if (ph == 0) { for (int rep = 0; rep < REP_PRO; ++rep) { phase_prologue(P, lds); __syncthreads(); } ++ph; continue; }
        if (ph == 1) { phase_init(P); ++ph; continue; }
        const bool lastl = (layer == 3);
        const float* modl = mod + (size_t)layer * 9 * NMODC;
        const int Mpost = lastl ? TL : TA;
        pg8::StaticOrder S;
        switch (st) {
        case 0: case 9: {
            const int s = st == 0 ? 0 : 1; const int M = (st == 9) ? Mpost : TA;
            pg8::Gemm g{hb, (const bf16_t*)(ws + OFF_W13T) + (size_t)(layer * 2 + s) * 5632 * 1024, M, 5632, 1024, 1024};
            S.init(M, 5632, G, bid); S.setk(1024); EpiSwiglu E{(bf16_t*)(ws + OFF_ACT)};
            for (int rep = 0; rep < REP_FFN1; ++rep) pg8::gemm_phase(lds, g, S, E, P.tid);
        } break;
        case 1: case 10: {
            const int s = st == 1 ? 0 : 1; const int M = (st == 10) ? Mpost : TA;
            pg8::Gemm g{(const bf16_t*)(ws + OFF_ACT), (const bf16_t*)(ws + OFF_W2T) + (size_t)(layer * 2 + s) * 1024 * FF, M, 1024, FF, FF};
            EpiResid E{lat, modl, s == 0 ? 2 : 8, 0.5f, nullptr};
            if (M == TA) { pg8::SplitOrder<8> S2; S2.init(FF, G, bid); EpiResidSplit E2{E, (float*)(ws + OFF_SLAB)}; pg8::gemm_phase(lds, g, S2, E2, P.tid); }
            else { S.init(M, 1024, G, bid); S.setk(FF); pg8::gemm_phase(lds, g, S, E, P.tid); }
        } break;
        case 2: case 8: case 11: {
            const int lidx = st == 2 ? 0 : (st == 8 ? 1 : 2);
            const bool fin = (st == 11) && lastl;
            const int Mln = st == 2 ? TA : (st == 8 ? Mpost : (lastl ? TL : TA));
            const float* nm = st == 11 ? modl + (size_t)9 * NMODC : modl;
            const int qs = st == 2 ? 3 : (st == 8 ? 6 : 0);
            const bool comb = (st == 2) || (st == 11 && !lastl);
            const float* sl = comb ? (const float*)(ws + OFF_SLAB) : nullptr;
            const float* g8 = modl + (size_t)8 * NMODC + (st == 2 ? 2 : 8) * 1024;
            phase_ln(P, Mln, P.in(6) + (size_t)(layer * 3 + lidx) * D, P.in(7) + (size_t)(layer * 3 + lidx) * D, nm, qs, fin ? P.out() : nullptr, sl, g8, 0.5f);
        } break;
        case 3: {
            if (kind == 0) {
                { pg8::Gemm g{hb, (const bf16_t*)(ws + OFF_WQKT) + (size_t)jm * 2048 * 1024, TA, 2048, 1024, 1024};
                  S.init(TA, 2048, G, bid); S.setk(1024); EpiQK E{(bf16_t*)(ws + OFF_QK), (const float*)(ws + OFF_ROPE)};
                  pg8::gemm_phase(lds, g, S, E, P.tid); }
                { pg8::Gemm g{(const bf16_t*)(ws + OFF_WVT) + (size_t)jm * 1024 * 1024, hb, 1024, TA, 1024, 1024};
                  S.init(1024, TA, G, bid); S.setk(1024); EpiB E{(bf16_t*)(ws + OFF_VT), TA, nullptr, TA};
                  pg8::gemm_phase(lds, g, S, E, P.tid); }
            } else if (kind == 1) {
                pg8::Gemm g{hb, (const bf16_t*)(ws + OFF_WHIT), TA, 3072, 1024, 1024};
                S.init(TA, 3072, G, bid); S.setk(1024); EpiB E{(bf16_t*)(ws + OFF_HU), 3072, P.in(15), 3072};
                pg8::gemm_phase(lds, g, S, E, P.tid);
            } else {
                pg8::Gemm g{hb, (const bf16_t*)(ws + OFF_WSIT), TA, SSM_INP, 1024, 1024};
                S.init(TA, SSM_INP, G, bid); S.setk(1024); EpiB E{(bf16_t*)(ws + OFF_ZX), SSM_IN, nullptr, SSM_IN};
                pg8::gemm_phase(lds, g, S, E, P.tid);
            }
        } break;
        case 4: {
            if (kind == 0) { for (int rep = 0; rep < REP_ATT; ++rep) phase_attention(P, lds, jm, layer == 0 ? 0.2f : (0.8f - 0.6f * 0.40656965974059917f), !lastl); }
            else if (kind == 1) phase_hy_short(P, lds);
            else phase_ssm_bc(P);
        } break;
        case 5: {
            if (kind == 1) phase_hy_conv(P, lds);
            else phase_ssm_scan(P, lds);
        } break;
        case 6: if (kind == 1) phase_hy_gate(P, lds); else phase_ssm_gate(P); break;
        case 7: {
            const bf16_t* Ap = kind == 0 ? (const bf16_t*)(ws + OFF_AO) : (kind == 1 ? (const bf16_t*)(ws + OFF_HG) : (const bf16_t*)(ws + OFF_Y));
            const bf16_t* Bp = kind == 0 ? (const bf16_t*)(ws + OFF_WOT) + (size_t)jm * 1024 * 1024 : (kind == 1 ? (const bf16_t*)(ws + OFF_WHOT) : (const bf16_t*)(ws + OFF_WSOT));
            const int Mo = kind == 0 ? Mpost : TA, Ko = kind == 2 ? 2048 : 1024, ldo = kind == 2 ? 4096 : 1024;
            const float* bo = kind == 1 ? P.in(25) : nullptr;
            pg8::Gemm g{Ap, Bp, Mo, 1024, Ko, ldo};
            S.init(Mo, 1024, G, bid); S.setk(Ko); EpiResid E{lat, modl, 5, 1.0f, bo};
            pg8::gemm_phase(lds, g, S, E, P.tid);
        } break;
        default: break;
        }
        if (PROBE_STAGE_MASK && ((PROBE_STAGE_MASK >> st) & 1) && ((PROBE_KIND_MASK >> kind) & 1) && prep == 0) prep = 1; else { prep = 0; ++ph; }
    }
}

extern "C" void kernel_launch(void* const* d_in, const int* in_sizes, int n_in, void* d_out, int out_size, void* d_ws, size_t ws_size, hipStream_t stream) {
    static int grid = 0;
    if (grid == 0) {
        if (n_in != 34 || ws_size < WS_END) { fprintf(stderr, "kernel_launch: unexpected n_in %d or ws_size %zu (< %zu)\n", n_in, ws_size, (size_t)WS_END); grid = -1; return; }
        int dev = 0, cus = 0, per_cu = 0;
        (void)hipGetDevice(&dev);
        (void)hipDeviceGetAttribute(&cus, hipDeviceAttributeMultiprocessorCount, dev);
        if (hipFuncSetAttribute((const void*)fwd_megakernel, hipFuncAttributeMaxDynamicSharedMemorySize, LDS_BYTES) != hipSuccess) { fprintf(stderr, "kernel_launch: hipFuncSetAttribute failed\n"); }
        (void)hipOccupancyMaxActiveBlocksPerMultiprocessor(&per_cu, (const void*)fwd_megakernel, 512, LDS_BYTES);
        (void)hipGetLastError();
        if (per_cu < 1) { fprintf(stderr, "kernel_launch: occupancy query says %d blocks per CU\n", per_cu); per_cu = 1; }
        grid = cus;
    }
    if (grid < 0) return;
    Params p{};
    for (int i = 0; i < 34; ++i) p.in[i] = (const float*)d_in[i];
    p.out = (float*)d_out; p.ws = (unsigned char*)d_ws; p.ph_lo = 0; p.ph_hi = 2 + 48;
    void* args[] = {&p};
    hipError_t e = hipLaunchCooperativeKernel((const void*)fwd_megakernel, dim3(grid), dim3(512), args, LDS_BYTES, stream);
    if (e != hipSuccess) fprintf(stderr, "cooperative launch failed: %s (grid %d)\n", hipGetErrorString(e), grid);
}
```

```cpp
#include <hip/hip_runtime.h>
#include <hip/hip_cooperative_groups.h>
#include <cstdio>
namespace cg = cooperative_groups;

#define LAS __attribute__((address_space(3)))
typedef unsigned short bf16_t;
typedef short bf16x8 __attribute__((ext_vector_type(8)));
typedef float f32x4 __attribute__((ext_vector_type(4)));
typedef float f32x2 __attribute__((ext_vector_type(2)));
typedef unsigned u32x4 __attribute__((ext_vector_type(4)));
typedef unsigned u32x2 __attribute__((ext_vector_type(2)));

constexpr int D = 1024, FF = 2816, TL = 16384, TC = 2048, TA = 18432, SEQ = 2048, CTXL = 256, NB = 8;
constexpr int NMODC = 9216;
constexpr float DN_ALPHA = 1.681792830507429f;
constexpr float LN_EPS = 1e-5f;
constexpr int SSM_IN = 5184, SSM_INP = 5376;

constexpr size_t al256(size_t x) { return (x + 255) & ~(size_t)255; }
constexpr size_t OFF_MOD = 0;
constexpr size_t OFF_ROPE = OFF_MOD + al256((size_t)4 * 9 * NMODC * 4);
constexpr size_t OFF_BAR = OFF_ROPE + al256(2 * 1024 * 4);
constexpr size_t OFF_KLAT = OFF_BAR + 16384;
constexpr size_t OFF_KCTX = OFF_KLAT + (size_t)4096 * 1024 * 4;
constexpr size_t OFF_W13T = OFF_KCTX + (size_t)512 * 1024 * 4;
constexpr size_t OFF_W2T = OFF_W13T + (size_t)8 * 5632 * 1024 * 2;
constexpr size_t OFF_WQKT = OFF_W2T + (size_t)8 * 1024 * 2816 * 2;
constexpr size_t OFF_WVT = OFF_WQKT + (size_t)2 * 2048 * 1024 * 2;
constexpr size_t OFF_WOT = OFF_WVT + (size_t)2 * 1024 * 1024 * 2;
constexpr size_t OFF_WHIT = OFF_WOT + (size_t)2 * 1024 * 1024 * 2;
constexpr size_t OFF_WHOT = OFF_WHIT + (size_t)3072 * 1024 * 2;
constexpr size_t OFF_WSIT = OFF_WHOT + (size_t)1024 * 1024 * 2;
constexpr size_t OFF_WSOT = OFF_WSIT + (size_t)SSM_INP * 1024 * 2;
constexpr size_t OFF_LAT = OFF_WSOT + (size_t)1024 * 2048 * 2;
constexpr size_t OFF_HB = OFF_LAT + (size_t)TA * D * 4;
constexpr size_t OFF_BIG = OFF_HB + (size_t)TA * D * 2;
constexpr size_t OFF_ACT = OFF_BIG;
constexpr size_t OFF_SLAB = OFF_ACT + al256((size_t)TA * FF * 2);
constexpr size_t OFF_QK = OFF_BIG;
constexpr size_t OFF_VT = OFF_QK + (size_t)TA * 2048 * 2;
constexpr size_t OFF_AO = OFF_VT + (size_t)1024 * TA * 2;
constexpr size_t OFF_HU = OFF_BIG;
constexpr int HLT = SEQ + CTXL;
constexpr size_t OFF_HX0 = OFF_HU + (size_t)TA * 3072 * 2;
constexpr size_t OFF_HVT = OFF_HX0 + (size_t)TA * D * 4;
constexpr size_t OFF_HYT = OFF_HVT + (size_t)D * NB * HLT * 2;
constexpr size_t OFF_HG = OFF_HYT + (size_t)D * NB * HLT * 2;
constexpr size_t OFF_ZX = OFF_BIG;
constexpr size_t OFF_Y = OFF_ZX + al256((size_t)TA * SSM_IN * 2);
constexpr size_t WS_END = OFF_Y + (size_t)TA * 2048 * 4;
static_assert(OFF_HG + (size_t)TA * D * 2 <= WS_END && OFF_SLAB + (size_t)8 * TC * D * 4 <= WS_END, "ws map");
static_assert(WS_END < (size_t)720 * 1000 * 1000, "ws budget");

constexpr int LDS_BYTES = 142336;

struct Params { const float* in[34]; float* out; unsigned char* ws; int ph_lo, ph_hi; };
typedef const __attribute__((address_space(4))) unsigned char* KArg;
struct PV {
    KArg ka; int tid, bid, gsz;
    __device__ __forceinline__ const float* in(int k) const { return *(const float* const __attribute__((address_space(4)))*)(ka + 8 * k); }
    __device__ __forceinline__ float* out() const { return *(float* const __attribute__((address_space(4)))*)(ka + 8 * 34); }
    __device__ __forceinline__ unsigned char* ws() const { return *(unsigned char* const __attribute__((address_space(4)))*)(ka + 8 * 35); }
};

typedef __bf16 bf16x2_t __attribute__((ext_vector_type(2)));
__device__ __forceinline__ unsigned cvt_pk_bf16(float lo, float hi) { const f32x2 v = {lo, hi}; const bf16x2_t r = __builtin_convertvector(v, bf16x2_t); return __builtin_bit_cast(unsigned, r); }
__device__ __forceinline__ unsigned cvt_pk_bf16_m(float lo, float hi) { return cvt_pk_bf16(lo, hi); }
__device__ __forceinline__ float bf2f(unsigned short b) { return __uint_as_float(((unsigned)b) << 16); }
__device__ __forceinline__ float bflo(unsigned w) { return __uint_as_float(w << 16); }
__device__ __forceinline__ float bfhi(unsigned w) { return __uint_as_float(w & 0xffff0000u); }
__device__ __forceinline__ float wave_sum(float v) {
#pragma unroll
    for (int o = 1; o < 64; o <<= 1) v += __shfl_xor(v, o);
    return v;
}
__device__ __forceinline__ float xmax16(float x) { const u32x2 r = __builtin_amdgcn_permlane16_swap(__float_as_uint(x), __float_as_uint(x), false, false); return fmaxf(__uint_as_float(r[0]), __uint_as_float(r[1])); }
__device__ __forceinline__ float xmax32(float x) { const u32x2 r = __builtin_amdgcn_permlane32_swap(__float_as_uint(x), __float_as_uint(x), false, false); return fmaxf(__uint_as_float(r[0]), __uint_as_float(r[1])); }
__device__ __forceinline__ float silu_f(float a) { return a * __builtin_amdgcn_rcpf(1.0f + __expf(-a)); }
#define LDS_WAIT() asm volatile("s_waitcnt lgkmcnt(0)" ::: "memory")

#define XB_TMO      128
#define XB_XCNT(j)  (256  + 64 * (j))
#define XB_XSUB(j)  (1280 + 64 * (j))
#define XB_XGEN(j)  (2304 + 64 * (j))
#define XB_TOP      3328
#define XB_TOPGEN   3392
#define XCD_BAR_WORDS 3456
#define XB_SPIN_CAP (1u << 18)
__device__ __forceinline__ unsigned xb_ld(unsigned* p)              { return __hip_atomic_load(p, __ATOMIC_RELAXED, __HIP_MEMORY_SCOPE_AGENT); }
__device__ __forceinline__ unsigned xb_add(unsigned* p, unsigned v) { return __hip_atomic_fetch_add(p, v, __ATOMIC_RELAXED, __HIP_MEMORY_SCOPE_AGENT); }
__device__ __forceinline__ unsigned xb_xcc_id() { return (unsigned)__builtin_amdgcn_s_getreg((3 << 11) | 20) & 0xFu; }
#define XB_SPIN(cond, bar) do { unsigned _sp = 0; while (cond) { __builtin_amdgcn_s_sleep(1); \
    if ((++_sp & 255u) == 0u) { if (xb_ld(&(bar)[XB_TMO])) break; if (_sp > XB_SPIN_CAP) { atomicAdd(&(bar)[XB_TMO], 1u); break; } } } } while (0)
struct XcdBarrier { unsigned* bar; unsigned x; volatile LAS unsigned* st; };
__device__ __forceinline__ XcdBarrier xcd_barrier_post(unsigned* bar, volatile LAS unsigned* st, int tid) {
    XcdBarrier b; b.bar = bar; b.x = xb_xcc_id(); b.st = st;
    if (tid == 0) (void)xb_add(&bar[XB_XCNT(b.x)], 1u);
    return b;
}
__device__ __forceinline__ void xcd_barrier_complete(unsigned* bar, unsigned x, unsigned G, unsigned& nloc, unsigned& nx) {
    unsigned sum, cnt, mine, sp = 0u;
    for (;;) {
        sum = 0u; cnt = 0u; mine = 0u;
#pragma unroll
        for (unsigned j = 0; j < 16; ++j) { const unsigned c = xb_ld(&bar[XB_XCNT(j)]); sum += c; cnt += (c > 0u) ? 1u : 0u; mine = (j == x) ? c : mine; }
        if (sum == G) break;
        __builtin_amdgcn_s_sleep(1);
        if ((++sp & 255u) == 0u) { if (xb_ld(&bar[XB_TMO])) break; if (sp > XB_SPIN_CAP) { atomicAdd(&bar[XB_TMO], 1u); break; } }
    }
    nloc = mine > 0u ? mine : 1u; nx = cnt > 0u ? cnt : 1u;
}
__device__ __forceinline__ void xcd_barrier(const XcdBarrier& b, int tid, unsigned G) {
    asm volatile("s_waitcnt vmcnt(0)" ::: "memory");
    __syncthreads();
    if (tid == 0) {
        unsigned* bar = b.bar;
        __builtin_amdgcn_s_waitcnt(0);
        unsigned nloc = b.st[0], nx = b.st[1];
        if (nloc == 0u) { xcd_barrier_complete(bar, b.x, G, nloc, nx); b.st[0] = nloc; b.st[1] = nx; }
        const unsigned old = xb_add(&bar[XB_XSUB(b.x)], 1u);
        const unsigned gen = old / nloc;
        if (old + 1u == (gen + 1u) * nloc) {
            __builtin_amdgcn_fence(__ATOMIC_RELEASE, "agent");
            asm volatile("s_waitcnt vmcnt(0)" ::: "memory");
            const unsigned og = xb_add(&bar[XB_TOP], 1u);
            const unsigned tg = og / nx;
            if (og + 1u == (tg + 1u) * nx) xb_add(&bar[XB_TOPGEN], 1u);
            else XB_SPIN(xb_ld(&bar[XB_TOPGEN]) == tg, bar);
            __builtin_amdgcn_fence(__ATOMIC_ACQUIRE, "agent");
            xb_add(&bar[XB_XGEN(b.x)], 1u);
            asm volatile("s_waitcnt vmcnt(0)" ::: "memory");
        } else {
            XB_SPIN(xb_ld(&bar[XB_XGEN(b.x)]) == gen, bar);
            __builtin_amdgcn_fence(__ATOMIC_ACQUIRE, "agent");
            asm volatile("s_waitcnt vmcnt(0)" ::: "memory");
        }
    }
    __syncthreads();
}


namespace pg8 {
constexpr int BM = 256, BK = 64, HALF = 128, HTB = HALF * BK * 2, STAGE_BYTES = 8 * HTB, NXCD = 8, WGM = 8;
__device__ __forceinline__ int lds_byte(int r, int c) { const int st = (r >> 4) * 2 + (c >> 5), rr = r & 15, cc = c & 31, ob = rr * 64 + cc * 2; return st * 1024 + (ob ^ (((ob >> 9) & 1) << 5)); }
__device__ __forceinline__ void stage_rc(int b, int& R, int& C) { const int st = b / 1024, sb = b % 1024, swz = sb ^ (((sb >> 9) & 1) << 5); R = (st >> 1) * 16 + swz / 64; C = (st & 1) * 32 + (swz % 64) / 2; }
__device__ __forceinline__ int perm32(int rho) { const int n = rho >> 4, i = rho & 15; return 8 * (i >> 2) + 4 * n + (i & 3); }
struct Unit { int pm, pn, kt0, nt, ks; };
struct Gemm { const bf16_t* A; const bf16_t* Bt; int M, N, K, lda; };
struct StaticOrder {
    int nM, nN, nwg, G, c, ntk;
    __device__ void init(int M, int N, int G_, int c_) { nM = M / BM; nN = N / BM; nwg = nM * nN; G = G_; c = c_; ntk = 0; }
    __device__ void setk(int K) { ntk = K / BK; }
    __device__ bool next(int i, Unit& u) const {
        const long L = (long)i * G + c; if (L >= nwg) return false;
        int wgid = (int)L; { const int q = nwg / NXCD, r = nwg % NXCD, xcd = wgid % NXCD, off = wgid / NXCD; wgid = (xcd < r ? xcd * (q + 1) : r * (q + 1) + (xcd - r) * q) + off; }
        const int nig = WGM * nN, gid = wgid / nig, fm = gid * WGM, gsz = (nM - fm) < WGM ? (nM - fm) : WGM;
        u.pm = fm + ((wgid % nig) % gsz); u.pn = (wgid % nig) / gsz; u.kt0 = 0; u.nt = ntk; u.ks = -1; return true;
    }
};
template <int NSL> struct SplitOrder {
    int G, c, ntk;
    __device__ void init(int K, int G_, int c_) { G = G_; c = c_; ntk = K / BK; }
    __device__ bool next(int i, Unit& u) const {
        const int L = i * G + c;
        if (L >= 256 + 32 * NSL) return false;
        if (L < 256) {
            const int xcd = L & 7, off = L >> 3;
            u.pm = 8 * xcd + (off & 7); u.pn = off >> 3; u.kt0 = 0; u.nt = ntk; u.ks = -1;
        } else {
            const int j = L - 256, ks = j % NSL, tile = j / NSL;
            const int np = ntk / 2, q = np / NSL, r = np % NSL;
            const int p0 = ks * q + (ks < r ? ks : r), pc = q + (ks < r ? 1 : 0);
            u.pm = 64 + (tile >> 2); u.pn = tile & 3; u.kt0 = 2 * p0; u.nt = 2 * pc; u.ks = ks;
        }
        return true;
    }
};

template <class Epi, class Sched>
__device__ __forceinline__ void gemm_phase(LAS unsigned char* lds, const Gemm g, const Sched& S, const Epi& E, const int tid_in) {
    const int tid = tid_in, wid = __builtin_amdgcn_readfirstlane(tid >> 6), lane = tid & 63, wr = wid >> 2, wc = wid & 3, fr = lane & 15, fq = lane >> 4;
    const int K = g.K, lda = g.lda;
    unsigned voffA[2], voffB[2];
#pragma unroll
    for (int i = 0; i < 2; ++i) { int R, C; stage_rc(tid * 16 + i * 8192, R, C); const int Rb = Epi::PERM ? ((R & ~31) + perm32(R & 31)) : R;
        voffA[i] = (unsigned)(R * lda + C) * 2u; voffB[i] = (unsigned)(Rb * K + C) * 2u; }
    const size_t kstep = (size_t)(BK * 2);
    const size_t hstepA = (size_t)HALF * lda * 2, hstepB = (size_t)HALF * K * 2;
    const size_t tstepA = 2 * hstepA, tstepB = 2 * hstepB;
    const unsigned ldsw = (unsigned)wid * 1024u;
    const int aoff = lds_byte(wr * 64 + fr, fq * 8), boff = lds_byte(wc * 32 + fr, fq * 8);
#define PG8_SA(b, h) (((b) * 2 + (h)) * HTB)
#define PG8_SB(b, h) ((4 + (b) * 2 + (h)) * HTB)
#define PG8_STAGE(bufoff, gbase, voff) do { _Pragma("unroll") for (int _i = 0; _i < 2; ++_i) \
        __builtin_amdgcn_global_load_lds((const unsigned*)((const char*)(gbase) + (voff)[_i]), (LAS unsigned*)(lds + (bufoff) + ldsw + _i * 8192), 16, 0, 0); } while (0)
#define PG8_LDA(dst, b, h) do { _Pragma("unroll") for (int m = 0; m < 4; ++m) _Pragma("unroll") for (int k = 0; k < 2; ++k) dst[m][k] = *(const LAS bf16x8*)(lds + PG8_SA(b, h) + aoff + m * 2048 + k * 1024); } while (0)
#define PG8_LDB(dst, b, h) do { _Pragma("unroll") for (int n = 0; n < 2; ++n) _Pragma("unroll") for (int k = 0; k < 2; ++k) dst[n][k] = *(const LAS bf16x8*)(lds + PG8_SB(b, h) + boff + n * 2048 + k * 1024); } while (0)
#define PG8_MMA(ai, bj, At, Bt) do { __builtin_amdgcn_s_setprio(1); _Pragma("unroll") for (int m = 0; m < 4; ++m) _Pragma("unroll") for (int n = 0; n < 2; ++n) _Pragma("unroll") for (int k = 0; k < 2; ++k) \
        acc[ai][bj][m][n] = __builtin_amdgcn_mfma_f32_16x16x32_bf16(Bt[n][k], At[m][k], acc[ai][bj][m][n], 0, 0, 0); __builtin_amdgcn_s_setprio(0); } while (0)
#define PG8_WAIT_V(n) asm volatile("s_waitcnt vmcnt(" #n ")" ::: "memory")
#define PG8_WAIT_L(n) asm volatile("s_waitcnt lgkmcnt(" #n ")" ::: "memory")
#define PG8_BAR __builtin_amdgcn_s_barrier()
#define PG8_SCHED __builtin_amdgcn_sched_barrier(0)
    Unit cur, nxt; int ui = 0;
    if (!S.next(0, cur)) return;
    f32x4 acc[2][2][4][2];
#pragma unroll
    for (int a = 0; a < 2; ++a)
#pragma unroll
        for (int b = 0; b < 2; ++b)
#pragma unroll
            for (int m = 0; m < 4; ++m)
#pragma unroll
                for (int n = 0; n < 2; ++n) acc[a][b][m][n] = (f32x4){0.f, 0.f, 0.f, 0.f};
    bf16x8 At[4][2], B0[2][2], B1[2][2];
    const char* cA = (const char*)g.A + (size_t)cur.pm * tstepA + (size_t)cur.kt0 * kstep; const char* cB = (const char*)g.Bt + (size_t)cur.pn * tstepB + (size_t)cur.kt0 * kstep;
    PG8_STAGE(PG8_SB(0, 0), cB, voffB); PG8_STAGE(PG8_SB(0, 1), cB + hstepB, voffB); PG8_STAGE(PG8_SA(0, 0), cA, voffA); PG8_STAGE(PG8_SA(0, 1), cA + hstepA, voffA);
    if (wr == 1) PG8_BAR;
    PG8_WAIT_V(2); PG8_BAR;
    PG8_STAGE(PG8_SB(1, 0), cB + kstep, voffB); PG8_STAGE(PG8_SA(1, 0), cA + kstep, voffA); PG8_STAGE(PG8_SB(1, 1), cB + hstepB + kstep, voffB);
    PG8_WAIT_V(6); PG8_BAR;
    for (;;) {
        const bool has_next = S.next(ui + 1, nxt);
        const char* nA = has_next ? (const char*)g.A + (size_t)nxt.pm * tstepA + (size_t)nxt.kt0 * kstep : cA; const char* nB = has_next ? (const char*)g.Bt + (size_t)nxt.pn * tstepB + (size_t)nxt.kt0 * kstep : cB;
        const int nt = cur.nt;
        for (int t = 0; t < nt; t += 2) {
            const bool last = (t == nt - 2);
            const char* a1 = cA + (size_t)(t + 1) * kstep;
            const char* a2 = last ? nA : cA + (size_t)(t + 2) * kstep; const char* b2 = last ? nB : cB + (size_t)(t + 2) * kstep;
            const char* a3 = a2 + kstep; const char* b3 = b2 + kstep;
            PG8_LDB(B0, 0, 0); PG8_LDB(B1, 0, 1); PG8_SCHED; PG8_LDA(At, 0, 0); PG8_STAGE(PG8_SA(1, 1), a1 + hstepA, voffA);
            PG8_WAIT_V(8); PG8_WAIT_L(0); PG8_BAR; PG8_MMA(0, 0, At, B0); PG8_MMA(0, 1, At, B1); PG8_BAR; PG8_SCHED;
            PG8_LDA(At, 0, 1); PG8_STAGE(PG8_SB(0, 0), b2, voffB); PG8_STAGE(PG8_SB(0, 1), b2 + hstepB, voffB); PG8_STAGE(PG8_SA(0, 0), a2, voffA);
            PG8_WAIT_V(8); PG8_WAIT_L(0); PG8_BAR; PG8_MMA(1, 0, At, B0); PG8_MMA(1, 1, At, B1); PG8_BAR; PG8_SCHED;
            PG8_LDB(B0, 1, 0); PG8_LDB(B1, 1, 1); PG8_SCHED; PG8_LDA(At, 1, 0); PG8_STAGE(PG8_SA(0, 1), a2 + hstepA, voffA);
            PG8_WAIT_V(8); PG8_WAIT_L(0); PG8_BAR; PG8_MMA(0, 0, At, B0); PG8_MMA(0, 1, At, B1); PG8_BAR; PG8_SCHED;
            PG8_LDA(At, 1, 1); PG8_STAGE(PG8_SB(1, 0), b3, voffB); PG8_STAGE(PG8_SB(1, 1), b3 + hstepB, voffB); PG8_STAGE(PG8_SA(1, 0), a3, voffA);
            PG8_WAIT_V(8); PG8_WAIT_L(0); PG8_BAR; PG8_MMA(1, 0, At, B0); PG8_MMA(1, 1, At, B1); PG8_BAR; PG8_SCHED;
        }
        if (wr == 0) PG8_BAR;
        E(acc, cur, wr, wc, fr, fq);
        if (!has_next) break;
#pragma unroll
        for (int a = 0; a < 2; ++a)
#pragma unroll
            for (int b = 0; b < 2; ++b)
#pragma unroll
                for (int m = 0; m < 4; ++m)
#pragma unroll
                    for (int n = 0; n < 2; ++n) acc[a][b][m][n] = (f32x4){0.f, 0.f, 0.f, 0.f};
        cur = nxt; cA = nA; cB = nB; ++ui;
        if (wr == 1) PG8_BAR;
    }
    PG8_WAIT_V(0);
    PG8_BAR;
#undef PG8_SA
#undef PG8_SB
#undef PG8_STAGE
#undef PG8_LDA
#undef PG8_LDB
#undef PG8_MMA
#undef PG8_WAIT_V
#undef PG8_WAIT_L
#undef PG8_BAR
#undef PG8_SCHED
}
}
using pg8::Unit;
typedef f32x4 AccT[2][2][4][2];

struct EpiSwiglu {
    static constexpr bool PERM = true;
    bf16_t* O;
    __device__ __forceinline__ void operator()(const AccT& acc, const Unit& u, int wr, int wc, int fr, int fq) const {
        const int row0 = u.pm * 256 + wr * 64 + fr, col0 = u.pn * 128 + wc * 32 + 8 * fq;
#pragma unroll
        for (int ai = 0; ai < 2; ++ai)
#pragma unroll
            for (int m = 0; m < 4; ++m) {
                bf16_t* rowp = O + (size_t)(row0 + ai * 128 + m * 16) * FF + col0;
                const f32x4 a0 = acc[ai][0][m][0], a1 = acc[ai][0][m][1], u0 = acc[ai][1][m][0], u1 = acc[ai][1][m][1];
                u32x4 w;
                w.x = cvt_pk_bf16(silu_f(a0[0]) * u0[0], silu_f(a0[1]) * u0[1]);
                w.y = cvt_pk_bf16(silu_f(a0[2]) * u0[2], silu_f(a0[3]) * u0[3]);
                w.z = cvt_pk_bf16(silu_f(a1[0]) * u1[0], silu_f(a1[1]) * u1[1]);
                w.w = cvt_pk_bf16(silu_f(a1[2]) * u1[2], silu_f(a1[3]) * u1[3]);
                *(u32x4*)rowp = w;
            }
    }
};
struct EpiResid {
    static constexpr bool PERM = false;
    float* lat; const float* modl; int gidx; float w; const float* bias;
    __device__ __forceinline__ void operator()(const AccT& acc, const Unit& u, int wr, int wc, int fr, int fq) const {
        const int mr = (u.pm < 64) ? (u.pm >> 3) : 8;
        const int row0 = u.pm * 256 + wr * 64 + fr, col0 = u.pn * 256 + wc * 32 + 4 * fq;
        const float* gate = modl + (size_t)mr * NMODC + gidx * 1024 + col0;
        float* base = lat + (size_t)row0 * D + col0;
        f32x4 xa[8], xb[8];
#pragma unroll
        for (int i = 0; i < 8; ++i) xa[i] = *(const f32x4*)(base + (size_t)((i >> 2) * 128 + (i & 3) * 16) * D);
#pragma unroll
        for (int k = 0; k < 4; ++k) {
            const int bj = k >> 1, n = k & 1, co = bj * 128 + n * 16;
            if (k < 3) { const int co2 = ((k + 1) >> 1) * 128 + ((k + 1) & 1) * 16;
#pragma unroll
                for (int i = 0; i < 8; ++i) xb[i] = *(const f32x4*)(base + (size_t)((i >> 2) * 128 + (i & 3) * 16) * D + co2); }
            const f32x4 gv = (*(const f32x4*)(gate + co) + 1.0f) * w;
            const f32x4 bv = bias ? *(const f32x4*)(bias + col0 + co) : (f32x4){0.f, 0.f, 0.f, 0.f};
            __builtin_amdgcn_sched_barrier(0);
#pragma unroll
            for (int i = 0; i < 8; ++i) { const int ai = i >> 2, m = i & 3;
                *(f32x4*)(base + (size_t)(ai * 128 + m * 16) * D + co) = xa[i] * DN_ALPHA + gv * (acc[ai][bj][m][n] + bv); }
#pragma unroll
            for (int i = 0; i < 8; ++i) xa[i] = xb[i];
        }
    }
};
struct EpiResidSplit {
    static constexpr bool PERM = false;
    EpiResid r; float* slabs;
    __device__ __forceinline__ void operator()(const AccT& acc, const Unit& u, int wr, int wc, int fr, int fq) const {
        if (u.ks < 0) { r(acc, u, wr, wc, fr, fq); return; }
        const int row0 = u.pm * 256 + wr * 64 + fr, col0 = u.pn * 256 + wc * 32 + 4 * fq;
        float* sb = slabs + ((size_t)u.ks * TC + (row0 - TL)) * D + col0;
#pragma unroll
        for (int ai = 0; ai < 2; ++ai)
#pragma unroll
            for (int m = 0; m < 4; ++m)
#pragma unroll
                for (int bj = 0; bj < 2; ++bj)
#pragma unroll
                    for (int n = 0; n < 2; ++n) *(f32x4*)(sb + (size_t)(ai * 128 + m * 16) * D + bj * 128 + n * 16) = acc[ai][bj][m][n];
    }
};
struct EpiQK {
    static constexpr bool PERM = false;
    bf16_t* O; const float* tab;
    __device__ __forceinline__ void operator()(const AccT& acc, const Unit& u, int wr, int wc, int fr, int fq) const {
        const int row0 = u.pm * 256 + wr * 64 + fr, col0 = u.pn * 256 + wc * 32 + 8 * fq;
        const int axis = wc & 1;
        if (u.pm < 64) {
            f32x4 cs, sn, csn, snn;
            { const int t = row0 & 2047; const int pos = axis ? (t & 63) : (t >> 6);
              cs = *(const f32x4*)(tab + pos * 16 + 4 * fq); sn = *(const f32x4*)(tab + 1024 + pos * 16 + 4 * fq); csn = cs; snn = sn; }
#pragma unroll
            for (int i = 0; i < 8; ++i) {
                const int ai = i >> 2, m = i & 3;
                const int r = row0 + ai * 128 + m * 16;
                if (i < 7) { const int r2 = row0 + ((i + 1) >> 2) * 128 + ((i + 1) & 3) * 16; const int t = r2 & 2047; const int pos = axis ? (t & 63) : (t >> 6);
                    csn = *(const f32x4*)(tab + pos * 16 + 4 * fq); snn = *(const f32x4*)(tab + 1024 + pos * 16 + 4 * fq); }
                bf16_t* rowp = O + (size_t)r * 2048 + col0;
#pragma unroll
                for (int bj = 0; bj < 2; ++bj) {
                    const f32x4 x1 = acc[ai][bj][m][0], x2 = acc[ai][bj][m][1];
                    const f32x4 o1 = x1 * cs - x2 * sn, o2 = x2 * cs + x1 * sn;
                    u32x4 w; w.x = cvt_pk_bf16(o1[0], o1[1]); w.y = cvt_pk_bf16(o1[2], o1[3]); w.z = cvt_pk_bf16(o2[0], o2[1]); w.w = cvt_pk_bf16(o2[2], o2[3]);
                    *(u32x4*)(rowp + bj * 128) = w;
                }
                cs = csn; sn = snn;
            }
        } else {
#pragma unroll
            for (int i = 0; i < 8; ++i) {
                const int ai = i >> 2, m = i & 3;
                bf16_t* rowp = O + (size_t)(row0 + ai * 128 + m * 16) * 2048 + col0;
#pragma unroll
                for (int bj = 0; bj < 2; ++bj) {
                    const f32x4 x1 = acc[ai][bj][m][0], x2 = acc[ai][bj][m][1];
                    u32x4 w; w.x = cvt_pk_bf16(x1[0], x1[1]); w.y = cvt_pk_bf16(x1[2], x1[3]); w.z = cvt_pk_bf16(x2[0], x2[1]); w.w = cvt_pk_bf16(x2[2], x2[3]);
                    *(u32x4*)(rowp + bj * 128) = w;
                }
            }
        }
    }
};
struct EpiB {
    static constexpr bool PERM = true;
    bf16_t* O; int ldc; const float* bias; int ncols;
    __device__ __forceinline__ void operator()(const AccT& acc, const Unit& u, int wr, int wc, int fr, int fq) const {
        const int row0 = u.pm * 256 + wr * 64 + fr, col0 = u.pn * 256 + wc * 32 + 8 * fq;
        bf16_t* base = O + (size_t)row0 * ldc + col0;
#pragma unroll
        for (int bj = 0; bj < 2; ++bj) {
            if (col0 + bj * 128 < ncols) {
                f32x4 b0 = (f32x4){0.f, 0.f, 0.f, 0.f}, b1 = (f32x4){0.f, 0.f, 0.f, 0.f};
                if (bias) { b0 = *(const f32x4*)(bias + col0 + bj * 128); b1 = *(const f32x4*)(bias + col0 + bj * 128 + 4); }
#pragma unroll
                for (int ai = 0; ai < 2; ++ai)
#pragma unroll
                    for (int m = 0; m < 4; ++m) {
                        const f32x4 v0 = acc[ai][bj][m][0] + b0, v1 = acc[ai][bj][m][1] + b1;
                        u32x4 w; w.x = cvt_pk_bf16(v0[0], v0[1]); w.y = cvt_pk_bf16(v0[2], v0[3]); w.z = cvt_pk_bf16(v1[0], v1[1]); w.w = cvt_pk_bf16(v1[2], v1[3]);
                        *(u32x4*)(base + (size_t)(ai * 128 + m * 16) * ldc + bj * 128) = w;
                    }
            }
            asm volatile("" ::: "memory");
        }
    }
};

__device__ __forceinline__ void transpose_tile(const float* W, int ldw, bf16_t* WT, int ldt, int k0, int n0, int drow0, LAS float* scr, int lane) {
    f32x4 wv[8];
#pragma unroll
    for (int i = 0; i < 8; ++i) wv[i] = *(const f32x4*)(W + (size_t)(k0 + 8 * i + (lane >> 3)) * ldw + n0 + 4 * (lane & 7));
#pragma unroll
    for (int i = 0; i < 8; ++i) { LAS float* dd = scr + (8 * i + (lane >> 3)) * 33 + 4 * (lane & 7); dd[0] = wv[i][0]; dd[1] = wv[i][1]; dd[2] = wv[i][2]; dd[3] = wv[i][3]; }
    LDS_WAIT();
    const int c = lane & 7;
#pragma unroll
    for (int j = 0; j < 4; ++j) { const int n = (lane >> 3) + 8 * j; const LAS float* s = scr + (8 * c) * 33 + n;
        u32x4 o; o.x = cvt_pk_bf16(s[0 * 33], s[1 * 33]); o.y = cvt_pk_bf16(s[2 * 33], s[3 * 33]); o.z = cvt_pk_bf16(s[4 * 33], s[5 * 33]); o.w = cvt_pk_bf16(s[6 * 33], s[7 * 33]);
        *(u32x4*)(WT + (size_t)(drow0 + n) * ldt + k0 + 8 * c) = o; }
    LDS_WAIT();
}

__device__ __forceinline__ void hyena_filter_pos(const PV& P, int pos, int lane) {
    const float* fw_in = P.in(18);
    const float* fw_mid = P.in(19);
    const float* fb = P.in(20);
    const float* ffreq = P.in(21);
    const float* fw_out = P.in(22);
    int L, n, RL; bf16_t* kf;
    if (pos < SEQ) { L = SEQ; n = pos; RL = 4096; kf = (bf16_t*)(P.ws() + OFF_KLAT); } else { L = CTXL; n = pos - SEQ; RL = 512; kf = (bf16_t*)(P.ws() + OFF_KCTX); }
    const float t = (float)n / (float)(L - 1);
    const float w = 6.283185307179586f * (float)n / (float)L;
    float zv = 0.f;
    if (lane == 0) zv = t;
    else if (lane < 17) { const float f = 1e-4f + (float)(lane - 1) * ((15.0f - 1e-4f) / 15.0f); zv = cosf(f * w); }
    else if (lane < 33) { const float f = 1e-4f + (float)(lane - 17) * ((15.0f - 1e-4f) / 15.0f); zv = -sinf(f * w); }
    const float fr = ffreq[lane];
    float a = fb[lane];
    for (int k = 0; k < 33; ++k) a += __shfl(zv, k) * fw_in[k * 64 + lane];
    float h = sinf(fr * a);
    a = fb[64 + lane];
    for (int k = 0; k < 64; ++k) a += __shfl(h, k) * fw_mid[k * 64 + lane];
    h = sinf(fr * a);
    a = fb[128 + lane];
    for (int k = 0; k < 64; ++k) a += __shfl(h, k) * fw_mid[4096 + k * 64 + lane];
    h = sinf(fr * a);
    f32x4 o[8];
#pragma unroll
    for (int i = 0; i < 8; ++i) o[i] = (f32x4){0.f, 0.f, 0.f, 0.f};
    for (int k = 0; k < 64; ++k) {
        const float hk = __shfl(h, k);
        const f32x4* wr = (const f32x4*)(fw_out + (size_t)k * 2048) + lane;
#pragma unroll
        for (int i = 0; i < 8; ++i) o[i] += hk * wr[64 * i];
    }
    const float dmin = -15.350567286626973f, dmax = -3.0701134573253945f;
#pragma unroll
    for (int i = 0; i < 8; ++i) {
        const int c = lane * 4 + 256 * i; const int dir = c >> 10, d0 = c & 1023;
        f32x4 r;
#pragma unroll
        for (int j = 0; j < 4; ++j) { const float dl = fabsf(dmin + (float)(d0 + j) * ((dmax - dmin) / 1023.0f)); r[j] = o[i][j] * (expf(-t * dl) + 0.05f); }
        const int idx = dir == 0 ? (L - 1 - n) : (L - 1 + n);
        if (dir == 0 || n >= 1) {
#pragma unroll
            for (int j = 0; j < 4; ++j) { float v = r[j]; if (dir == 0 && n == 0) v += P.in(23)[d0 + j];
                kf[(size_t)(d0 + j) * RL + idx] = (bf16_t)(cvt_pk_bf16(v, 0.f) & 0xffffu); }
        }
    }
}

__device__ __forceinline__ void phase_prologue(const PV& P, LAS unsigned char* lds) {
    const int tid = P.tid, lane = tid & 63, wave = __builtin_amdgcn_readfirstlane(tid >> 6), G = P.gsz;
    unsigned char* ws = P.ws();
    {
        LAS float* sv = (LAS float*)lds;
        LAS float* red = (LAS float*)(lds + 9 * 1024 * 4);
        const float* cin = P.in(1); const float* cctx = P.in(3);
        for (int i = tid; i < 9 * 1024; i += 512) { const float v = (i < 8192) ? cin[i] : cctx[i - 8192]; sv[i] = v / (1.0f + expf(-v)); }
        __syncthreads();
        const float* ada_w = P.in(4); const float* ada_b = P.in(5);
        float* mod = (float*)(ws + OFF_MOD);
        for (int uidx = P.bid; uidx < 288; uidx += G) {
            const int l = uidx / 72, cb = uidx % 72, cn = tid & 127, kq = tid >> 7;
            const float* wp = ada_w + (size_t)l * 1024 * NMODC + (size_t)(256 * kq) * NMODC + 128 * cb + cn;
            float acc[9];
#pragma unroll
            for (int r = 0; r < 9; ++r) acc[r] = 0.f;
#pragma unroll 4
            for (int k = 0; k < 256; ++k) {
                const float wv = wp[(size_t)k * NMODC];
#pragma unroll
                for (int r = 0; r < 9; ++r) acc[r] += sv[r * 1024 + 256 * kq + k] * wv;
            }
#pragma unroll
            for (int r = 0; r < 9; ++r) red[(kq * 9 + r) * 128 + cn] = acc[r];
            __syncthreads();
            for (int o = tid; o < 9 * 128; o += 512) { const int r = o >> 7, c2 = o & 127;
                const float s = red[(0 * 9 + r) * 128 + c2] + red[(1 * 9 + r) * 128 + c2] + red[(2 * 9 + r) * 128 + c2] + red[(3 * 9 + r) * 128 + c2];
                mod[((size_t)l * 9 + r) * NMODC + 128 * cb + c2] = s + ada_b[(size_t)l * NMODC + 128 * cb + c2]; }
            __syncthreads();
        }
    }
    if (P.bid == 0) { unsigned* bw = (unsigned*)(ws + OFF_BAR); for (int i = tid; i < XCD_BAR_WORDS; i += 512) bw[i] = 0u; }
    if (P.bid == G - 1) {
        float* tab = (float*)(ws + OFF_ROPE);
        for (int i = tid; i < 1024; i += 512) { const int pos = i >> 4, f = i & 15; const float inv = powf(10000.0f, -(float)f / 16.0f); const float ang = (float)pos * inv; tab[i] = cosf(ang); tab[1024 + i] = sinf(ang); }
    }
    __syncthreads();
    LAS float* scr = (LAS float*)(lds + wave * 16384);
    const int gw = P.bid * 8 + wave, NGW = G * 8;
    constexpr int I_13 = 8 * 16 * 176, I_2 = 8 * 44 * 32, I_QKV = 2 * 16 * 96, I_O = 2 * 16 * 32, I_HI = 16 * 96, I_HO = 16 * 32, I_SI = 16 * 162, I_SO = 32 * 32, I_PAD = 192, I_F = SEQ + CTXL;
    constexpr int NIT = I_13 + I_2 + I_QKV + I_O + I_HI + I_HO + I_SI + I_SO + I_PAD + I_F;
    for (int it = gw; it < NIT; it += NGW) {
        int r = it;
        if (r < I_13) { const int q = r / 2816, rr = r % 2816, kb = rr / 176, nb = rr % 176, n0 = 32 * nb; const int half = n0 >= FF ? 1 : 0, jn = n0 - half * FF;
            transpose_tile(P.in(8) + (size_t)q * 1024 * 5632, 5632, (bf16_t*)(ws + OFF_W13T) + (size_t)q * 5632 * 1024, 1024, 64 * kb, n0, 256 * (jn >> 7) + 128 * half + (jn & 127), scr, lane); continue; } r -= I_13;
        if (r < I_2) { const int q = r / 1408, rr = r % 1408, kb = rr / 32, nb = rr % 32;
            transpose_tile(P.in(9) + (size_t)q * FF * 1024, 1024, (bf16_t*)(ws + OFF_W2T) + (size_t)q * 1024 * FF, FF, 64 * kb, 32 * nb, 32 * nb, scr, lane); continue; } r -= I_2;
        if (r < I_QKV) { const int q = r / 1536, rr = r % 1536, kb = rr / 96, nb = rr % 96, n0 = 32 * nb;
            if (n0 < 2048) transpose_tile(P.in(10) + (size_t)q * 1024 * 3072, 3072, (bf16_t*)(ws + OFF_WQKT) + (size_t)q * 2048 * 1024, 1024, 64 * kb, n0, n0, scr, lane);
            else transpose_tile(P.in(10) + (size_t)q * 1024 * 3072, 3072, (bf16_t*)(ws + OFF_WVT) + (size_t)q * 1024 * 1024, 1024, 64 * kb, n0, n0 - 2048, scr, lane);
            continue; } r -= I_QKV;
        if (r < I_O) { const int q = r / 512, rr = r % 512, kb = rr / 32, nb = rr % 32;
            transpose_tile(P.in(11) + (size_t)q * 1024 * 1024, 1024, (bf16_t*)(ws + OFF_WOT) + (size_t)q * 1024 * 1024, 1024, 64 * kb, 32 * nb, 32 * nb, scr, lane); continue; } r -= I_O;
        if (r < I_HI) { const int kb = r / 96, nb = r % 96;
            transpose_tile(P.in(14), 3072, (bf16_t*)(ws + OFF_WHIT), 1024, 64 * kb, 32 * nb, 32 * nb, scr, lane); continue; } r -= I_HI;
        if (r < I_HO) { const int kb = r / 32, nb = r % 32;
            transpose_tile(P.in(24), 1024, (bf16_t*)(ws + OFF_WHOT), 1024, 64 * kb, 32 * nb, 32 * nb, scr, lane); continue; } r -= I_HO;
        if (r < I_SI) { const int kb = r / 162, nb = r % 162;
            transpose_tile(P.in(26), SSM_IN, (bf16_t*)(ws + OFF_WSIT), 1024, 64 * kb, 32 * nb, 32 * nb, scr, lane); continue; } r -= I_SI;
        if (r < I_SO) { const int kb = r / 32, nb = r % 32;
            transpose_tile(P.in(33), 1024, (bf16_t*)(ws + OFF_WSOT), 2048, 64 * kb, 32 * nb, 32 * nb, scr, lane); continue; } r -= I_SO;
        if (r < I_PAD) { u32x4* p = (u32x4*)((bf16_t*)(ws + OFF_WSIT) + (size_t)(SSM_IN + r) * 1024); unsigned zz = 0u; asm volatile("" : "+v"(zz)); const u32x4 z = (u32x4){zz, zz, zz, zz}; p[lane] = z; p[64 + lane] = z; continue; } r -= I_PAD;
        hyena_filter_pos(P, r, lane);
    }
}

__device__ __forceinline__ void ln_rows(f32x4 (&v)[4], const float* g, const float* b, int lane) {
    float s = 0.f;
#pragma unroll
    for (int j = 0; j < 4; ++j) s += (v[j][0] + v[j][1]) + (v[j][2] + v[j][3]);
    const float mean = wave_sum(s) * (1.f / D); float s2 = 0.f;
#pragma unroll
    for (int j = 0; j < 4; ++j) { v[j] = v[j] - mean; s2 += (v[j][0] * v[j][0] + v[j][1] * v[j][1]) + (v[j][2] * v[j][2] + v[j][3] * v[j][3]); }
    const float rstd = 1.0f / sqrtf(wave_sum(s2) * (1.f / D) + LN_EPS);
#pragma unroll
    for (int j = 0; j < 4; ++j) { const f32x4 gg = *((const f32x4*)g + lane + 64 * j), bb = *((const f32x4*)b + lane + 64 * j); v[j] = v[j] * rstd * gg + bb; }
}
__device__ __forceinline__ void write_hb(const f32x4 (&v)[4], const float* shift, const float* scale, bf16_t* hrow, int lane) {
#pragma unroll
    for (int j = 0; j < 4; ++j) { const f32x4 sh = *((const f32x4*)shift + lane + 64 * j), sc = *((const f32x4*)scale + lane + 64 * j);
        const f32x4 o = v[j] * (sc + 1.0f) + sh; u32x2 w; w.x = cvt_pk_bf16(o[0], o[1]); w.y = cvt_pk_bf16(o[2], o[3]);
        *((u32x2*)hrow + lane + 64 * j) = w; }
}
__device__ __forceinline__ int mod_row(int r) { return r < TL ? (r >> 11) : 8; }

__device__ __forceinline__ void phase_init(const PV& P) {
    const int lane = P.tid & 63, wave = P.tid >> 6, gw = P.bid * 8 + wave, NGW = P.gsz * 8;
    float* lat = (float*)(P.ws() + OFF_LAT); bf16_t* hb = (bf16_t*)(P.ws() + OFF_HB); const float* mod = (const float*)(P.ws() + OFF_MOD);
    f32x4 nv[4];
    if (gw < TA) { const float* s0 = gw < TL ? P.in(0) + (size_t)gw * D : P.in(2) + (size_t)(gw - TL) * D;
#pragma unroll
        for (int j = 0; j < 4; ++j) nv[j] = *((const f32x4*)s0 + lane + 64 * j); }
    for (int r = gw; r < TA; r += NGW) {
        f32x4 v[4];
#pragma unroll
        for (int j = 0; j < 4; ++j) v[j] = nv[j];
        if (r + NGW < TA) { const int r2 = r + NGW; const float* s2 = r2 < TL ? P.in(0) + (size_t)r2 * D : P.in(2) + (size_t)(r2 - TL) * D;
#pragma unroll
            for (int j = 0; j < 4; ++j) nv[j] = *((const f32x4*)s2 + lane + 64 * j); }
#pragma unroll
        for (int j = 0; j < 4; ++j) *((f32x4*)(lat + (size_t)r * D) + lane + 64 * j) = v[j];
        const float* m = mod + (size_t)mod_row(r) * NMODC;
        write_hb(v, m, m + 1024, hb + (size_t)r * D, lane);
    }
}
__device__ __forceinline__ void phase_ln(const PV& P, int M, const float* g, const float* b, const float* nmod  , int qshift, float* outp,
                                         const float* slabs, const float* gate8  , float wres) {
    const int lane = P.tid & 63, wave = P.tid >> 6, gw = P.bid * 8 + wave, NGW = P.gsz * 8;
    float* lat = (float*)(P.ws() + OFF_LAT); bf16_t* hb = (bf16_t*)(P.ws() + OFF_HB);
    f32x4 gg[4], bb[4];
#pragma unroll
    for (int j = 0; j < 4; ++j) { gg[j] = *((const f32x4*)g + lane + 64 * j); bb[j] = *((const f32x4*)b + lane + 64 * j); }
    f32x4 nv[4];
    if (gw < M) {
#pragma unroll
        for (int j = 0; j < 4; ++j) nv[j] = *((const f32x4*)(lat + (size_t)gw * D) + lane + 64 * j);
    }
    for (int r = gw; r < M; r += NGW) {
        float* row = lat + (size_t)r * D;
        f32x4 v[4];
#pragma unroll
        for (int j = 0; j < 4; ++j) v[j] = nv[j];
        if (r + NGW < M) {
#pragma unroll
            for (int j = 0; j < 4; ++j) nv[j] = *((const f32x4*)(lat + (size_t)(r + NGW) * D) + lane + 64 * j);
        }
        if (slabs && r >= TL) {
#pragma unroll
            for (int j = 0; j < 4; ++j) {
                f32x4 s = (f32x4){0.f, 0.f, 0.f, 0.f};
#pragma unroll
                for (int k = 0; k < 8; ++k) s += *((const f32x4*)(slabs + ((size_t)k * TC + (r - TL)) * D) + lane + 64 * j);
                const f32x4 gt = *((const f32x4*)gate8 + lane + 64 * j);
                v[j] = v[j] * DN_ALPHA + (gt + 1.0f) * wres * s;
            }
        }
        f32x4 shv[4], scv[4];
        if (!outp) { const float* m = nmod + (size_t)mod_row(r) * NMODC + qshift * 1024;
#pragma unroll
            for (int j = 0; j < 4; ++j) { shv[j] = *((const f32x4*)m + lane + 64 * j); scv[j] = *((const f32x4*)(m + 1024) + lane + 64 * j); } }
        {
            float s = 0.f;
#pragma unroll
            for (int j = 0; j < 4; ++j) s += (v[j][0] + v[j][1]) + (v[j][2] + v[j][3]);
            const float mean = wave_sum(s) * (1.f / D); float s2 = 0.f;
#pragma unroll
            for (int j = 0; j < 4; ++j) { v[j] = v[j] - mean; s2 += (v[j][0] * v[j][0] + v[j][1] * v[j][1]) + (v[j][2] * v[j][2] + v[j][3] * v[j][3]); }
            const float rstd = 1.0f / sqrtf(wave_sum(s2) * (1.f / D) + LN_EPS);
#pragma unroll
            for (int j = 0; j < 4; ++j) v[j] = v[j] * rstd * gg[j] + bb[j];
        }
        if (outp) {
#pragma unroll
            for (int j = 0; j < 4; ++j) *((f32x4*)(outp + (size_t)r * D) + lane + 64 * j) = v[j];
        } else {
#pragma unroll
            for (int j = 0; j < 4; ++j) *((f32x4*)row + lane + 64 * j) = v[j];
#pragma unroll
            for (int j = 0; j < 4; ++j) { const f32x4 o = v[j] * (scv[j] + 1.0f) + shv[j]; u32x2 w; w.x = cvt_pk_bf16(o[0], o[1]); w.y = cvt_pk_bf16(o[2], o[3]);
                *((u32x2*)(hb + (size_t)r * D) + lane + 64 * j) = w; }
        }
    }
}

__device__ __forceinline__ void phase_attention(const PV& P, LAS unsigned char* lds, int j_attn, float lam_init, bool ctx_q) {
    const int tid = P.tid, lane = tid & 63, wave = __builtin_amdgcn_readfirstlane(tid >> 6), g = lane >> 4, q16 = lane & 15;
    const bf16_t* qk = (const bf16_t*)(P.ws() + OFF_QK); const bf16_t* vt = (const bf16_t*)(P.ws() + OFF_VT); bf16_t* ao = (bf16_t*)(P.ws() + OFF_AO);
    const float* lam = P.in(12) + j_attn * 256; const float* subg = P.in(13) + j_attn * 128;
    const float lam_full = expf(wave_sum(lam[lane] * lam[64 + lane])) - expf(wave_sum(lam[128 + lane] * lam[192 + lane])) + lam_init;
    constexpr int KROW = 272, VROW = 144;
    constexpr int ABUF = 64 * KROW + 128 * VROW;
    const float sc = 0.125f * 1.4426950408889634f;
    const int NU = 1024 + (ctx_q ? 128 : 0);
    for (int uidx = P.bid; uidx < NU; uidx += P.gsz) {
        int b, h, qrow0, ntiles;
        if (uidx < 1024) { b = uidx >> 7; h = (uidx >> 4) & 7; qrow0 = b * SEQ + (uidx & 15) * 128; ntiles = 36; }
        else { const int u2 = uidx - 1024; b = u2 >> 4; h = (u2 >> 1) & 7; qrow0 = TL + b * CTXL + (u2 & 1) * 128; ntiles = 4; }
        bf16x8 qf[2][2];
        { const bf16_t* qp = qk + (size_t)(qrow0 + wave * 16 + q16) * 2048 + h * 128 + 8 * g;
#pragma unroll
          for (int mp = 0; mp < 2; ++mp)
#pragma unroll
              for (int kk = 0; kk < 2; ++kk) { const u32x4 qw = *(const u32x4*)(qp + mp * 64 + kk * 32); u32x4 qs;
#pragma unroll
                  for (int e = 0; e < 4; ++e) qs[e] = cvt_pk_bf16_m(bflo(qw[e]) * sc, bfhi(qw[e]) * sc);
                  qf[mp][kk] = __builtin_bit_cast(bf16x8, qs); } }
        f32x4 accO[2][8];
#pragma unroll
        for (int mp = 0; mp < 2; ++mp)
#pragma unroll
            for (int nt = 0; nt < 8; ++nt) accO[mp][nt] = (f32x4){0.f, 0.f, 0.f, 0.f};
        float mrun[2] = {-INFINITY, -INFINITY}, lrun[2] = {0.f, 0.f};
        u32x4 stg[4];
        auto tile_tok = [&](int i) { return i < 4 ? TL + b * CTXL + 64 * i : b * SEQ + 64 * (i - 4); };
#define ATT_LOAD(i) do { const int tok = tile_tok(i); \
            _Pragma("unroll") for (int c2 = 0; c2 < 2; ++c2) { const int c = tid + 512 * c2; \
                stg[c2] = *(const u32x4*)(qk + (size_t)(tok + (c >> 4)) * 2048 + 1024 + h * 128 + (c & 15) * 8); \
                stg[2 + c2] = *(const u32x4*)(vt + (size_t)(h * 128 + (c >> 3)) * TA + tok + (c & 7) * 8); } } while (0)
#define ATT_STORE(bi) do { LAS unsigned char* Kw = lds + (bi) * ABUF; LAS unsigned char* Vw = Kw + 64 * KROW; \
            _Pragma("unroll") for (int c2 = 0; c2 < 2; ++c2) { const int c = tid + 512 * c2; \
                *(LAS u32x4*)(Kw + (c >> 4) * KROW + (c & 15) * 16) = stg[c2]; \
                *(LAS u32x4*)(Vw + (c >> 3) * VROW + (c & 7) * 16) = stg[2 + c2]; } } while (0)
        ATT_LOAD(0);
        ATT_STORE(0);
        __syncthreads();
        for (int it = 0; it < ntiles; ++it) {
            const LAS unsigned char* Kl = lds + (it & 1) * ABUF; const LAS unsigned char* Vl = Kl + 64 * KROW;
            if (it + 1 < ntiles) ATT_LOAD(it + 1);
            bf16x8 pf[2][2];
            const LAS unsigned char* kbase = Kl + (8 * (q16 >> 2) + (q16 & 3)) * KROW + 16 * g;
#define ATT_KF(mp, kt, kk) (*(const LAS bf16x8*)(kbase + (32 * ((kt) >> 1) + 4 * ((kt) & 1)) * KROW + (mp) * 128 + (kk) * 64))
            bf16x8 kf[2][8];
#pragma unroll
            for (int f = 0; f < 8; ++f) kf[0][f] = ATT_KF(0, f >> 1, f & 1);
#pragma unroll
            for (int mp = 0; mp < 2; ++mp) {
                f32x4 s[4];
                if (mp == 0) {
#pragma unroll
                    for (int f = 0; f < 8; ++f) kf[1][f] = ATT_KF(1, f >> 1, f & 1);
                    __builtin_amdgcn_sched_barrier(0);
                }
#pragma unroll
                for (int kk = 0; kk < 2; ++kk)
#pragma unroll
                    for (int kt = 0; kt < 4; ++kt) {
                        if (kk == 0) s[kt] = (f32x4){0.f, 0.f, 0.f, 0.f};
                        s[kt] = __builtin_amdgcn_mfma_f32_16x16x32_bf16(kf[mp][2 * kt + kk], qf[mp][kk], s[kt], 0, 0, 0);
                    }
                float mx = -INFINITY;
#pragma unroll
                for (int kt = 0; kt < 4; ++kt) mx = fmaxf(mx, fmaxf(fmaxf(s[kt][0], s[kt][1]), fmaxf(s[kt][2], s[kt][3])));
                mx = xmax32(xmax16(mx));
                const float mnew = fmaxf(mrun[mp], mx);
                const float alpha = __builtin_amdgcn_exp2f(mrun[mp] - mnew);
                mrun[mp] = mnew;
                float ps = 0.f;
#pragma unroll
                for (int kt = 0; kt < 4; ++kt) {
#pragma unroll
                    for (int j = 0; j < 4; ++j) { const float p = __builtin_amdgcn_exp2f(s[kt][j] - mnew); s[kt][j] = p; ps += p; }
                }
                lrun[mp] = lrun[mp] * alpha + ps;
                if (__any(alpha != 1.0f)) {
#pragma unroll
                    for (int nt = 0; nt < 8; ++nt) accO[mp][nt] = accO[mp][nt] * alpha;
                }
#pragma unroll
                for (int kb = 0; kb < 2; ++kb) {
                    u32x4 w;
                    w.x = cvt_pk_bf16_m(s[2 * kb][0], s[2 * kb][1]); w.y = cvt_pk_bf16_m(s[2 * kb][2], s[2 * kb][3]);
                    w.z = cvt_pk_bf16_m(s[2 * kb + 1][0], s[2 * kb + 1][1]); w.w = cvt_pk_bf16_m(s[2 * kb + 1][2], s[2 * kb + 1][3]);
                    pf[mp][kb] = __builtin_bit_cast(bf16x8, w);
                }
            }
            {
                const LAS unsigned char* vbase = Vl + q16 * VROW + 16 * g;
#define ATT_VF(f) (*(const LAS bf16x8*)(vbase + ((f) >> 1) * 16 * VROW + ((f) & 1) * 64))
                bf16x8 va[4], vn[4];
#pragma unroll
                for (int f = 0; f < 4; ++f) va[f] = ATT_VF(f);
#pragma unroll
                for (int grp = 0; grp < 4; ++grp) {
                    if (grp < 3) {
#pragma unroll
                        for (int f = 0; f < 4; ++f) vn[f] = ATT_VF(4 * (grp + 1) + f);
                    }
                    __builtin_amdgcn_sched_barrier(0);
#pragma unroll
                    for (int f = 0; f < 4; ++f) { const int nt = 2 * grp + (f >> 1), kb = f & 1;
                        accO[0][nt] = __builtin_amdgcn_mfma_f32_16x16x32_bf16(va[f], pf[0][kb], accO[0][nt], 0, 0, 0);
                        accO[1][nt] = __builtin_amdgcn_mfma_f32_16x16x32_bf16(va[f], pf[1][kb], accO[1][nt], 0, 0, 0); }
#pragma unroll
                    for (int f = 0; f < 4; ++f) va[f] = vn[f];
                }
#undef ATT_VF
            }
#undef ATT_KF
            if (it + 1 < ntiles) ATT_STORE((it + 1) & 1);
            __syncthreads();
        }
#undef ATT_LOAD
#undef ATT_STORE
        float l0 = lrun[0]; l0 += __shfl_xor(l0, 16); l0 += __shfl_xor(l0, 32);
        float l1 = lrun[1]; l1 += __shfl_xor(l1, 16); l1 += __shfl_xor(l1, 32);
        const float i0 = 1.0f / l0, i1 = lam_full / l1;
        float ss = 0.f;
#pragma unroll
        for (int nt = 0; nt < 8; ++nt) { accO[0][nt] = accO[0][nt] * i0 - accO[1][nt] * i1;
            ss += (accO[0][nt][0] * accO[0][nt][0] + accO[0][nt][1] * accO[0][nt][1]) + (accO[0][nt][2] * accO[0][nt][2] + accO[0][nt][3] * accO[0][nt][3]); }
        ss += __shfl_xor(ss, 16); ss += __shfl_xor(ss, 32);
        const float rs = (1.0f / sqrtf(ss * (1.0f / 128.0f) + LN_EPS)) * (1.0f - lam_init);
        bf16_t* op = ao + (size_t)(qrow0 + wave * 16 + q16) * D + h * 128 + 4 * g;
#pragma unroll
        for (int nt = 0; nt < 8; ++nt) { const f32x4 gg = *(const f32x4*)(subg + 16 * nt + 4 * g); const f32x4 o = accO[0][nt] * rs * gg;
            u32x2 w; w.x = cvt_pk_bf16(o[0], o[1]); w.y = cvt_pk_bf16(o[2], o[3]); *(u32x2*)(op + 16 * nt) = w; }
    }
}

__device__ __forceinline__ void phase_hy_short(const PV& P, LAS unsigned char* lds) {
    const bf16_t* hu = (const bf16_t*)(P.ws() + OFF_HU); float* x0o = (float*)(P.ws() + OFF_HX0); bf16_t* vT = (bf16_t*)(P.ws() + OFF_HVT);
    const float* cw = P.in(16); const float* cb = P.in(17);
    const int tid = P.tid;
    constexpr int RS = 264;
    const bool hoist = (P.gsz & 7) == 0;
    f32x4 hw0[3], hw1[3], hw2[3], hbb[3];
    { const int dq0 = 128 * (P.bid & 7) + 4 * (tid & 31);
#pragma unroll
      for (int part = 0; part < 3; ++part) { const int c = part * 1024 + dq0;
          hw0[part] = *(const f32x4*)(cw + c); hw1[part] = *(const f32x4*)(cw + 3072 + c); hw2[part] = *(const f32x4*)(cw + 6144 + c); hbb[part] = *(const f32x4*)(cb + c); } }
    for (int uidx = P.bid; uidx < 8 * 36 * 8; uidx += P.gsz) {
        const int db = uidx & 7, sb = (uidx >> 3) % 36, b = uidx / 288;
        const bool isl = sb < 32; const int L = isl ? SEQ : CTXL, t0 = isl ? 64 * sb : 64 * (sb - 32), rbase = isl ? b * SEQ : TL + b * CTXL, toff = isl ? 0 : SEQ;
#pragma unroll
        for (int k = 0; k < 4; ++k) {
            const int idx = tid + 512 * k, tl = idx >> 5, d4 = idx & 31, t = t0 + tl, r = rbase + t, dq = 128 * db + 4 * d4;
            const bool hp = t > 0, hn = t < L - 1;
            float res[3][4];
#pragma unroll
            for (int part = 0; part < 3; ++part) {
                const int c = part * 1024 + dq;
                const u32x2 z2 = (u32x2){0u, 0u};
                const u32x2 um = hp ? *(const u32x2*)(hu + (size_t)(r - 1) * 3072 + c) : z2;
                const u32x2 u0 = *(const u32x2*)(hu + (size_t)r * 3072 + c);
                const u32x2 up = hn ? *(const u32x2*)(hu + (size_t)(r + 1) * 3072 + c) : z2;
                f32x4 w0 = hw0[part], w1 = hw1[part], w2 = hw2[part], bb = hbb[part];
                if (!hoist) { w0 = *(const f32x4*)(cw + c); w1 = *(const f32x4*)(cw + 3072 + c); w2 = *(const f32x4*)(cw + 6144 + c); bb = *(const f32x4*)(cb + c); }
                res[part][0] = bb[0] + bflo(um.x) * w0[0] + bflo(u0.x) * w1[0] + bflo(up.x) * w2[0];
                res[part][1] = bb[1] + bfhi(um.x) * w0[1] + bfhi(u0.x) * w1[1] + bfhi(up.x) * w2[1];
                res[part][2] = bb[2] + bflo(um.y) * w0[2] + bflo(u0.y) * w1[2] + bflo(up.y) * w2[2];
                res[part][3] = bb[3] + bfhi(um.y) * w0[3] + bfhi(u0.y) * w1[3] + bfhi(up.y) * w2[3];
            }
            *(f32x4*)(x0o + (size_t)r * D + dq) = (f32x4){res[0][0], res[0][1], res[0][2], res[0][3]};
            u32x2 w; w.x = cvt_pk_bf16(res[2][0] * res[1][0], res[2][1] * res[1][1]); w.y = cvt_pk_bf16(res[2][2] * res[1][2], res[2][3] * res[1][3]);
            *(LAS u32x2*)(lds + tl * RS + d4 * 8) = w;
        }
        __syncthreads();
#pragma unroll
        for (int k = 0; k < 2; ++k) {
            const int idx = tid + 512 * k, tk = idx & 7, dl = idx >> 3;
            unsigned e[8];
#pragma unroll
            for (int j = 0; j < 8; ++j) e[j] = *(const LAS bf16_t*)(lds + (8 * tk + j) * RS + dl * 2);
            u32x4 w; w.x = e[0] | (e[1] << 16); w.y = e[2] | (e[3] << 16); w.z = e[4] | (e[5] << 16); w.w = e[6] | (e[7] << 16);
            *(u32x4*)(vT + ((size_t)(128 * db + dl) * NB + b) * HLT + toff + t0 + 8 * tk) = w;
        }
        __syncthreads();
    }
}

__device__ __forceinline__ void phase_hy_conv(const PV& P, LAS unsigned char* lds) {
    const bf16_t* vT = (const bf16_t*)(P.ws() + OFF_HVT); bf16_t* yT = (bf16_t*)(P.ws() + OFF_HYT);
    const int tid = P.tid, lane = tid & 63, wave = __builtin_amdgcn_readfirstlane(tid >> 6), g = lane >> 4, q16 = lane & 15;
    constexpr int R0_OFF = 0, R1_OFF = 8208, VT_OFF = 16416, VRS = 4112;
    u32x4 pr0 = (u32x4){0u, 0u, 0u, 0u}, pvt[4];
#pragma unroll
    for (int k = 0; k < 4; ++k) pvt[k] = (u32x4){0u, 0u, 0u, 0u};
#define HC_PREFETCH(uu) do { const bool isl_ = (uu) < 1024; const int d_ = (uu) & 1023; const int L_ = isl_ ? SEQ : CTXL, RL_ = isl_ ? 4096 : 512, toff_ = isl_ ? 0 : SEQ; \
        const bf16_t* rs_ = isl_ ? (const bf16_t*)(P.ws() + OFF_KLAT) + (size_t)d_ * 4096 : (const bf16_t*)(P.ws() + OFF_KCTX) + (size_t)d_ * 512; \
        if (tid < RL_ / 8) pr0 = *(const u32x4*)(rs_ + 8 * tid); \
        _Pragma("unroll") for (int k = 0; k < 4; ++k) { const int i_ = tid + 512 * k; if (i_ < L_) { const int bb_ = i_ / (L_ / 8), c_ = i_ % (L_ / 8); \
            pvt[k] = *(const u32x4*)(vT + ((size_t)d_ * NB + bb_) * HLT + toff_ + 8 * c_); } } } while (0)
    if (P.bid < 2048) HC_PREFETCH(P.bid);
    for (int uidx = P.bid; uidx < 2048; uidx += P.gsz) {
        const bool isl = uidx < 1024; const int d = uidx & 1023;
        const int L = isl ? SEQ : CTXL, RL = isl ? 4096 : 512, toff = isl ? 0 : SEQ;
        if (tid < RL / 8) *(LAS u32x4*)(lds + R0_OFF + tid * 16) = pr0;
#pragma unroll
        for (int k = 0; k < 4; ++k) { const int i = tid + 512 * k; if (i < L) { const int bb = i / (L / 8), c = i % (L / 8);
            *(LAS u32x4*)(lds + VT_OFF + bb * VRS + c * 16) = pvt[k]; } }
        __syncthreads();
        if (uidx + P.gsz < 2048) HC_PREFETCH(uidx + P.gsz);
        for (int k = tid; k < RL / 2; k += 512) {
            const unsigned hi = *(const LAS unsigned*)(lds + R0_OFF + 4 * k), lo = k > 0 ? *(const LAS unsigned*)(lds + R0_OFF + 4 * k - 4) : 0u;
            *(LAS unsigned*)(lds + R1_OFF + 4 * k) = __builtin_amdgcn_alignbit(hi, lo, 16);
        }
        __syncthreads();
        const int ntile = L / 16, nsb = L / 32, C = L - 1;
        const int tau0 = (wave & 1) + 32 * (wave >> 1);
        if (tau0 < ntile) {
            const int base0 = C - 16 * tau0 - q16 + 8 * g;
            const int sel = (q16 & 1) ? R0_OFF : (R1_OFF + 2);
#define HC_FRAG(dst, f) do { int eb = base0 - 32 * (f); eb = eb < 0 ? (eb & 1) : eb; const LAS unsigned* p_ = (const LAS unsigned*)(lds + sel + eb * 2); \
            u32x4 w_; w_.x = p_[0]; w_.y = p_[1]; w_.z = p_[2]; w_.w = p_[3]; dst = __builtin_bit_cast(bf16x8, w_); } while (0)
            f32x4 acc[16]; bf16x8 fr[16];
#pragma unroll
            for (int i = 0; i < 16; ++i) acc[i] = (f32x4){0.f, 0.f, 0.f, 0.f};
#pragma unroll
            for (int i = 1; i < 16; ++i) HC_FRAG(fr[i], i);
            const LAS unsigned char* vrow = lds + VT_OFF + (q16 & 7) * VRS + 16 * g;
            for (int sb0 = 0; sb0 < nsb; sb0 += 16) {
#pragma unroll
                for (int u = 0; u < 16; ++u) {
                    const int sbk = sb0 + u;
                    if (sbk < nsb) {
                        HC_FRAG(fr[(16 - u) & 15], -sbk);
                        const bf16x8 bv = *(const LAS bf16x8*)(vrow + sbk * 64);
#pragma unroll
                        for (int i = 0; i < 16; ++i) acc[i] = __builtin_amdgcn_mfma_f32_16x16x32_bf16(fr[(i - u) & 15], bv, acc[i], 0, 0, 0);
                    }
                }
            }
#undef HC_FRAG
            if (q16 < 8) {
                bf16_t* yp = yT + ((size_t)d * NB + q16) * HLT + toff + 4 * g;
#pragma unroll
                for (int i = 0; i < 16; ++i) { const int tau = tau0 + 2 * i;
                    if (tau < ntile) { u32x2 w; w.x = cvt_pk_bf16(acc[i][0], acc[i][1]); w.y = cvt_pk_bf16(acc[i][2], acc[i][3]); *(u32x2*)(yp + 16 * tau) = w; } }
            }
        }
        __syncthreads();
    }
#undef HC_PREFETCH
}

__device__ __forceinline__ void phase_hy_gate(const PV& P, LAS unsigned char* lds) {
    const bf16_t* yT = (const bf16_t*)(P.ws() + OFF_HYT); const float* x0 = (const float*)(P.ws() + OFF_HX0); bf16_t* gout = (bf16_t*)(P.ws() + OFF_HG);
    const int tid = P.tid;
    constexpr int RS = 264;
    for (int uidx = P.bid; uidx < 8 * 36 * 8; uidx += P.gsz) {
        const int db = uidx & 7, sb = (uidx >> 3) % 36, b = uidx / 288;
        const bool isl = sb < 32; const int t0 = isl ? 64 * sb : 64 * (sb - 32), rbase = isl ? b * SEQ : TL + b * CTXL, toff = isl ? 0 : SEQ;
        f32x4 xq[4];
#pragma unroll
        for (int k = 0; k < 4; ++k) { const int idx = tid + 512 * k, tl = idx >> 5, d4 = idx & 31; xq[k] = *(const f32x4*)(x0 + (size_t)(rbase + t0 + tl) * D + 128 * db + 4 * d4); }
#pragma unroll
        for (int k = 0; k < 2; ++k) {
            const int idx = tid + 512 * k, tk = idx & 7, dl = idx >> 3;
            const u32x4 w = *(const u32x4*)(yT + ((size_t)(128 * db + dl) * NB + b) * HLT + toff + t0 + 8 * tk);
#pragma unroll
            for (int j = 0; j < 4; ++j) { *(LAS bf16_t*)(lds + (8 * tk + 2 * j) * RS + dl * 2) = (bf16_t)(w[j] & 0xffffu); *(LAS bf16_t*)(lds + (8 * tk + 2 * j + 1) * RS + dl * 2) = (bf16_t)(w[j] >> 16); }
        }
        __syncthreads();
#pragma unroll
        for (int k = 0; k < 4; ++k) {
            const int idx = tid + 512 * k, tl = idx >> 5, d4 = idx & 31, r = rbase + t0 + tl, dq = 128 * db + 4 * d4;
            const u32x2 yv = *(const LAS u32x2*)(lds + tl * RS + d4 * 8);
            const f32x4 xv = xq[k];
            u32x2 w; w.x = cvt_pk_bf16(bflo(yv.x) * xv[0], bfhi(yv.x) * xv[1]); w.y = cvt_pk_bf16(bflo(yv.y) * xv[2], bfhi(yv.y) * xv[3]);
            *(u32x2*)(gout + (size_t)r * D + dq) = w;
        }
        __syncthreads();
    }
}

__device__ __forceinline__ float softplus_f(float x) { return x > 20.f ? x : log1pf(expf(x)); }
__device__ __forceinline__ void phase_ssm_scan(const PV& P, LAS unsigned char* lds) {
    const bf16_t* zx = (const bf16_t*)(P.ws() + OFF_ZX); float* Y = (float*)(P.ws() + OFF_Y); const bf16_t* bcact = (const bf16_t*)(P.ws() + OFF_HB);
    const float* cw = P.in(27); const float* cb = P.in(28); const float* dtb = P.in(29); const float* alog = P.in(30); const float* dsk = P.in(31);
    const int tid = P.tid, lane = tid & 63, wave = __builtin_amdgcn_readfirstlane(tid >> 6), g = lane >> 4, q16 = lane & 15;
    constexpr int RS = 272;
    LAS unsigned char* BS = lds;
    LAS unsigned char* CS = lds + 128 * RS;
    LAS unsigned char* BT = lds + 256 * RS;
    LAS unsigned char* XT = lds + 384 * RS;
    LAS unsigned char* ST = lds + 448 * RS;
    LAS float* csf = (LAS float*)(lds + 512 * RS);
    LAS float* dtf = csf + 128;
    LAS float* WX = (LAS float*)(lds + 512 * RS + 1024);
    for (int uidx = P.bid; uidx < 256; uidx += P.gsz) {
        const int b = uidx >> 5, h = uidx & 31, grp = h >> 3;
        const float Dh = dsk[h];
        __syncthreads();
        if (tid < 256) { const int tap = tid >> 6, cx = tid & 63; WX[tid] = tap < 3 ? cw[tap * 3072 + h * 64 + cx] : cb[h * 64 + cx]; }
        __syncthreads();
        for (int dir = 0; dir < 2; ++dir) {
            const float av = -expf(alog[dir * 32 + h]), dtbias = dtb[dir * 32 + h];
            f32x4 st[4];
#pragma unroll
            for (int i = 0; i < 4; ++i) st[i] = (f32x4){0.f, 0.f, 0.f, 0.f};
            u32x4 rawX[2][3], rawC[8]; float dtr0 = 0.f, dtr1 = 0.f;
#define SC_GEO(cx, ccx, Lx, basex) const int ccx = (cx) < 2 ? (cx) : (cx) - 2, Lx = (cx) < 2 ? CTXL : SEQ, basex = (cx) < 2 ? TL + b * CTXL : b * SEQ
#define SC_ROWX(l, ccx, Lx) (dir == 0 ? 128 * (ccx) + (l) : (Lx) - 1 - 128 * (ccx) - (l))
#define SC_FETCH(ccx, Lx, basex) do { \
            _Pragma("unroll") for (int k = 0; k < 2; ++k) { const int it = tid + 512 * k; const int l = it & 127, gi = __builtin_amdgcn_readfirstlane(it >> 7); \
                const int t = SC_ROWX(l, ccx, Lx); const u32x4 z4 = (u32x4){0u, 0u, 0u, 0u}; \
                const bf16_t* bp = zx + (size_t)((basex) + t) * SSM_IN + 2048 + h * 64 + 8 * gi; \
                rawX[k][0] = t > 0 ? *(const u32x4*)(bp - SSM_IN) : z4; rawX[k][1] = *(const u32x4*)bp; rawX[k][2] = t < (Lx) - 1 ? *(const u32x4*)(bp + SSM_IN) : z4; } \
            _Pragma("unroll") for (int k = 2; k < 10; ++k) { const int it = tid + 512 * k; const int l = it & 127, gi = __builtin_amdgcn_readfirstlane(it >> 7); \
                const int t = SC_ROWX(l, ccx, Lx); \
                const int bcol = gi < 24 ? grp * 128 + 8 * (gi - 8) : 512 + grp * 128 + 8 * (gi - 24); \
                rawC[k - 2] = *(const u32x4*)(bcact + (size_t)((basex) + t) * 1024 + bcol); } } while (0)
#define SC_FETCH_DT(ccx, Lx, basex) do { if (wave < 2) { \
                dtr0 = bf2f(zx[(size_t)((basex) + SC_ROWX(64 * wave + lane, ccx, Lx)) * SSM_IN + 5120 + dir * 32 + h]); \
                if (wave == 1) dtr1 = bf2f(zx[(size_t)((basex) + SC_ROWX(lane, ccx, Lx)) * SSM_IN + 5120 + dir * 32 + h]); } } while (0)
#define SC_STAGE() do { \
            _Pragma("unroll") for (int k = 0; k < 2; ++k) { const int it = tid + 512 * k; const int l = it & 127, gi = __builtin_amdgcn_readfirstlane(it >> 7); \
                float o[8]; \
                _Pragma("unroll") for (int e2 = 0; e2 < 4; ++e2) { \
                    const unsigned wm = rawX[k][0][e2], w0 = rawX[k][1][e2], wp = rawX[k][2][e2]; \
                    const f32x2 c0 = *(const LAS f32x2*)(WX + 8 * gi + 2 * e2), c1 = *(const LAS f32x2*)(WX + 64 + 8 * gi + 2 * e2), c2 = *(const LAS f32x2*)(WX + 128 + 8 * gi + 2 * e2), cbv = *(const LAS f32x2*)(WX + 192 + 8 * gi + 2 * e2); \
                    o[2 * e2] = silu_f(cbv[0] + bflo(wm) * c0[0] + bflo(w0) * c1[0] + bflo(wp) * c2[0]); \
                    o[2 * e2 + 1] = silu_f(cbv[1] + bfhi(wm) * c0[1] + bfhi(w0) * c1[1] + bfhi(wp) * c2[1]); } \
                const float dtl = dtf[l]; \
                _Pragma("unroll") for (int e = 0; e < 8; ++e) *(LAS bf16_t*)(XT + (8 * gi + e) * RS + l * 2) = (bf16_t)(cvt_pk_bf16(o[e] * dtl, 0.f) & 0xffffu); \
                if (dir == 0) { float* yq = Y + (size_t)(base + SC_ROW(l)) * 2048 + h * 64 + 8 * gi; \
                    *(f32x4*)yq = (f32x4){o[0] * Dh, o[1] * Dh, o[2] * Dh, o[3] * Dh}; *(f32x4*)(yq + 4) = (f32x4){o[4] * Dh, o[5] * Dh, o[6] * Dh, o[7] * Dh}; } } \
            _Pragma("unroll") for (int k = 2; k < 10; ++k) { const int it = tid + 512 * k; const int l = it & 127, gi = __builtin_amdgcn_readfirstlane(it >> 7); \
                const u32x4 w = rawC[k - 2]; \
                if (gi < 24) { \
                    const int n0 = 8 * (gi - 8); \
                    *(LAS u32x4*)(BS + l * RS + n0 * 2) = w; \
                    const float dec = __expf(cs127 - csf[l]); \
                    _Pragma("unroll") for (int e2 = 0; e2 < 4; ++e2) { \
                        *(LAS bf16_t*)(BT + (n0 + 2 * e2) * RS + l * 2) = (bf16_t)(cvt_pk_bf16(bflo(w[e2]) * dec, 0.f) & 0xffffu); \
                        *(LAS bf16_t*)(BT + (n0 + 2 * e2 + 1) * RS + l * 2) = (bf16_t)(cvt_pk_bf16(bfhi(w[e2]) * dec, 0.f) & 0xffffu); } \
                } else { \
                    *(LAS u32x4*)(CS + l * RS + 8 * (gi - 24) * 2) = w; \
                } } } while (0)
            { SC_GEO(0, cc0, L0, base0); SC_FETCH(cc0, L0, base0); SC_FETCH_DT(cc0, L0, base0); }
#pragma unroll 1
            for (int c = 0; c < 18; ++c) {
                SC_GEO(c, cc, L, base);
#define SC_ROW(l) SC_ROWX(l, cc, L)
                if (wave < 2) {
                    const int l = 64 * wave + lane;
                    const float dtv = softplus_f(dtr0 + dtbias);
                    float x = av * dtv;
#pragma unroll
                    for (int o = 1; o < 64; o <<= 1) { const float y = __shfl_up(x, o); if (lane >= o) x += y; }
                    if (wave == 1) { const float d0 = softplus_f(dtr1 + dtbias); x += wave_sum(av * d0); }
                    csf[l] = x; dtf[l] = dtv;
                }
                __syncthreads();
                const float cs127 = csf[127];
                SC_STAGE();
                asm volatile("s_waitcnt vmcnt(0)" ::: "memory");
                __syncthreads();
                if (c + 1 < 18) { SC_GEO(c + 1, ccn, Ln, basen); SC_FETCH(ccn, Ln, basen); SC_FETCH_DT(ccn, Ln, basen); }
                {
                    const int l = 16 * wave + q16;
                    const float csl = csf[l];
                    float* yp = Y + (size_t)(base + SC_ROW(l)) * 2048 + h * 64 + 4 * g;
                    f32x4 yold[4];
#pragma unroll
                    for (int pt = 0; pt < 4; ++pt) yold[pt] = (f32x4){0.f, 0.f, 0.f, 0.f};
                    if (dir == 1) {
#pragma unroll
                        for (int pt = 0; pt < 4; ++pt) yold[pt] = *(const f32x4*)(yp + 16 * pt);
                    }
                    bf16x8 cfrag[4];
#pragma unroll
                    for (int kk = 0; kk < 4; ++kk) cfrag[kk] = *(const LAS bf16x8*)(CS + l * RS + (8 * g + 32 * kk) * 2);
                    f32x4 acc[4];
#pragma unroll
                    for (int pt = 0; pt < 4; ++pt) acc[pt] = (f32x4){0.f, 0.f, 0.f, 0.f};
                    if (c > 0) {
                        const LAS unsigned char* sbase = ST + q16 * RS + 16 * g;
                        bf16x8 sa[4], sn[4];
#pragma unroll
                        for (int kk = 0; kk < 4; ++kk) sa[kk] = *(const LAS bf16x8*)(sbase + 64 * kk);
#pragma unroll
                        for (int pt = 0; pt < 4; ++pt) {
                            if (pt < 3) {
#pragma unroll
                                for (int kk = 0; kk < 4; ++kk) sn[kk] = *(const LAS bf16x8*)(sbase + (16 * (pt + 1)) * RS + 64 * kk);
                            }
                            __builtin_amdgcn_sched_barrier(0);
#pragma unroll
                            for (int kk = 0; kk < 4; ++kk) acc[pt] = __builtin_amdgcn_mfma_f32_16x16x32_bf16(sa[kk], cfrag[kk], acc[pt], 0, 0, 0);
#pragma unroll
                            for (int kk = 0; kk < 4; ++kk) sa[kk] = sn[kk];
                        }
                        const float el = __expf(csl);
#pragma unroll
                        for (int pt = 0; pt < 4; ++pt) acc[pt] = acc[pt] * el;
                    }
                    const int nblk = (wave >> 1) + 1;
                    for (int sb = 0; sb < nblk; ++sb) {
                        f32x4 gt[2];
                        bf16x8 bfr8[8], xfr[4];
#pragma unroll
                        for (int f = 0; f < 8; ++f) { const int kt = f >> 2, kk = f & 3; const int srow = 32 * sb + 8 * (q16 >> 2) + 4 * kt + (q16 & 3);
                            bfr8[f] = *(const LAS bf16x8*)(BS + srow * RS + (8 * g + 32 * kk) * 2); }
#pragma unroll
                        for (int pt = 0; pt < 4; ++pt) xfr[pt] = *(const LAS bf16x8*)(XT + (16 * pt + q16) * RS + (32 * sb + 8 * g) * 2);
                        __builtin_amdgcn_sched_barrier(0);
#pragma unroll
                        for (int kt = 0; kt < 2; ++kt) {
                            gt[kt] = (f32x4){0.f, 0.f, 0.f, 0.f};
#pragma unroll
                            for (int kk = 0; kk < 4; ++kk) gt[kt] = __builtin_amdgcn_mfma_f32_16x16x32_bf16(bfr8[4 * kt + kk], cfrag[kk], gt[kt], 0, 0, 0);
                        }
                        const f32x4 cs0 = *(const LAS f32x4*)(csf + 32 * sb + 8 * g), cs1 = *(const LAS f32x4*)(csf + 32 * sb + 8 * g + 4);
                        float mm[8];
#pragma unroll
                        for (int j = 0; j < 4; ++j) {
                            const int s0 = 32 * sb + 8 * g + j, s1 = s0 + 4;
                            mm[j] = (s0 <= l) ? gt[0][j] * __expf(fminf(csl - cs0[j], 0.f)) : 0.f;
                            mm[4 + j] = (s1 <= l) ? gt[1][j] * __expf(fminf(csl - cs1[j], 0.f)) : 0.f;
                        }
                        u32x4 w; w.x = cvt_pk_bf16_m(mm[0], mm[1]); w.y = cvt_pk_bf16_m(mm[2], mm[3]); w.z = cvt_pk_bf16_m(mm[4], mm[5]); w.w = cvt_pk_bf16_m(mm[6], mm[7]);
                        const bf16x8 pm = __builtin_bit_cast(bf16x8, w);
#pragma unroll
                        for (int pt = 0; pt < 4; ++pt) acc[pt] = __builtin_amdgcn_mfma_f32_16x16x32_bf16(xfr[pt], pm, acc[pt], 0, 0, 0);
                    }
#pragma unroll
                    for (int pt = 0; pt < 4; ++pt) { if (dir == 0) yold[pt] = *(const f32x4*)(yp + 16 * pt); *(f32x4*)(yp + 16 * pt) = yold[pt] + acc[pt]; }
                }
                asm volatile("s_waitcnt vmcnt(0)" ::: "memory");
                __syncthreads();
                {
                    const float ec = __expf(cs127);
#pragma unroll
                    for (int pt = 0; pt < 4; ++pt) st[pt] = st[pt] * ec;
                    {
                        bf16x8 btf[4], xa[4], xn[4];
#pragma unroll
                        for (int kk = 0; kk < 4; ++kk) btf[kk] = *(const LAS bf16x8*)(BT + (16 * wave + q16) * RS + (8 * g + 32 * kk) * 2);
#pragma unroll
                        for (int pt = 0; pt < 4; ++pt) xa[pt] = *(const LAS bf16x8*)(XT + (16 * pt + q16) * RS + (8 * g) * 2);
#pragma unroll
                        for (int kk = 0; kk < 4; ++kk) {
                            if (kk < 3) {
#pragma unroll
                                for (int pt = 0; pt < 4; ++pt) xn[pt] = *(const LAS bf16x8*)(XT + (16 * pt + q16) * RS + (8 * g + 32 * (kk + 1)) * 2);
                            }
                            __builtin_amdgcn_sched_barrier(0);
#pragma unroll
                            for (int pt = 0; pt < 4; ++pt) st[pt] = __builtin_amdgcn_mfma_f32_16x16x32_bf16(xa[pt], btf[kk], st[pt], 0, 0, 0);
#pragma unroll
                            for (int pt = 0; pt < 4; ++pt) xa[pt] = xn[pt];
                        }
                    }
#pragma unroll
                    for (int pt = 0; pt < 4; ++pt)
#pragma unroll
                        for (int j = 0; j < 4; ++j) *(LAS bf16_t*)(ST + (16 * pt + 4 * g + j) * RS + (16 * wave + q16) * 2) = (bf16_t)(cvt_pk_bf16(st[pt][j], 0.f) & 0xffffu);
                }
                __syncthreads();
#undef SC_ROW
            }
#undef SC_GEO
#undef SC_ROWX
#undef SC_FETCH
#undef SC_FETCH_DT
#undef SC_STAGE
        }
    }
}
__device__ __forceinline__ void phase_ssm_bc(const PV& P) {
    const bf16_t* zx = (const bf16_t*)(P.ws() + OFF_ZX); bf16_t* bc = (bf16_t*)(P.ws() + OFF_HB);
    const float* cw = P.in(27); const float* cb = P.in(28);
    const int tid = P.tid, c8 = (tid & 127) * 8, rsub = tid >> 7;
    f32x4 w0[2], w1[2], w2[2], bb[2];
#pragma unroll
    for (int q = 0; q < 2; ++q) { w0[q] = *(const f32x4*)(cw + 2048 + c8 + 4 * q); w1[q] = *(const f32x4*)(cw + 3072 + 2048 + c8 + 4 * q); w2[q] = *(const f32x4*)(cw + 6144 + 2048 + c8 + 4 * q); bb[q] = *(const f32x4*)(cb + 2048 + c8 + 4 * q); }
    const int rstep = P.gsz * 4;
    u32x4 nm, n0, np;
#define BC_LOAD(rr) do { int t_, L_; if ((rr) < TL) { t_ = (rr) & (SEQ - 1); L_ = SEQ; } else { t_ = ((rr) - TL) & (CTXL - 1); L_ = CTXL; } \
        const bf16_t* bp_ = zx + (size_t)(rr) * SSM_IN + 4096 + c8; const u32x4 z4_ = (u32x4){0u, 0u, 0u, 0u}; \
        nm = t_ > 0 ? *(const u32x4*)(bp_ - SSM_IN) : z4_; n0 = *(const u32x4*)bp_; np = t_ < L_ - 1 ? *(const u32x4*)(bp_ + SSM_IN) : z4_; } while (0)
    if (P.bid * 4 + rsub < TA) BC_LOAD(P.bid * 4 + rsub);
    for (int r = P.bid * 4 + rsub; r < TA; r += rstep) {
        const u32x4 um = nm, u0 = n0, up = np;
        if (r + rstep < TA) BC_LOAD(r + rstep);
        float o[8];
#pragma unroll
        for (int e2 = 0; e2 < 4; ++e2) { const int q = e2 >> 1, k = (e2 & 1) * 2;
            o[2 * e2] = silu_f(bb[q][k] + bflo(um[e2]) * w0[q][k] + bflo(u0[e2]) * w1[q][k] + bflo(up[e2]) * w2[q][k]);
            o[2 * e2 + 1] = silu_f(bb[q][k + 1] + bfhi(um[e2]) * w0[q][k + 1] + bfhi(u0[e2]) * w1[q][k + 1] + bfhi(up[e2]) * w2[q][k + 1]); }
        u32x4 w; w.x = cvt_pk_bf16(o[0], o[1]); w.y = cvt_pk_bf16(o[2], o[3]); w.z = cvt_pk_bf16(o[4], o[5]); w.w = cvt_pk_bf16(o[6], o[7]);
        *(u32x4*)(bc + (size_t)r * 1024 + c8) = w;
    }
#undef BC_LOAD
}
__device__ __forceinline__ void phase_ssm_gate(const PV& P) {
    const bf16_t* zx = (const bf16_t*)(P.ws() + OFF_ZX); float* Y = (float*)(P.ws() + OFF_Y); const float* ng = P.in(32);
    const int lane = P.tid & 63, wave = P.tid >> 6, gw = P.bid * 8 + wave, NGW = P.gsz * 8;
    f32x4 ngv[8];
#pragma unroll
    for (int j = 0; j < 8; ++j) ngv[j] = *((const f32x4*)ng + lane + 64 * j);
    f32x4 ny[8]; u32x2 nz[8];
    if (gw < TA) {
#pragma unroll
        for (int j = 0; j < 8; ++j) { ny[j] = *((const f32x4*)(Y + (size_t)gw * 2048) + lane + 64 * j); nz[j] = *((const u32x2*)(zx + (size_t)gw * SSM_IN) + lane + 64 * j); }
    }
    for (int r = gw; r < TA; r += NGW) {
        float* yrow = Y + (size_t)r * 2048;
        f32x4 v[8], cy[8]; u32x2 cz[8];
#pragma unroll
        for (int j = 0; j < 8; ++j) { cy[j] = ny[j]; cz[j] = nz[j]; }
        if (r + NGW < TA) {
#pragma unroll
            for (int j = 0; j < 8; ++j) { ny[j] = *((const f32x4*)(Y + (size_t)(r + NGW) * 2048) + lane + 64 * j); nz[j] = *((const u32x2*)(zx + (size_t)(r + NGW) * SSM_IN) + lane + 64 * j); }
        }
#pragma unroll
        for (int j = 0; j < 8; ++j) { const f32x4 y = cy[j]; const u32x2 zz = cz[j];
            v[j][0] = y[0] * silu_f(bflo(zz.x)); v[j][1] = y[1] * silu_f(bfhi(zz.x)); v[j][2] = y[2] * silu_f(bflo(zz.y)); v[j][3] = y[3] * silu_f(bfhi(zz.y)); }
        float rs[4];
#pragma unroll
        for (int gq = 0; gq < 4; ++gq) { float s = 0.f;
#pragma unroll
            for (int jj = 0; jj < 2; ++jj) { const f32x4 x = v[2 * gq + jj]; s += (x[0] * x[0] + x[1] * x[1]) + (x[2] * x[2] + x[3] * x[3]); }
            rs[gq] = 1.0f / sqrtf(wave_sum(s) * (1.0f / 512.0f) + LN_EPS); }
        bf16_t* orow = (bf16_t*)yrow;
#pragma unroll
        for (int j = 0; j < 8; ++j) { const f32x4 o = v[j] * rs[j >> 1] * ngv[j];
            u32x2 w; w.x = cvt_pk_bf16(o[0], o[1]); w.y = cvt_pk_bf16(o[2], o[3]); *((u32x2*)orow + lane + 64 * j) = w; }
    }
}


#ifndef REP_ATT
#define REP_ATT 1
#endif
#ifndef REP_HL
#define REP_HL 1
#endif
#ifndef REP_SCAN
#define REP_SCAN 1
#endif
#ifndef REP_FFN1
#define REP_FFN1 1
#endif
#ifndef REP_PRO
#define REP_PRO 1
#endif
#ifndef PROBE_STAGE_MASK
#define PROBE_STAGE_MASK 0
#endif
#ifndef PROBE_KIND_MASK
#define PROBE_KIND_MASK 7
#endif
__global__ void __launch_bounds__(512, 2) fwd_megakernel(Params PK) {
    extern __shared__ __attribute__((aligned(16))) unsigned char shm[];
    LAS unsigned char* lds = (LAS unsigned char*)shm;
    cg::grid_group grid = cg::this_grid();
    bool first = true;
    const int ph_lo = PK.ph_lo, ph_hi = PK.ph_hi;
    volatile LAS unsigned* bst = (volatile LAS unsigned*)(lds + LDS_BYTES - 64);
    if (threadIdx.x < 2) bst[threadIdx.x] = 0u;
    __syncthreads();
    XcdBarrier xbar; xbar.bar = nullptr; xbar.x = 0u; xbar.st = bst;
    int nseam = 0;
    int prep = 0;
    for (int ph = ph_lo; ph < ph_hi; ) {
        int layer = 0, st = -1;
        if (ph >= 2) { layer = (ph - 2) / 12; st = (ph - 2) % 12; }
        const int kind = layer % 3, jm = layer / 3;
        if (ph >= 2 && ((st == 5 || st == 6) && kind == 0)) { ++ph; continue; }
        if (!first) {
            if (nseam == 0) { grid.sync(); xbar = xcd_barrier_post((unsigned*)(PK.ws + OFF_BAR), bst, (int)threadIdx.x); }
            else xcd_barrier(xbar, (int)threadIdx.x, gridDim.x);
            ++nseam;
        }
        first = false;
        PV P; P.ka = (KArg)__builtin_amdgcn_kernarg_segment_ptr();
        asm volatile("" : "+s"(P.ka));
        { int t_ = threadIdx.x, b_ = blockIdx.x, g_ = gridDim.x; asm volatile("" : "+v"(t_)); asm volatile("" : "+s"(b_)); asm volatile("" : "+s"(g_)); P.tid = t_; P.bid = b_; P.gsz = g_; }
        const int G = P.gsz, bid = P.bid;
        unsigned char* ws = P.ws();
        float* lat = (float*)(ws + OFF_LAT); const bf16_t* hb = (const bf16_t*)(ws + OFF_HB); const float* mod = (const float*)(ws + OFF_MOD);
        if (ph == 0) { for (int rep = 0; rep < REP_PRO; ++rep) { phase_prologue(P, lds); __syncthreads(); } ++ph; continue; }
        if (ph == 1) { phase_init(P); ++ph; continue; }
        const bool lastl = (layer == 3);
        const float* modl = mod + (size_t)layer * 9 * NMODC;
        const int Mpost = lastl ? TL : TA;
        pg8::StaticOrder S;
        switch (st) {
        case 0: case 9: {
            const int s = st == 0 ? 0 : 1; const int M = (st == 9) ? Mpost : TA;
            pg8::Gemm g{hb, (const bf16_t*)(ws + OFF_W13T) + (size_t)(layer * 2 + s) * 5632 * 1024, M, 5632, 1024, 1024};
            S.init(M, 5632, G, bid); S.setk(1024); EpiSwiglu E{(bf16_t*)(ws + OFF_ACT)};
            for (int rep = 0; rep < REP_FFN1; ++rep) pg8::gemm_phase(lds, g, S, E, P.tid);
        } break;
        case 1: case 10: {
            const int s = st == 1 ? 0 : 1; const int M = (st == 10) ? Mpost : TA;
            pg8::Gemm g{(const bf16_t*)(ws + OFF_ACT), (const bf16_t*)(ws + OFF_W2T) + (size_t)(layer * 2 + s) * 1024 * FF, M, 1024, FF, FF};
            EpiResid E{lat, modl, s == 0 ? 2 : 8, 0.5f, nullptr};
            if (M == TA) { pg8::SplitOrder<8> S2; S2.init(FF, G, bid); EpiResidSplit E2{E, (float*)(ws + OFF_SLAB)}; pg8::gemm_phase(lds, g, S2, E2, P.tid); }
            else { S.init(M, 1024, G, bid); S.setk(FF); pg8::gemm_phase(lds, g, S, E, P.tid); }
        } break;
        case 2: case 8: case 11: {
            const int lidx = st == 2 ? 0 : (st == 8 ? 1 : 2);
            const bool fin = (st == 11) && lastl;
            const int Mln = st == 2 ? TA : (st == 8 ? Mpost : (lastl ? TL : TA));
            const float* nm = st == 11 ? modl + (size_t)9 * NMODC : modl;
            const int qs = st == 2 ? 3 : (st == 8 ? 6 : 0);
            const bool comb = (st == 2) || (st == 11 && !lastl);
            const float* sl = comb ? (const float*)(ws + OFF_SLAB) : nullptr;
            const float* g8 = modl + (size_t)8 * NMODC + (st == 2 ? 2 : 8) * 1024;
            phase_ln(P, Mln, P.in(6) + (size_t)(layer * 3 + lidx) * D, P.in(7) + (size_t)(layer * 3 + lidx) * D, nm, qs, fin ? P.out() : nullptr, sl, g8, 0.5f);
        } break;
        case 3: {
            if (kind == 0) {
                { pg8::Gemm g{hb, (const bf16_t*)(ws + OFF_WQKT) + (size_t)jm * 2048 * 1024, TA, 2048, 1024, 1024};
                  S.init(TA, 2048, G, bid); S.setk(1024); EpiQK E{(bf16_t*)(ws + OFF_QK), (const float*)(ws + OFF_ROPE)};
                  pg8::gemm_phase(lds, g, S, E, P.tid); }
                { pg8::Gemm g{(const bf16_t*)(ws + OFF_WVT) + (size_t)jm * 1024 * 1024, hb, 1024, TA, 1024, 1024};
                  S.init(1024, TA, G, bid); S.setk(1024); EpiB E{(bf16_t*)(ws + OFF_VT), TA, nullptr, TA};
                  pg8::gemm_phase(lds, g, S, E, P.tid); }
            } else if (kind == 1) {
                pg8::Gemm g{hb, (const bf16_t*)(ws + OFF_WHIT), TA, 3072, 1024, 1024};
                S.init(TA, 3072, G, bid); S.setk(1024); EpiB E{(bf16_t*)(ws + OFF_HU), 3072, P.in(15), 3072};
                pg8::gemm_phase(lds, g, S, E, P.tid);
            } else {
                pg8::Gemm g{hb, (const bf16_t*)(ws + OFF_WSIT), TA, SSM_INP, 1024, 1024};
                S.init(TA, SSM_INP, G, bid); S.setk(1024); EpiB E{(bf16_t*)(ws + OFF_ZX), SSM_IN, nullptr, SSM_IN};
                pg8::gemm_phase(lds, g, S, E, P.tid);
            }
        } break;
        case 4: {
            if (kind == 0) { for (int rep = 0; rep < REP_ATT; ++rep) phase_attention(P, lds, jm, layer == 0 ? 0.2f : (0.8f - 0.6f * 0.40656965974059917f), !lastl); }
            else if (kind == 1) phase_hy_short(P, lds);
            else phase_ssm_bc(P);
        } break;
        case 5: {
            if (kind == 1) phase_hy_conv(P, lds);
            else phase_ssm_scan(P, lds);
        } break;
        case 6: if (kind == 1) phase_hy_gate(P, lds); else phase_ssm_gate(P); break;
        case 7: {
            const bf16_t* Ap = kind == 0 ? (const bf16_t*)(ws + OFF_AO) : (kind == 1 ? (const bf16_t*)(ws + OFF_HG) : (const bf16_t*)(ws + OFF_Y));
            const bf16_t* Bp = kind == 0 ? (const bf16_t*)(ws + OFF_WOT) + (size_t)jm * 1024 * 1024 : (kind == 1 ? (const bf16_t*)(ws + OFF_WHOT) : (const bf16_t*)(ws + OFF_WSOT));
            const int Mo = kind == 0 ? Mpost : TA, Ko = kind == 2 ? 2048 : 1024, ldo = kind == 2 ? 4096 : 1024;
            const float* bo = kind == 1 ? P.in(25) : nullptr;
            pg8::Gemm g{Ap, Bp, Mo, 1024, Ko, ldo};
            S.init(Mo, 1024, G, bid); S.setk(Ko); EpiResid E{lat, modl, 5, 1.0f, bo};
            pg8::gemm_phase(lds, g, S, E, P.tid);
        } break;
        default: break;
        }
        if (PROBE_STAGE_MASK && ((PROBE_STAGE_MASK >> st) & 1) && ((PROBE_KIND_MASK >> kind) & 1) && prep == 0) prep = 1; else { prep = 0; ++ph; }
    }
}

extern "C" void kernel_launch(void* const* d_in, const int* in_sizes, int n_in, void* d_out, int out_size, void* d_ws, size_t ws_size, hipStream_t stream) {
    static int grid = 0;
    if (grid == 0) {
        if (n_in != 34 || ws_size < WS_END) { fprintf(stderr, "kernel_launch: unexpected n_in %d or ws_size %zu (< %zu)\n", n_in, ws_size, (size_t)WS_END); grid = -1; return; }
        int dev = 0, cus = 0, per_cu = 0;
        (void)hipGetDevice(&dev);
        (void)hipDeviceGetAttribute(&cus, hipDeviceAttributeMultiprocessorCount, dev);
        if (hipFuncSetAttribute((const void*)fwd_megakernel, hipFuncAttributeMaxDynamicSharedMemorySize, LDS_BYTES) != hipSuccess) { fprintf(stderr, "kernel_launch: hipFuncSetAttribute failed\n"); }
        (void)hipOccupancyMaxActiveBlocksPerMultiprocessor(&per_cu, (const void*)fwd_megakernel, 512, LDS_BYTES);
        (void)hipGetLastError();
        if (per_cu < 1) { fprintf(stderr, "kernel_launch: occupancy query says %d blocks per CU\n", per_cu); per_cu = 1; }
        grid = cus;
    }
    if (grid < 0) return;
    Params p{};
    for (int i = 0; i < 34; ++i) p.in[i] = (const float*)d_in[i];
    p.out = (float*)d_out; p.ws = (unsigned char*)d_ws; p.ph_lo = 0; p.ph_hi = 2 + 48;
    void* args[] = {&p};
    hipError_t e = hipLaunchCooperativeKernel((const void*)fwd_megakernel, dim3(grid), dim3(512), args, LDS_BYTES, stream);
    if (e != hipSuccess) fprintf(stderr, "cooperative launch failed: %s (grid %d)\n", hipGetErrorString(e), grid);
}
```
